# Optimizing an MI355X kernel written in HIP

```python
import jax, jax.numpy as jnp
from jax import lax
import numpy as np

D_MODEL = 1024
BATCH = 4
SEQ = 8192
DEPTH = 4

N_A = DEPTH // 2
N_B = DEPTH - N_A
RET_HEADS = 4
RET_QK_DIM = D_MODEL // RET_HEADS
RET_V_DIM = 2 * RET_QK_DIM
RET_PROJ = 2 * RET_HEADS * RET_QK_DIM + 2 * RET_HEADS * RET_V_DIM
RET_CHUNK = 128
GN_EPS = 1e-6
MLA_HEADS = 8
QK_NOPE = 128
QK_ROPE = 64
V_HEAD = 128
Q_LORA = 256
KV_LORA = 256
ATTN_BLOCK = 128
RMS_EPS = 1e-6
ROPE_THETA = 10000.0
MAX_POS_OFFSET = 4096
N_EXPERTS = 32
TOP_K = 4
D_FF = D_MODEL
SWIGLU_LIMIT = 7.0
SWIGLU_ALPHA = 1.702
MOE_BLOCK = 128
PLE_DIM = 256
DN_ALPHA = (2 * DEPTH) ** 0.25
DN_BETA = (8 * DEPTH) ** -0.25
LN_EPS = 1e-5

kernel_name = 'yoco_retnet_mla_moe_deepnorm_ple'


def layer_norm(x, g, b):
    xf = x.astype(jnp.float32)
    mu = xf.mean(-1, keepdims=True)
    var = jnp.square(xf - mu).mean(-1, keepdims=True)
    return ((xf - mu) * lax.rsqrt(var + LN_EPS) * g + b).astype(x.dtype)


def rms_norm(x, g):
    xf = x.astype(jnp.float32)
    return (xf * lax.rsqrt(jnp.square(xf).mean(-1, keepdims=True) + RMS_EPS) * g).astype(x.dtype)


def rope_tables(positions, dim):
    inv = ROPE_THETA ** (-jnp.arange(0, dim, 2, dtype=jnp.float32) / dim)
    ang = positions.astype(jnp.float32)[..., None] * inv
    return jnp.cos(ang), jnp.sin(ang)


def apply_rope(x, cos, sin):
    x1, x2 = jnp.split(x, 2, axis=-1)
    c = cos[:, :, None, :].astype(x.dtype)
    s = sin[:, :, None, :].astype(x.dtype)
    return jnp.concatenate([x1 * c - x2 * s, x1 * s + x2 * c], axis=-1)


def chunkwise_retention(q, k, v):
    B, S, H, dk = q.shape
    dv = v.shape[-1]
    C = RET_CHUNK
    N = S // C
    log_g = jnp.log(1.0 - 2.0 ** (-5.0 - jnp.arange(H, dtype=jnp.float32)))
    idx = jnp.arange(C, dtype=jnp.float32)
    diff = idx[:, None] - idx[None, :]
    decay_intra = jnp.where(diff >= 0, jnp.exp(log_g[:, None, None] * jnp.maximum(diff, 0.0)), 0.0)
    decay_q = jnp.exp(log_g[:, None] * (idx + 1.0))[None, :, :, None]
    decay_k = jnp.exp(log_g[:, None] * (C - 1.0 - idx))[None, :, :, None]
    decay_chunk = jnp.exp(log_g * C)[None, :, None, None]

    def to_chunks(t):
        return t.astype(jnp.float32).reshape(B, N, C, H, t.shape[-1]).transpose(1, 0, 3, 2, 4)

    qc, kc, vc = to_chunks(q), to_chunks(k), to_chunks(v)

    def step(state, inp):
        qi, ki, vi = inp
        inner = jnp.einsum('bhqd,bhkd->bhqk', qi, ki) * decay_intra
        y = jnp.einsum('bhqk,bhkv->bhqv', inner, vi)
        y = y + jnp.einsum('bhqd,bhdv->bhqv', qi, state) * decay_q
        state = state * decay_chunk + jnp.einsum('bhkd,bhkv->bhdv', ki * decay_k, vi)
        return state, y

    state0 = jnp.zeros((B, H, dk, dv), jnp.float32)
    _, ys = lax.scan(step, state0, (qc, kc, vc))
    return ys.transpose(1, 0, 3, 2, 4).reshape(B, S, H, dv)


def retention_mixer(x, cos, sin, w_in, gn_g, gn_b, w_out):
    B, S, _ = x.shape
    H, dk, dv = RET_HEADS, RET_QK_DIM, RET_V_DIM
    q, k, v, g = jnp.split(x @ w_in, [H * dk, 2 * H * dk, 2 * H * dk + H * dv], axis=-1)
    q = apply_rope(q.reshape(B, S, H, dk), cos, sin)
    k = apply_rope(k.reshape(B, S, H, dk), cos, sin) * (dk ** -0.5)
    y = chunkwise_retention(q, k, v.reshape(B, S, H, dv))
    mu = y.mean(-1, keepdims=True)
    var = jnp.square(y - mu).mean(-1, keepdims=True)
    y = ((y - mu) * lax.rsqrt(var + GN_EPS)).reshape(B, S, H * dv) * gn_g + gn_b
    y = y.astype(x.dtype)
    return (jax.nn.silu(g) * y) @ w_out


def mla_shared_kv(h, cos, sin, w_kv_a, kv_norm_g, w_kv_b):
    B, S, _ = h.shape
    c_kv, k_rope = jnp.split(h @ w_kv_a, [KV_LORA], axis=-1)
    c_kv = rms_norm(c_kv, kv_norm_g)
    kv = (c_kv @ w_kv_b).reshape(B, S, MLA_HEADS, QK_NOPE + V_HEAD)
    k_nope, v = jnp.split(kv, [QK_NOPE], axis=-1)
    k_rope = apply_rope(k_rope[:, :, None, :], cos, sin)[:, :, 0]
    return k_nope, k_rope, v


def mla_mixer(x, cos, sin, k_nope, k_rope, v, w_q_a, q_norm_g, w_q_b, w_o):
    B, S, _ = x.shape
    H = MLA_HEADS
    q = (rms_norm(x @ w_q_a, q_norm_g) @ w_q_b).reshape(B, S, H, QK_NOPE + QK_ROPE)
    q_nope, q_rope = jnp.split(q, [QK_NOPE], axis=-1)
    q_rope = apply_rope(q_rope, cos, sin)
    scale = (QK_NOPE + QK_ROPE) ** -0.5
    nblk = S // ATTN_BLOCK
    qn_b = q_nope.reshape(B, nblk, ATTN_BLOCK, H, QK_NOPE).transpose(1, 0, 2, 3, 4)
    qr_b = q_rope.reshape(B, nblk, ATTN_BLOCK, H, QK_ROPE).transpose(1, 0, 2, 3, 4)
    key_pos = jnp.arange(S)

    def block(args):
        i, qn, qr = args
        s = jnp.einsum('bqhd,bkhd->bhqk', qn, k_nope) + jnp.einsum('bqhr,bkr->bhqk', qr, k_rope)
        s = s.astype(jnp.float32) * scale
        q_pos = i * ATTN_BLOCK + jnp.arange(ATTN_BLOCK)
        s = jnp.where(key_pos[None, :] <= q_pos[:, None], s, -jnp.inf)
        pr = jax.nn.softmax(s, axis=-1).astype(v.dtype)
        return jnp.einsum('bhqk,bkhv->bqhv', pr, v)

    o = lax.map(block, (jnp.arange(nblk), qn_b, qr_b))
    o = o.transpose(1, 0, 2, 3, 4).reshape(B, S, H * V_HEAD)
    return o @ w_o


def moe_ffn(x, w_router, b_router, w_gate_up, b_gate_up, w_down, b_down):
    B, S, D = x.shape
    T = B * S
    xf = x.reshape(T, D)
    logits = (xf @ w_router + b_router).astype(jnp.float32)
    top_vals, top_idx = lax.top_k(logits, TOP_K)
    gates = jax.nn.softmax(top_vals, axis=-1).astype(x.dtype)
    n_assign = T * TOP_K
    e_flat = top_idx.reshape(-1).astype(jnp.int32)
    tok_flat = jnp.repeat(jnp.arange(T, dtype=jnp.int32), TOP_K)
    g_flat = gates.reshape(-1)
    order = jnp.argsort(e_flat)
    e_sorted, tok_sorted, g_sorted = e_flat[order], tok_flat[order], g_flat[order]
    counts = jnp.zeros((N_EXPERTS,), jnp.int32).at[e_flat].add(1)
    padded = (counts + MOE_BLOCK - 1) // MOE_BLOCK * MOE_BLOCK
    start = jnp.cumsum(counts) - counts
    pend = jnp.cumsum(padded)
    pstart = pend - padded
    dest = pstart[e_sorted] + jnp.arange(n_assign, dtype=jnp.int32) - start[e_sorted]
    n_slots = n_assign + N_EXPERTS * MOE_BLOCK
    n_blocks = n_slots // MOE_BLOCK
    slot_tok = jnp.zeros((n_slots,), jnp.int32).at[dest].set(tok_sorted)
    slot_gate = jnp.zeros((n_slots,), x.dtype).at[dest].set(g_sorted)
    block_start = jnp.arange(n_blocks, dtype=jnp.int32) * MOE_BLOCK
    block_expert = jnp.minimum(jnp.searchsorted(pend, block_start, side='right'), N_EXPERTS - 1)

    def expert_block(args):
        e, toks, gts = args
        hgu = xf[toks] @ w_gate_up[e] + b_gate_up[e]
        gate, up = jnp.split(hgu, 2, axis=-1)
        gate = jnp.minimum(gate, SWIGLU_LIMIT)
        up = jnp.clip(up, -SWIGLU_LIMIT, SWIGLU_LIMIT)
        act = gate * jax.nn.sigmoid(SWIGLU_ALPHA * gate) * (up + 1.0)
        return (act @ w_down[e] + b_down[e]) * gts[:, None]

    y_slots = lax.map(expert_block, (block_expert, slot_tok.reshape(n_blocks, MOE_BLOCK),
                                     slot_gate.reshape(n_blocks, MOE_BLOCK)))
    y = jnp.zeros((T, D), x.dtype).at[slot_tok].add(y_slots.reshape(n_slots, D))
    return y.reshape(B, S, D)


def setup_inputs(seed: int = 0) -> dict:
    key = jax.random.key(seed)
    ks = jax.random.split(key, 32)
    f32 = jnp.float32

    def nrm(k, shape, scale):
        return jax.random.normal(k, shape, f32) * scale

    def gain(k, shape):
        return 1.0 + 0.02 * jax.random.normal(k, shape, f32)

    H, dk, dv = RET_HEADS, RET_QK_DIM, RET_V_DIM
    x = nrm(ks[0], (BATCH, SEQ, D_MODEL), 1.0)
    p = nrm(ks[1], (DEPTH, BATCH, SEQ, PLE_DIM), 1.0)
    positions = (jax.random.randint(ks[2], (BATCH, 1), 0, MAX_POS_OFFSET, jnp.int32)
                 + jnp.arange(SEQ, dtype=jnp.int32)[None, :])
    ret_col = jnp.concatenate([jnp.ones((2 * H * dk,), f32), jnp.full((H * dv,), DN_BETA, f32),
                               jnp.ones((H * dv,), f32)])
    ret_w_in = nrm(ks[3], (N_A, D_MODEL, RET_PROJ), D_MODEL ** -0.5) * ret_col
    ret_gn_g = gain(ks[4], (N_A, H * dv))
    ret_gn_b = nrm(ks[5], (N_A, H * dv), 0.02)
    ret_w_out = nrm(ks[6], (N_A, H * dv, D_MODEL), (H * dv) ** -0.5 * DN_BETA)
    mla_w_kv_a = nrm(ks[7], (D_MODEL, KV_LORA + QK_ROPE), D_MODEL ** -0.5)
    mla_kv_norm_g = gain(ks[8], (KV_LORA,))
    kv_col = jnp.concatenate([jnp.ones((QK_NOPE,), f32), jnp.full((V_HEAD,), DN_BETA, f32)])
    mla_w_kv_b = (nrm(ks[9], (KV_LORA, MLA_HEADS, QK_NOPE + V_HEAD), KV_LORA ** -0.5) * kv_col
                  ).reshape(KV_LORA, MLA_HEADS * (QK_NOPE + V_HEAD))
    mla_w_q_a = nrm(ks[10], (N_B, D_MODEL, Q_LORA), D_MODEL ** -0.5)
    mla_q_norm_g = gain(ks[11], (N_B, Q_LORA))
    mla_w_q_b = nrm(ks[12], (N_B, Q_LORA, MLA_HEADS * (QK_NOPE + QK_ROPE)), Q_LORA ** -0.5)
    mla_w_o = nrm(ks[13], (N_B, MLA_HEADS * V_HEAD, D_MODEL), (MLA_HEADS * V_HEAD) ** -0.5 * DN_BETA)
    ln_mix_g = gain(ks[14], (DEPTH, D_MODEL))
    ln_mix_b = nrm(ks[15], (DEPTH, D_MODEL), 0.02)
    ln_ffn_g = gain(ks[16], (DEPTH, D_MODEL))
    ln_ffn_b = nrm(ks[17], (DEPTH, D_MODEL), 0.02)
    moe_w_router = nrm(ks[18], (DEPTH, D_MODEL, N_EXPERTS), D_MODEL ** -0.5)
    moe_b_router = nrm(ks[19], (DEPTH, N_EXPERTS), 0.01)
    moe_w_gate_up = nrm(ks[20], (DEPTH, N_EXPERTS, D_MODEL, 2 * D_FF), D_MODEL ** -0.5)
    moe_b_gate_up = nrm(ks[21], (DEPTH, N_EXPERTS, 2 * D_FF), 0.02)
    moe_w_down = nrm(ks[22], (DEPTH, N_EXPERTS, D_FF, D_MODEL), D_FF ** -0.5 * DN_BETA)
    moe_b_down = nrm(ks[23], (DEPTH, N_EXPERTS, D_MODEL), 0.02)
    ple_w_gate = nrm(ks[24], (DEPTH, D_MODEL, D_MODEL), D_MODEL ** -0.5)
    ple_w_proj = nrm(ks[25], (DEPTH, PLE_DIM, D_MODEL), PLE_DIM ** -0.5)
    return {'x': x, 'p': p, 'positions': positions,
            'ret_w_in': ret_w_in, 'ret_gn_g': ret_gn_g, 'ret_gn_b': ret_gn_b, 'ret_w_out': ret_w_out,
            'mla_w_kv_a': mla_w_kv_a, 'mla_kv_norm_g': mla_kv_norm_g, 'mla_w_kv_b': mla_w_kv_b,
            'mla_w_q_a': mla_w_q_a, 'mla_q_norm_g': mla_q_norm_g, 'mla_w_q_b': mla_w_q_b, 'mla_w_o': mla_w_o,
            'ln_mix_g': ln_mix_g, 'ln_mix_b': ln_mix_b, 'ln_ffn_g': ln_ffn_g, 'ln_ffn_b': ln_ffn_b,
            'moe_w_router': moe_w_router, 'moe_b_router': moe_b_router,
            'moe_w_gate_up': moe_w_gate_up, 'moe_b_gate_up': moe_b_gate_up,
            'moe_w_down': moe_w_down, 'moe_b_down': moe_b_down,
            'ple_w_gate': ple_w_gate, 'ple_w_proj': ple_w_proj}


def reference(x, p, positions, ret_w_in, ret_gn_g, ret_gn_b, ret_w_out,
              mla_w_kv_a, mla_kv_norm_g, mla_w_kv_b, mla_w_q_a, mla_q_norm_g, mla_w_q_b, mla_w_o,
              ln_mix_g, ln_mix_b, ln_ffn_g, ln_ffn_b, moe_w_router, moe_b_router,
              moe_w_gate_up, moe_b_gate_up, moe_w_down, moe_b_down, ple_w_gate, ple_w_proj):
    cos_r, sin_r = rope_tables(positions, RET_QK_DIM)
    cos_m, sin_m = rope_tables(positions, QK_ROPE)
    h = x
    shared_kv = None
    for i in range(DEPTH):
        if i < N_A:
            mix = retention_mixer(h, cos_r, sin_r, ret_w_in[i], ret_gn_g[i], ret_gn_b[i], ret_w_out[i])
        else:
            if i == N_A:
                shared_kv = mla_shared_kv(h, cos_m, sin_m, mla_w_kv_a, mla_kv_norm_g, mla_w_kv_b)
            j = i - N_A
            mix = mla_mixer(h, cos_m, sin_m, shared_kv[0], shared_kv[1], shared_kv[2],
                            mla_w_q_a[j], mla_q_norm_g[j], mla_w_q_b[j], mla_w_o[j])
        h = layer_norm(DN_ALPHA * h + mix, ln_mix_g[i], ln_mix_b[i])
        ffn = moe_ffn(h, moe_w_router[i], moe_b_router[i], moe_w_gate_up[i], moe_b_gate_up[i],
                      moe_w_down[i], moe_b_down[i])
        h = layer_norm(DN_ALPHA * h + ffn, ln_ffn_g[i], ln_ffn_b[i])
        h = h + jax.nn.sigmoid(h @ ple_w_gate[i]) * (p[i] @ ple_w_proj[i])
    return h
```

```cpp
#include <hip/hip_runtime.h>
#include <cstdio>
#include <cstdint>

#define LAS __attribute__((address_space(3)))
#define GAS __attribute__((address_space(1)))
typedef unsigned short bf16_t;
typedef short bf16x8 __attribute__((ext_vector_type(8)));
typedef short s16x4 __attribute__((ext_vector_type(4)));
typedef float f32x4 __attribute__((ext_vector_type(4)));
typedef float f32x2 __attribute__((ext_vector_type(2)));
typedef float f32x16 __attribute__((ext_vector_type(16)));
typedef unsigned u32x4 __attribute__((ext_vector_type(4)));
typedef unsigned u32x2 __attribute__((ext_vector_type(2)));

constexpr int T = 32768, SEQ = 8192, NB = 4, D = 1024, DEPTH = 4, NE = 32;
constexpr int NSLOT = T * 4 + NE * 256;
constexpr float DN_ALPHA = 1.6817928305074290f;
constexpr float LN_EPS = 1e-5f, GN_EPS = 1e-6f, RMS_EPS = 1e-6f;
constexpr float SWIGLU_LIMIT = 7.0f, SWIGLU_ALPHA = 1.702f;
#ifndef ATT_FP8
#define ATT_FP8 1
#endif
constexpr float ATT_QS = 8.0f, ATT_VS = 2.0f, ATT_PS = 16.0f;
#ifndef G5_FP8
#define G5_FP8 1
#endif
constexpr float WROUT_SCALE = 128.0f, Z_SCALE = 4.0f;
#ifndef G1B_FP8
#define G1B_FP8 1
#endif
constexpr float WV_SCALE = 32.0f;
constexpr float WQA_SCALE = 32.0f, WKVA_SCALE = 32.0f, WO_SCALE = 64.0f, OB_SCALE = 16.0f;
constexpr float WGU_SCALE = 32.0f, WDN_SCALE = 64.0f, ACT_SCALE = 4.0f, YS_SCALE = 16.0f;

constexpr size_t al256(size_t x) { return (x + 255) & ~(size_t)255; }
constexpr size_t WS_CTL = 0, CTL_BYTES = 1u << 20;
constexpr size_t WS_WRT = WS_CTL + (512u << 10);
constexpr size_t WS_WRIN  = WS_CTL + CTL_BYTES;
constexpr size_t WS_WROUT = WS_WRIN  + (size_t)2 * 6144 * 1024 * 2;
constexpr size_t WS_WKVA  = WS_WROUT + (size_t)2 * 1024 * 2048 * 2;
constexpr size_t WS_WKVB  = WS_WKVA  + (size_t)512 * 1024 * 2;
constexpr size_t WS_WQA   = WS_WKVB  + (size_t)2048 * 256 * 2;
constexpr size_t WS_WQB   = WS_WQA   + (size_t)2 * 256 * 1024 * 2;
constexpr size_t WS_WO    = WS_WQB   + (size_t)2 * 1536 * 256 * 2;
constexpr size_t WS_WGU   = WS_WO    + (size_t)2 * 1024 * 1024 * 2;
constexpr size_t WS_WDN   = WS_WGU   + (size_t)4 * 32 * 2048 * 1024 * 2;
constexpr size_t WS_WPG   = WS_WDN   + (size_t)4 * 32 * 1024 * 1024 * 2;
constexpr size_t WS_WPP   = WS_WPG   + (size_t)4 * 1024 * 1024 * 2;
constexpr size_t WS_COSR  = WS_WPP   + (size_t)4 * 1024 * 256 * 2;
constexpr size_t WS_SINR  = WS_COSR  + (size_t)T * 128 * 4;
constexpr size_t WS_COSRT = WS_SINR  + (size_t)T * 128 * 4;
constexpr size_t WS_SINRT = WS_COSRT + (size_t)T * 128 * 4;
constexpr size_t WS_COSM  = WS_SINRT + (size_t)T * 128 * 4;
constexpr size_t WS_SINM  = WS_COSM  + (size_t)T * 32 * 4;
constexpr size_t WS_XBA   = WS_SINM  + (size_t)T * 32 * 4;
constexpr size_t WS_XBB   = WS_XBA   + (size_t)T * 1024 * 2;
constexpr size_t WS_H     = WS_XBB   + (size_t)T * 1024 * 2;
constexpr size_t WS_XF8   = WS_H     + (size_t)T * 1024 * 2;
constexpr size_t WS_MIX   = WS_H     + (size_t)T * 1024 * 4;
constexpr size_t WS_PB    = WS_MIX   + (size_t)T * 1024 * 4;
constexpr size_t WS_PP    = WS_PB    + (size_t)4 * T * 256 * 2;
constexpr size_t WS_MIXER = WS_PP    + (size_t)4 * T * 1024 * 2;
constexpr size_t WS_QB    = WS_MIXER;
constexpr size_t WS_KB    = WS_QB    + (size_t)T * 1024 * 2;
constexpr size_t WS_ACAT  = WS_KB    + (size_t)T * 1024 * 2;
constexpr size_t WS_KDT   = WS_ACAT  + (size_t)T * 2048 * 2;
constexpr size_t WS_VS    = WS_KDT   + (size_t)T * 1024 * 2;
constexpr size_t WS_GB    = WS_VS    + (size_t)16 * 32 * 512 * 512 * 2;
constexpr size_t WS_Y     = WS_GB    + (size_t)T * 2048 * 2;
constexpr size_t WS_Z     = WS_Y     + (size_t)T * 2048 * 2;
constexpr size_t WS_MIXER_END = WS_Z + (size_t)T * 2048 * 2;
constexpr size_t WS_CKV   = WS_MIXER;
constexpr size_t WS_SSQ   = WS_CKV   + (size_t)T * 256 * 2;
constexpr size_t WS_SSQ2  = WS_SSQ   + (size_t)T * 4 * 4;
constexpr size_t WS_KBUF  = WS_SSQ2  + (size_t)T * 4 * 4;
constexpr size_t WS_VBUF  = WS_KBUF  + (size_t)T * 1536 * 2;
constexpr size_t WS_QLAT  = WS_VBUF  + (size_t)T * 1024 * 2;
constexpr size_t WS_QBUF  = WS_QLAT  + (size_t)T * 256 * 2;
constexpr size_t WS_OB    = WS_QBUF  + (size_t)T * 1536 * 2;
static_assert(WS_OB + (size_t)T * 1024 * 2 <= WS_MIXER_END, "MLA overlay fits");
constexpr size_t WS_XG    = WS_MIXER_END;
constexpr size_t WS_ACT   = WS_XG    + (size_t)NSLOT * 1024 * 2;
constexpr size_t WS_YS    = WS_ACT   + (size_t)NSLOT * 1024 * 2;
constexpr size_t WS_EIDX  = WS_YS    + (size_t)NSLOT * 1024 * 2;
constexpr size_t WS_GATE  = WS_EIDX  + (size_t)T * 16;
constexpr size_t WS_POS   = WS_GATE  + (size_t)T * 16;
constexpr size_t WS_SLOT  = WS_POS   + (size_t)T * 16;
constexpr size_t WS_END   = WS_SLOT  + (size_t)T * 16;
constexpr size_t WS_WV8   = WS_END + ((size_t)200 << 20);
constexpr int CW_BAR = 4096;
constexpr int CW_CNT = 8192;

constexpr int RING_BYTES = 131072;
constexpr int MISC_OFF = 139264;
constexpr int GB_OFF = 147456;
constexpr int LDS_BYTES = 155648;
constexpr int MW_BAR = 0, MW_PSTART = 16, MW_CNT = 48, MW_GIDX = 1024, MW_NRB = 80, MW_RBEXP = 128, MW_LCNT = 320, MW_LBASE = 352, MW_TOK = 384;

__device__ __forceinline__ unsigned cvt_pk_bf16(float lo, float hi) { unsigned r; asm volatile("v_cvt_pk_bf16_f32 %0, %1, %2" : "=v"(r) : "v"(lo), "v"(hi)); return r; }
__device__ __forceinline__ u32x4 pack8(f32x4 a, f32x4 b) { u32x4 w; w.x = cvt_pk_bf16(a[0], a[1]); w.y = cvt_pk_bf16(a[2], a[3]); w.z = cvt_pk_bf16(b[0], b[1]); w.w = cvt_pk_bf16(b[2], b[3]); return w; }
__device__ __forceinline__ unsigned cvt4_fp8(float a, float b, float c, float d) { int w = 0; w = __builtin_amdgcn_cvt_pk_fp8_f32(a, b, w, false); w = __builtin_amdgcn_cvt_pk_fp8_f32(c, d, w, true); return (unsigned)w; }
__device__ __forceinline__ float bf2f(unsigned short b) { return __uint_as_float(((unsigned)b) << 16); }
__device__ __forceinline__ float bflo(unsigned w) { return __uint_as_float(w << 16); }
__device__ __forceinline__ float bfhi(unsigned w) { return __uint_as_float(w & 0xffff0000u); }
#define DPP_F(v, ctrl) __uint_as_float((unsigned)__builtin_amdgcn_update_dpp(0, (int)__float_as_uint(v), ctrl, 0xF, 0xF, false))
#define DPP_U(v, ctrl) ((unsigned)__builtin_amdgcn_update_dpp(0, (int)(v), ctrl, 0xF, 0xF, false))
__device__ __forceinline__ float wave_sum(float v) {
    v += DPP_F(v, 0xB1); v += DPP_F(v, 0x4E); v += DPP_F(v, 0x141); v += DPP_F(v, 0x140);
    const float r0 = __uint_as_float(__builtin_amdgcn_readlane(__float_as_uint(v), 0)), r1 = __uint_as_float(__builtin_amdgcn_readlane(__float_as_uint(v), 16));
    const float r2 = __uint_as_float(__builtin_amdgcn_readlane(__float_as_uint(v), 32)), r3 = __uint_as_float(__builtin_amdgcn_readlane(__float_as_uint(v), 48));
    return (r0 + r1) + (r2 + r3);
}
__device__ __forceinline__ unsigned wave_umax(unsigned v) {
    v = max(v, DPP_U(v, 0xB1)); v = max(v, DPP_U(v, 0x4E)); v = max(v, DPP_U(v, 0x141)); v = max(v, DPP_U(v, 0x140));
    const unsigned r0 = __builtin_amdgcn_readlane(v, 0), r1 = __builtin_amdgcn_readlane(v, 16), r2 = __builtin_amdgcn_readlane(v, 32), r3 = __builtin_amdgcn_readlane(v, 48);
    return max(max(r0, r1), max(r2, r3));
}
__device__ __forceinline__ void xpose8(float (&x)[8], int lane) {
    const bool b4 = lane & 4, b2 = lane & 2, b1 = lane & 1;
#pragma unroll
    for (int j = 0; j < 4; ++j) { const float a = x[j], b = x[j + 4]; const float snd = b4 ? a : b; const float rcv = DPP_F(DPP_F(snd, 0x141), 0x1B); x[j] = b4 ? rcv : a; x[j + 4] = b4 ? b : rcv; }
#pragma unroll
    for (int j = 0; j < 8; ++j) if ((j & 2) == 0) { const float a = x[j], b = x[j + 2]; const float snd = b2 ? a : b; const float rcv = DPP_F(snd, 0x4E); x[j] = b2 ? rcv : a; x[j + 2] = b2 ? b : rcv; }
#pragma unroll
    for (int j = 0; j < 8; ++j) if ((j & 1) == 0) { const float a = x[j], b = x[j + 1]; const float snd = b1 ? a : b; const float rcv = DPP_F(snd, 0xB1); x[j] = b1 ? rcv : a; x[j + 1] = b1 ? b : rcv; }
}
__device__ __forceinline__ int lane_id() { int l; asm volatile("v_mbcnt_lo_u32_b32 %0, -1, 0\n\tv_mbcnt_hi_u32_b32 %0, -1, %0" : "=v"(l)); return l; }
__device__ __forceinline__ float sigmoidf_(float x) { return __builtin_amdgcn_rcpf(1.0f + __builtin_amdgcn_exp2f(x * -1.4426950408889634f)); }

#define XB_TMO      128
#define XB_XCNT(j)  (256  + 64 * (j))
#define XB_XSUB(j)  (1280 + 64 * (j))
#define XB_XGEN(j)  (2304 + 64 * (j))
#define XB_TOP      3328
#define XB_TOPGEN   3392
#define XCD_BAR_WORDS 3456
#define XB_SPIN_CAP (1u << 18)
__device__ __forceinline__ unsigned xb_ld(unsigned* p)              { return __hip_atomic_load(p, __ATOMIC_RELAXED, __HIP_MEMORY_SCOPE_AGENT); }
__device__ __forceinline__ unsigned xb_add(unsigned* p, unsigned v) { return __hip_atomic_fetch_add(p, v, __ATOMIC_RELAXED, __HIP_MEMORY_SCOPE_AGENT); }
__device__ __forceinline__ unsigned xb_xcc_id() { return (unsigned)__builtin_amdgcn_s_getreg((3 << 11) | 20) & 0xFu; }
#define XB_SPIN(cond, bar) do { unsigned _sp = 0; while (cond) { __builtin_amdgcn_s_sleep(1); \
    if ((++_sp & 255u) == 0u) { if (xb_ld(&(bar)[XB_TMO])) break; if (_sp > XB_SPIN_CAP) { atomicAdd(&(bar)[XB_TMO], 1u); break; } } } } while (0)
struct XcdBarrier { unsigned* bar; unsigned x; volatile LAS unsigned* st; int wave; };
__device__ __forceinline__ XcdBarrier xcd_barrier_post(unsigned* bar, volatile LAS unsigned* st) {
    XcdBarrier b; b.bar = bar; b.x = xb_xcc_id(); b.st = st; b.wave = __builtin_amdgcn_readfirstlane((int)(threadIdx.x >> 6));
    if (threadIdx.x == 0) (void)xb_add(&bar[XB_XCNT(b.x)], 1u);
    return b;
}
__device__ __forceinline__ void xcd_barrier_complete(unsigned* bar, unsigned x, unsigned& nloc, unsigned& nx) {
    const unsigned G = gridDim.x * gridDim.y * gridDim.z;
    unsigned sum, cnt, mine, sp = 0u;
    for (;;) {
        sum = 0u; cnt = 0u; mine = 0u;
#pragma unroll
        for (unsigned j = 0; j < 16; ++j) { const unsigned c = xb_ld(&bar[XB_XCNT(j)]); sum += c; cnt += (c > 0u) ? 1u : 0u; mine = (j == x) ? c : mine; }
        if (sum == G) break;
        __builtin_amdgcn_s_sleep(1);
        if ((++sp & 255u) == 0u) { if (xb_ld(&bar[XB_TMO])) break; if (sp > XB_SPIN_CAP) { atomicAdd(&bar[XB_TMO], 1u); break; } }
    }
    nloc = mine > 0u ? mine : 1u; nx = cnt > 0u ? cnt : 1u;
}
__device__ __forceinline__ void xcd_barrier(const XcdBarrier& b) {
    asm volatile("s_waitcnt vmcnt(0)" ::: "memory");
    __syncthreads();
    if (b.wave == 0 && lane_id() == 0) {
        unsigned* bar = b.bar; asm volatile("" : "+s"(bar));
        __builtin_amdgcn_s_waitcnt(0);
        unsigned nloc = b.st[0], nx = b.st[1];
        if (nloc == 0u) { xcd_barrier_complete(bar, b.x, nloc, nx); b.st[0] = nloc; b.st[1] = nx; }
        const unsigned old = xb_add(&bar[XB_XSUB(b.x)], 1u);
        const unsigned gen = old / nloc;
        if (old + 1u == (gen + 1u) * nloc) {
            __builtin_amdgcn_fence(__ATOMIC_RELEASE, "agent");
            asm volatile("s_waitcnt vmcnt(0)" ::: "memory");
            const unsigned og = xb_add(&bar[XB_TOP], 1u);
            const unsigned tg = og / nx;
            if (og + 1u == (tg + 1u) * nx) xb_add(&bar[XB_TOPGEN], 1u);
            else XB_SPIN(xb_ld(&bar[XB_TOPGEN]) == tg, bar);
            __builtin_amdgcn_fence(__ATOMIC_ACQUIRE, "agent");
            xb_add(&bar[XB_XGEN(b.x)], 1u);
            asm volatile("s_waitcnt vmcnt(0)" ::: "memory");
        } else {
            XB_SPIN(xb_ld(&bar[XB_XGEN(b.x)]) == gen, bar);
            __builtin_amdgcn_fence(__ATOMIC_ACQUIRE, "agent");
            asm volatile("s_waitcnt vmcnt(0)" ::: "memory");
        }
    }
    __syncthreads();
}

namespace pg8 {
constexpr int BM = 256, BK = 64, HALF = 128, HTB = HALF * BK * 2, STAGE_BYTES = 8 * HTB, NXCD = 8, WGM = 8;
__device__ __forceinline__ int lds_byte(int r, int c) { const int st = (r >> 4) * 2 + (c >> 5), rr = r & 15, cc = c & 31, ob = rr * 64 + cc * 2; return st * 1024 + (ob ^ (((ob >> 9) & 1) << 5)); }
__device__ __forceinline__ void stage_rc(int b, int& R, int& C) { const int st = b / 1024, sb = b % 1024, swz = sb ^ (((sb >> 9) & 1) << 5); R = (st >> 1) * 16 + swz / 64; C = (st & 1) * 32 + (swz % 64) / 2; }
__device__ __forceinline__ int perm32(int rho) { const int n = rho >> 4, i = rho & 15; return 8 * (i >> 2) + 4 * n + (i & 3); }

struct Unit { const char* A; const char* B; int pm, pn, e, nv; };
typedef int v8i32 __attribute__((ext_vector_type(8)));
typedef int v4i32 __attribute__((ext_vector_type(4)));
__device__ __forceinline__ void mfma_fp8(f32x4& acc, v8i32 b, v8i32 a, int sc) {
    asm volatile("s_nop 1\n\tv_mfma_scale_f32_16x16x128_f8f6f4 %0, %1, %2, %0, %3, %3 op_sel_hi:[0,0,0]" : "+v"(acc) : "v"(b), "v"(a), "v"(sc)); }
__device__ __forceinline__ void mfma_fp8z(f32x4& acc, v8i32 b, v8i32 a, int sc) {
    asm volatile("s_nop 1\n\tv_mfma_scale_f32_16x16x128_f8f6f4 %0, %1, %2, 0, %3, %3 op_sel_hi:[0,0,0]" : "=&v"(acc) : "v"(b), "v"(a), "v"(sc)); }
__device__ __forceinline__ void mfma_bf16(f32x4& acc, bf16x8 b, bf16x8 a) { asm volatile("v_mfma_f32_16x16x32_bf16 %0, %1, %2, %0" : "+v"(acc) : "v"(b), "v"(a)); }
__device__ __forceinline__ void mfma_bf16z(f32x4& acc, bf16x8 b, bf16x8 a) { asm volatile("v_mfma_f32_16x16x32_bf16 %0, %1, %2, 0" : "=&v"(acc) : "v"(b), "v"(a)); }
__device__ __forceinline__ v8i32 cat8(bf16x8 a, bf16x8 b) { return __builtin_shufflevector(__builtin_bit_cast(v4i32, a), __builtin_bit_cast(v4i32, b), 0, 1, 2, 3, 4, 5, 6, 7); }

template <class E, class = void> struct epi_nvm { static constexpr int value = 0; };
template <class E> struct epi_nvm<E, decltype((void)E::NVM)> { static constexpr int value = E::NVM; };
template <bool FP8 = false, bool SP2 = true, bool GATHER = false, class Epi, class Sched>
__device__ __forceinline__ void gemm_phase(LAS unsigned char* lds, int tid, const int lda, const int ldb, const int K, const Sched& S, const Epi& E) {
    asm volatile("" : "+v"(tid));
    const int wid = __builtin_amdgcn_readfirstlane(tid >> 6), lane = tid & 63, wr = wid >> 2, wc = wid & 3, fr = lane & 15, fq = lane >> 4;
    int Kx = K; asm volatile("" : "+s"(Kx));
    const int nt = Kx / BK;
    unsigned voffA[2], voffB[2];
#pragma unroll
    for (int i = 0; i < 2; ++i) { int R, C; stage_rc(tid * 16 + i * 8192, R, C); const int Rb = (R & ~31) + perm32(R & 31);
        voffA[i] = (unsigned)(R * lda + C) * 2u; voffB[i] = (unsigned)(Rb * ldb + C) * 2u; }
    unsigned vc[2][2], vn[2][2];
    LAS unsigned* gslot = (LAS unsigned*)(lds + MISC_OFF) + MW_GIDX + wid * 64;
#define PG8_GIDX_ISSUE(U, buf) do { int lq_ = lane; asm volatile("" : "+v"(lq_)); const int h_ = lq_ >> 5, i_ = (lq_ >> 4) & 1, r_ = lq_ & 15; int row_ = h_ * 128 + (wid >> 1) * 16 + 64 * i_ + r_; row_ = row_ < (U).nv ? row_ : (U).nv - 1; \
        __builtin_amdgcn_global_load_lds((const unsigned*)(U).A + row_, gslot + (buf) * 512, 4, 0, 0); } while (0)
#define PG8_GIDX_READ(buf, V) do { int tq_ = tid; asm volatile("" : "+v"(tq_));     \
        _Pragma("unroll") for (int i_ = 0; i_ < 2; ++i_) { int R_, C_; stage_rc(tq_ * 16 + i_ * 8192, R_, C_); \
        _Pragma("unroll") for (int h_ = 0; h_ < 2; ++h_) (V)[h_][i_] = gslot[(buf) * 512 + h_ * 32 + i_ * 16 + (R_ & 15)] * 1024u + (unsigned)(C_ * 2); } } while (0)
    const size_t kstep = (size_t)(BK * 2);
    const size_t hstepA = (size_t)HALF * lda * 2, hstepB = (size_t)HALF * ldb * 2;
    const unsigned ldsw = (unsigned)wid * 1024u;
    int aoffk[2], boffk[2];
#pragma unroll
    for (int k = 0; k < 2; ++k) { aoffk[k] = FP8 ? lds_byte(wr * 64 + fr, 16 * fq + 8 * k) : lds_byte(wr * 64 + fr, fq * 8) + k * 1024;
                                  boffk[k] = FP8 ? lds_byte(wc * 32 + fr, 16 * fq + 8 * k) : lds_byte(wc * 32 + fr, fq * 8) + k * 1024; }
#define PG8_SA(b, h) (((b) * 2 + (h)) * HTB)
#define PG8_SB(b, h) ((4 + (b) * 2 + (h)) * HTB)
#define PG8_STAGE(bufoff, gbase, voff) do { _Pragma("unroll") for (int _i = 0; _i < 2; ++_i) \
        __builtin_amdgcn_global_load_lds((const unsigned*)((const char*)(gbase) + (voff)[_i]), (LAS unsigned*)(lds + (bufoff) + ldsw + _i * 8192), 16, 0, 0); } while (0)
#define PG8_STAGE_A(bufoff, abase, half, NX) do { if constexpr (GATHER) { if (NX) PG8_STAGE(bufoff, abase, vn[half]); else PG8_STAGE(bufoff, abase, vc[half]); } \
        else PG8_STAGE(bufoff, (abase) + (half) * hstepA, voffA); } while (0)
#define PG8_LDA(dst, b, h) do { _Pragma("unroll") for (int m = 0; m < 4; ++m) _Pragma("unroll") for (int k = 0; k < 2; ++k) dst[m][k] = *(const LAS bf16x8*)(lds + PG8_SA(b, h) + aoffk[k] + m * 2048); } while (0)
#define PG8_LDB(dst, b, h) do { _Pragma("unroll") for (int n = 0; n < 2; ++n) _Pragma("unroll") for (int k = 0; k < 2; ++k) dst[n][k] = *(const LAS bf16x8*)(lds + PG8_SB(b, h) + boffk[k] + n * 2048); } while (0)
#define PG8_MMA(ai, bj, At, Bt) do { __builtin_amdgcn_s_setprio(1); \
        if constexpr (FP8) { _Pragma("unroll") for (int m = 0; m < 4; ++m) _Pragma("unroll") for (int n = 0; n < 2; ++n) mfma_fp8(acc[ai][bj][m][n], cat8(Bt[n][0], Bt[n][1]), cat8(At[m][0], At[m][1]), sc8); } \
        else { _Pragma("unroll") for (int k = 0; k < 2; ++k) _Pragma("unroll") for (int m = 0; m < 4; ++m) _Pragma("unroll") for (int n = 0; n < 2; ++n) mfma_bf16(acc[ai][bj][m][n], Bt[n][k], At[m][k]); } \
        __builtin_amdgcn_s_setprio(0); } while (0)
#define PG8_MMA0(ai, bj, At, Bt) do { if (first_) { __builtin_amdgcn_s_setprio(1); \
        if constexpr (FP8) { _Pragma("unroll") for (int m = 0; m < 4; ++m) _Pragma("unroll") for (int n = 0; n < 2; ++n) mfma_fp8z(acc[ai][bj][m][n], cat8(Bt[n][0], Bt[n][1]), cat8(At[m][0], At[m][1]), sc8); } \
        else { _Pragma("unroll") for (int m = 0; m < 4; ++m) _Pragma("unroll") for (int n = 0; n < 2; ++n) mfma_bf16z(acc[ai][bj][m][n], Bt[n][0], At[m][0]); \
               _Pragma("unroll") for (int m = 0; m < 4; ++m) _Pragma("unroll") for (int n = 0; n < 2; ++n) mfma_bf16(acc[ai][bj][m][n], Bt[n][1], At[m][1]); } \
        __builtin_amdgcn_s_setprio(0); } else PG8_MMA(ai, bj, At, Bt); } while (0)
#define PG8_ZERO_ACC() do { _Pragma("unroll") for (int a = 0; a < 2; ++a) _Pragma("unroll") for (int b = 0; b < 2; ++b) _Pragma("unroll") for (int m = 0; m < 4; ++m) \
        _Pragma("unroll") for (int n = 0; n < 2; ++n) acc[a][b][m][n] = (f32x4){0.f, 0.f, 0.f, 0.f}; } while (0)
#define PG8_WAIT_V(n) asm volatile("s_waitcnt vmcnt(" #n ")" ::: "memory")
#define PG8_WAIT_L(n) asm volatile("s_waitcnt lgkmcnt(" #n ")" ::: "memory")
#define PG8_BAR __builtin_amdgcn_s_barrier()
#define PG8_SCHED __builtin_amdgcn_sched_barrier(0)
    Unit cur, nxt; int ui = 0;
    if (!S.next(0, cur)) return;
    f32x4 acc[2][2][4][2];
    bf16x8 At[4][2], B0[2][2], B1[2][2];
    int sc8 = 0x7F7F7F7F; if constexpr (FP8) asm volatile("" : "+v"(sc8));
    const char* cA = cur.A; const char* cB = cur.B;
    if constexpr (GATHER) { cA = S.X; PG8_GIDX_ISSUE(cur, 0); asm volatile("s_waitcnt vmcnt(0)" ::: "memory"); PG8_GIDX_READ(0, vc);
#pragma unroll
        for (int h_ = 0; h_ < 2; ++h_) { vn[h_][0] = vc[h_][0]; vn[h_][1] = vc[h_][1]; } }
    if constexpr (SP2) {
        PG8_STAGE(PG8_SB(0, 0), cB, voffB); PG8_STAGE(PG8_SB(0, 1), cB + hstepB, voffB); PG8_STAGE_A(PG8_SA(0, 0), cA, 0, false); PG8_STAGE_A(PG8_SA(0, 1), cA, 1, false);
        if (wr == 1) PG8_BAR;
        PG8_WAIT_V(2); PG8_BAR;
        PG8_STAGE(PG8_SB(1, 0), cB + kstep, voffB); PG8_STAGE_A(PG8_SA(1, 0), cA + kstep, 0, false); PG8_STAGE(PG8_SB(1, 1), cB + hstepB + kstep, voffB);
        PG8_WAIT_V(6); PG8_BAR;
    } else {
    PG8_STAGE(PG8_SB(0, 0), cB, voffB); PG8_STAGE(PG8_SA(0, 0), cA, voffA); PG8_STAGE(PG8_SB(0, 1), cB + hstepB, voffB); PG8_STAGE(PG8_SA(0, 1), cA + hstepA, voffA);
    if (wr == 1) PG8_BAR;
    PG8_WAIT_V(4); PG8_BAR;
    PG8_STAGE(PG8_SB(1, 0), cB + kstep, voffB); PG8_STAGE(PG8_SA(1, 0), cA + kstep, voffA); PG8_STAGE(PG8_SB(1, 1), cB + hstepB + kstep, voffB);
    PG8_WAIT_V(6); PG8_BAR;
    }
    for (;;) {
        const bool has_next = S.next(ui + 1, nxt);
        const char* nA = GATHER ? cA : (has_next ? nxt.A : cA); const char* nB = has_next ? nxt.B : cB;
        if constexpr (GATHER) { if (has_next) PG8_GIDX_ISSUE(nxt, (ui + 1) & 1); }
        for (int t = 0; t < nt; t += 2) {
            const bool last = (t == nt - 2), first_ = (t == 0), relax_ = first_ && ui > 0;
#define PG8_WAIT_V8R() do { if constexpr (epi_nvm<Epi>::value > 0) { if (relax_) asm volatile("s_waitcnt vmcnt(%0)" :: "n"(8 + epi_nvm<Epi>::value) : "memory"); else PG8_WAIT_V(8); } else PG8_WAIT_V(8); } while (0)
            if constexpr (GATHER) { if (last && has_next) PG8_GIDX_READ((ui + 1) & 1, vn); }
            const char* a1 = cA + (size_t)(t + 1) * kstep;
            const char* a2 = last ? nA : cA + (size_t)(t + 2) * kstep; const char* b2 = last ? nB : cB + (size_t)(t + 2) * kstep;
            const char* a3 = a2 + kstep; const char* b3 = b2 + kstep;
            if constexpr (SP2) {
            PG8_LDB(B0, 0, 0); PG8_LDB(B1, 0, 1); PG8_SCHED; PG8_LDA(At, 0, 0); PG8_STAGE_A(PG8_SA(1, 1), a1, 1, false);
            PG8_WAIT_V8R(); PG8_WAIT_L(0); PG8_BAR; PG8_MMA0(0, 0, At, B0); PG8_MMA0(0, 1, At, B1); PG8_BAR; PG8_SCHED;
            PG8_LDA(At, 0, 1); PG8_STAGE(PG8_SB(0, 0), b2, voffB); PG8_STAGE(PG8_SB(0, 1), b2 + hstepB, voffB); PG8_STAGE_A(PG8_SA(0, 0), a2, 0, last);
            PG8_WAIT_V8R(); PG8_WAIT_L(0); PG8_BAR; PG8_MMA0(1, 0, At, B0); PG8_MMA0(1, 1, At, B1); PG8_BAR; PG8_SCHED;
            PG8_LDB(B0, 1, 0); PG8_LDB(B1, 1, 1); PG8_SCHED; PG8_LDA(At, 1, 0); PG8_STAGE_A(PG8_SA(0, 1), a2, 1, last);
            PG8_WAIT_V8R(); PG8_WAIT_L(0); PG8_BAR; PG8_MMA(0, 0, At, B0); PG8_MMA(0, 1, At, B1); PG8_BAR; PG8_SCHED;
            PG8_LDA(At, 1, 1); PG8_STAGE(PG8_SB(1, 0), b3, voffB); PG8_STAGE(PG8_SB(1, 1), b3 + hstepB, voffB); PG8_STAGE_A(PG8_SA(1, 0), a3, 0, last);
            PG8_WAIT_V(8); PG8_WAIT_L(0); PG8_BAR; PG8_MMA(1, 0, At, B0); PG8_MMA(1, 1, At, B1); PG8_BAR; PG8_SCHED;
            } else {
            PG8_LDB(B0, 0, 0); PG8_SCHED; PG8_LDA(At, 0, 0); PG8_STAGE(PG8_SA(1, 1), a1 + hstepA, voffA);
            PG8_WAIT_L(8); PG8_BAR; PG8_WAIT_L(0); PG8_MMA(0, 0, At, B0); PG8_BAR; PG8_SCHED;
            PG8_LDB(B1, 0, 1); PG8_STAGE(PG8_SB(0, 0), b2, voffB);
            PG8_BAR; PG8_WAIT_L(0); PG8_MMA(0, 1, At, B1); PG8_BAR;
            PG8_LDA(At, 0, 1); PG8_STAGE(PG8_SA(0, 0), a2, voffA);
            PG8_BAR; PG8_WAIT_L(0); PG8_MMA(1, 0, At, B0); PG8_BAR; PG8_SCHED;
            PG8_STAGE(PG8_SB(0, 1), b2 + hstepB, voffB);
            PG8_WAIT_V(6); PG8_BAR; PG8_MMA(1, 1, At, B1); PG8_BAR;
            PG8_LDB(B0, 1, 0); PG8_SCHED; PG8_LDA(At, 1, 0); PG8_STAGE(PG8_SA(0, 1), a2 + hstepA, voffA);
            PG8_WAIT_L(8); PG8_BAR; PG8_WAIT_L(0); PG8_MMA(0, 0, At, B0); PG8_BAR; PG8_SCHED;
            PG8_LDB(B1, 1, 1); PG8_STAGE(PG8_SB(1, 0), b3, voffB);
            PG8_BAR; PG8_WAIT_L(0); PG8_MMA(0, 1, At, B1); PG8_BAR;
            PG8_LDA(At, 1, 1); PG8_STAGE(PG8_SA(1, 0), a3, voffA);
            PG8_BAR; PG8_WAIT_L(0); PG8_MMA(1, 0, At, B0); PG8_BAR; PG8_SCHED;
            PG8_STAGE(PG8_SB(1, 1), b3 + hstepB, voffB);
            PG8_WAIT_V(6); PG8_BAR; PG8_MMA(1, 1, At, B1); PG8_BAR;
            }
        }
        asm volatile("s_nop 15\n\ts_nop 15" ::: "memory");
        E(acc, cur, wr, wc, fr, fq);
        if (!has_next) break;
        cur = nxt; cA = nA; cB = nB; ++ui;
        if constexpr (GATHER) {
#pragma unroll
            for (int h_ = 0; h_ < 2; ++h_) { vc[h_][0] = vn[h_][0]; vc[h_][1] = vn[h_][1]; } }
    }
    PG8_WAIT_V(0);
    if (wr == 0) PG8_BAR;
    PG8_BAR;
#undef PG8_SA
#undef PG8_SB
#undef PG8_STAGE
#undef PG8_LDA
#undef PG8_STAGE_A
#undef PG8_GIDX_ISSUE
#undef PG8_GIDX_READ
#undef PG8_LDB
#undef PG8_MMA
#undef PG8_WAIT_V
#undef PG8_WAIT_L
#undef PG8_BAR
#undef PG8_SCHED
}
}
using pg8::Unit;
typedef f32x4 Acc[2][2][4][2];

#define EPI_OPAQUE() int fr_ = fr, fq_ = fq; asm volatile("" : "+v"(fr_), "+v"(fq_))
#define EPI_BEGIN _Pragma("unroll") for (int ai = 0; ai < 2; ++ai) _Pragma("unroll") for (int m = 0; m < 4; ++m) { EPI_OPAQUE(); const int row = ai * 128 + wr * 64 + m * 16 + fr_; \
    _Pragma("unroll") for (int bj = 0; bj < 2; ++bj) { const int col = bj * 128 + wc * 32 + fq_ * 8; f32x4 v0 = acc[ai][bj][m][0], v1 = acc[ai][bj][m][1];
#define EPI_END } }

struct Params {
    const float* in[26];
    float* out;
    unsigned char* ws;
};
typedef const __attribute__((address_space(4))) Params* KPtr;

struct DenseSched {
    const char* A; const char* B; size_t tA, tB; int nM, nN, nwg, G, c;
    __device__ __forceinline__ void init(const void* A_, const void* B_, int M, int N, int lda, int ldb, int G_, int c_) {
        A = (const char*)A_; B = (const char*)B_; tA = (size_t)256 * lda * 2; tB = (size_t)256 * ldb * 2; nM = M / 256; nN = N / 256; nwg = nM * nN; G = G_; c = c_; }
    __device__ __forceinline__ bool next(int i, Unit& u) const {
        const long L = (long)i * G + c; if (L >= nwg) return false;
        int wgid = (int)L; { const int q = nwg / 8, r = nwg % 8, xcd = wgid % 8, off = wgid / 8; wgid = (xcd < r ? xcd * (q + 1) : r * (q + 1) + (xcd - r) * q) + off; }
        const int nig = 8 * nN, gid = wgid / nig, fm = gid * 8, gsz = (nM - fm) < 8 ? (nM - fm) : 8;
        u.pm = fm + ((wgid % nig) % gsz); u.pn = (wgid % nig) / gsz; u.e = 0;
        u.A = A + (size_t)u.pm * tA; u.B = B + (size_t)u.pn * tB; return true;
    }
};
struct SchedG2 {
    const char* Q; const char* K; int G, c;
    __device__ __forceinline__ bool next(int i, Unit& u) const {
        const int L = i * G + c; if (L >= 512) return false;
        const int bh = L >> 5, n = L & 31, b = bh >> 2, h = bh & 3, t0 = b * 8192 + n * 256;
        const size_t off = ((size_t)t0 * 1024 + h * 256) * 2;
        u.A = Q + ((size_t)t0 * 2048 + h * 512 + 256) * 2; u.B = K + off; u.pm = t0 >> 8; u.pn = h; u.e = L; return true;
    }
};
struct SchedG3 {
    const char* VS; const char* KDT; int G, c;
    __device__ __forceinline__ bool next(int i, Unit& u) const {
        const int L = i * G + c; if (L >= 1024) return false;
        const int cidx = L >> 1, half = L & 1;
        u.A = VS + (size_t)cidx * 524288 + (size_t)half * 262144; u.B = KDT + (size_t)cidx * 131072; u.pm = half; u.pn = 0; u.e = cidx; return true;
    }
};
struct SchedG4 {
    const char* ACAT; const char* VS; int G, c;
    __device__ __forceinline__ bool next(int i, Unit& u) const {
        const int L = i * G + c; if (L >= 1024) return false;
        const int cidx = L >> 1, half = L & 1, bh = cidx >> 5, n = cidx & 31, b = bh >> 2, h = bh & 3, t0 = b * 8192 + n * 256;
        u.A = ACAT + ((size_t)t0 * 2048 + h * 512) * 2; u.B = VS + (size_t)cidx * 524288 + (size_t)half * 262144; u.pm = t0 >> 8; u.pn = h * 2 + half; u.e = cidx; return true;
    }
};
struct MoeSched {
    const char* A; const char* W; size_t wstride; int NT, G, c; volatile LAS unsigned* misc; const char* X; const int* TOKL;
    __device__ __forceinline__ bool next(int i, Unit& u) const {
        const int L = i * G + c; const int nrb = __builtin_amdgcn_readfirstlane((int)misc[MW_NRB]); if (L >= nrb * NT) return false;
        const int rb = L / NT, pn = L - rb * NT; const int e = __builtin_amdgcn_readfirstlane((int)((volatile LAS unsigned char*)(misc + MW_RBEXP))[rb]);
        u.B = W + (size_t)e * wstride + (size_t)pn * (256 * 1024); u.pm = rb; u.pn = pn; u.e = e;
        if (TOKL) { const int j0 = rb * 256 - __builtin_amdgcn_readfirstlane((int)misc[MW_PSTART + e]); u.A = (const char*)(TOKL + (size_t)e * T + j0); u.nv = __builtin_amdgcn_readfirstlane((int)misc[MW_CNT + e]) - j0; }
        else { u.A = A + (size_t)rb * (256 * 1024); u.nv = 256; }
        return true;
    }
};

__device__ __forceinline__ float log2gamma(int h) { return __log2f(1.0f - __builtin_amdgcn_exp2f(-5.0f - (float)h)); }
__device__ __forceinline__ void rope8(f32x4& v0, f32x4& v1, const f32x4 c, const f32x4 s) {
    f32x4 a, b;
    a[0] = v0[0] * c[0] - v0[1] * s[0]; a[1] = v0[0] * s[0] + v0[1] * c[0];
    a[2] = v0[2] * c[1] - v0[3] * s[1]; a[3] = v0[2] * s[1] + v0[3] * c[1];
    b[0] = v1[0] * c[2] - v1[1] * s[2]; b[1] = v1[0] * s[2] + v1[1] * c[2];
    b[2] = v1[2] * c[3] - v1[3] * s[3]; b[3] = v1[2] * s[3] + v1[3] * c[3];
    v0 = a; v1 = b;
}
struct EpiRetA {
    static constexpr int NVM = 16;
    bf16_t* QB; bf16_t* ACAT; bf16_t* GB; bf16_t* KB; const float* COSR; const float* SINR; bf16_t* KDT;
    __device__ __forceinline__ void operator()(const Acc& acc, const Unit& u, int wr, int wc, int fr, int fq) const {
        const int pn = u.pn, t0 = u.pm * 256;
        if (pn < 4 || pn >= 12) {
            const int head = pn < 4 ? pn : pn - 12; const float l2g = log2gamma(head);
            EPI_OPAQUE();
            const int rbase = wr * 64 + fr_, cb = wc * 32 + fq_ * 8;
            f32x4 cc[2], ss[2], cn[2], sn[2];
#define ROPE_LD(it, C_, S_) do { const size_t o_ = (size_t)(t0 + rbase + ((it) >> 2) * 128 + ((it) & 3) * 16) * 128 + (cb >> 1); \
                C_[0] = *(const f32x4*)(COSR + o_); C_[1] = *(const f32x4*)(COSR + o_ + 64); S_[0] = *(const f32x4*)(SINR + o_); S_[1] = *(const f32x4*)(SINR + o_ + 64); } while (0)
            if (pn < 4) {
            ROPE_LD(0, cc, ss);
#pragma unroll
            for (int it = 0; it < 8; ++it) { const int ai = it >> 2, m = it & 3, row = ai * 128 + m * 16 + rbase, t = t0 + row;
                if (it < 7) ROPE_LD(it + 1, cn, sn);
#pragma unroll
                for (int bj = 0; bj < 2; ++bj) { const int col = bj * 128 + cb; f32x4 v0 = acc[ai][bj][m][0], v1 = acc[ai][bj][m][1];
                    rope8(v0, v1, cc[bj], ss[bj]);
                    if (true) {
                        const float f = __builtin_amdgcn_exp2f(l2g * (float)(row + 1));
                        *(u32x4*)(ACAT + (size_t)t * 2048 + head * 512 + 256 + col) = pack8(v0 * f, v1 * f);
                    } else {
                        v0 = v0 * 0.0625f; v1 = v1 * 0.0625f;
                        *(u32x4*)(KB + (size_t)t * 1024 + head * 256 + col) = pack8(v0, v1);
                        const float fd = __builtin_amdgcn_exp2f(l2g * (float)(255 - row));
                        float xk[8] = {v0[0] * fd, v0[1] * fd, v0[2] * fd, v0[3] * fd, v1[0] * fd, v1[1] * fd, v1[2] * fd, v1[3] * fd};
                        xpose8(xk, fr_);
                        bf16_t* kd = KDT + ((size_t)(((t0 >> 13) * 4 + head) * 32 + ((t0 >> 8) & 31))) * 65536 + (size_t)(col + (fr_ & 7)) * 256 + (row & ~7);
                        u32x4 w; w.x = cvt_pk_bf16(xk[0], xk[1]); w.y = cvt_pk_bf16(xk[2], xk[3]); w.z = cvt_pk_bf16(xk[4], xk[5]); w.w = cvt_pk_bf16(xk[6], xk[7]);
                        *(u32x4*)kd = w;
                    } }
                cc[0] = cn[0]; cc[1] = cn[1]; ss[0] = sn[0]; ss[1] = sn[1]; }
            } else {
            ROPE_LD(0, cc, ss);
#pragma unroll
            for (int it = 0; it < 8; ++it) { const int ai = it >> 2, m = it & 3, row = ai * 128 + m * 16 + rbase, t = t0 + row;
                if (it < 7) ROPE_LD(it + 1, cn, sn);
#pragma unroll
                for (int bj = 0; bj < 2; ++bj) { const int col = bj * 128 + cb; f32x4 v0 = acc[ai][bj][m][0], v1 = acc[ai][bj][m][1];
                    rope8(v0, v1, cc[bj], ss[bj]);
                    if (false) {
                        const float f = __builtin_amdgcn_exp2f(l2g * (float)(row + 1));
                        *(u32x4*)(ACAT + (size_t)t * 2048 + head * 512 + 256 + col) = pack8(v0 * f, v1 * f);
                    } else {
                        v0 = v0 * 0.0625f; v1 = v1 * 0.0625f;
                        *(u32x4*)(KB + (size_t)t * 1024 + head * 256 + col) = pack8(v0, v1);
                        const float fd = __builtin_amdgcn_exp2f(l2g * (float)(255 - row));
                        float xk[8] = {v0[0] * fd, v0[1] * fd, v0[2] * fd, v0[3] * fd, v1[0] * fd, v1[1] * fd, v1[2] * fd, v1[3] * fd};
                        xpose8(xk, fr_);
                        bf16_t* kd = KDT + ((size_t)(((t0 >> 13) * 4 + head) * 32 + ((t0 >> 8) & 31))) * 65536 + (size_t)(col + (fr_ & 7)) * 256 + (row & ~7);
                        u32x4 w; w.x = cvt_pk_bf16(xk[0], xk[1]); w.y = cvt_pk_bf16(xk[2], xk[3]); w.z = cvt_pk_bf16(xk[4], xk[5]); w.w = cvt_pk_bf16(xk[6], xk[7]);
                        *(u32x4*)kd = w;
                    } }
                cc[0] = cn[0]; cc[1] = cn[1]; ss[0] = sn[0]; ss[1] = sn[1]; }
            }
#undef ROPE_LD
        } else {
            EPI_BEGIN
                const int t = t0 + row;
                *(u32x4*)(GB + (size_t)t * 2048 + (pn - 4) * 256 + col) = pack8(v0, v1);
            EPI_END
        }
    }
};
struct EpiRetB {
    static constexpr int NVM = 16;
    bf16_t* VS; float asc = 1.0f;
    __device__ __forceinline__ void operator()(const Acc& acc, const Unit& u, int wr, int wc, int fr, int fq) const {
        const int pm = u.pm, b = u.pn >> 5, n = u.pn & 31, hh = pm >> 1, dvb = (pm & 1) * 256;
        EPI_BEGIN
            *(u32x4*)(VS + ((size_t)((b * 4 + hh) * 32 + n)) * 262144 + (size_t)(dvb + row) * 512 + col) = pack8(v0 * asc, v1 * asc);
        EPI_END
    }
};
struct EpiRetP {
    static constexpr int NVM = 16;
    bf16_t* ACAT;
    __device__ __forceinline__ void operator()(const Acc& acc, const Unit& u, int wr, int wc, int fr, int fq) const {
        const int t0 = u.pm * 256, h = u.pn; const float l2g = -log2gamma(h);
        f32x4 cf[2][2];
        { int fq1 = fq; asm volatile("" : "+v"(fq1));
#pragma unroll
          for (int bj = 0; bj < 2; ++bj)
#pragma unroll
              for (int j = 0; j < 4; ++j) { const int c0 = bj * 128 + wc * 32 + fq1 * 8 + j; cf[bj][0][j] = __builtin_amdgcn_exp2f(l2g * (float)(c0 + 1)); cf[bj][1][j] = __builtin_amdgcn_exp2f(l2g * (float)(c0 + 5)); } }
        EPI_BEGIN
            v0 = v0 * cf[bj][0]; v1 = v1 * cf[bj][1];
#pragma unroll
            for (int j = 0; j < 4; ++j) { const int d0 = row - (col + j), d1 = row - (col + 4 + j); v0[j] = d0 >= 0 ? v0[j] : 0.f; v1[j] = d1 >= 0 ? v1[j] : 0.f; }
            *(u32x4*)(ACAT + (size_t)(t0 + row) * 2048 + h * 512 + col) = pack8(v0, v1);
        EPI_END
    }
};
struct EpiRetU {
    static constexpr int NVM = 16;
    bf16_t* VS;
    __device__ __forceinline__ void operator()(const Acc& acc, const Unit& u, int wr, int wc, int fr, int fq) const {
        bf16_t* base = VS + (size_t)u.e * 262144 + (size_t)(u.pm * 256) * 512 + 256;
        EPI_BEGIN
            *(u32x4*)(base + (size_t)row * 512 + col) = pack8(v0, v1);
        EPI_END
    }
};
struct EpiBf16 {
    static constexpr int NVM = 16;
    bf16_t* O; int ldc; float asc = 1.0f;
    __device__ __forceinline__ void operator()(const Acc& acc, const Unit& u, int wr, int wc, int fr, int fq) const {
        bf16_t* base = O + (size_t)(u.pm * 256) * ldc + u.pn * 256;
        EPI_BEGIN
            *(u32x4*)(base + (size_t)row * ldc + col) = pack8(v0 * asc, v1 * asc);
        EPI_END
    }
};
struct EpiF32 {
    float* O; int ldc;
    __device__ __forceinline__ void operator()(const Acc& acc, const Unit& u, int wr, int wc, int fr, int fq) const {
        float* base = O + (size_t)(u.pm * 256) * ldc + u.pn * 256;
        EPI_BEGIN
            *(f32x4*)(base + (size_t)row * ldc + col) = v0; *(f32x4*)(base + (size_t)row * ldc + col + 4) = v1;
        EPI_END
    }
};
struct EpiKVA {
    bf16_t* CKV; float* SSQ; bf16_t* KBUF; const float* COSM; const float* SINM; float asc;
    __device__ __forceinline__ void operator()(const Acc& acc, const Unit& u, int wr, int wc, int fr, int fq) const {
        const int t0 = u.pm * 256;
        if (u.pn == 0) {
#pragma unroll
            for (int ai = 0; ai < 2; ++ai)
#pragma unroll
                for (int m = 0; m < 4; ++m) { EPI_OPAQUE(); const int t = t0 + ai * 128 + wr * 64 + m * 16 + fr_; float ss = 0.f;
#pragma unroll
                    for (int bj = 0; bj < 2; ++bj) { const int col = bj * 128 + wc * 32 + fq_ * 8; const f32x4 v0 = acc[ai][bj][m][0] * asc, v1 = acc[ai][bj][m][1] * asc;
                        ss += (v0[0] * v0[0] + v0[1] * v0[1]) + (v0[2] * v0[2] + v0[3] * v0[3]) + (v1[0] * v1[0] + v1[1] * v1[1]) + (v1[2] * v1[2] + v1[3] * v1[3]);
                        *(u32x4*)(CKV + (size_t)t * 256 + col) = pack8(v0, v1); }
                    ss += __shfl_xor(ss, 16); ss += __shfl_xor(ss, 32);
                    if (fq_ == 0) SSQ[(size_t)t * 4 + wc] = ss; }
        } else {
            if (wc < 2) {
#pragma unroll
                for (int ai = 0; ai < 2; ++ai)
#pragma unroll
                    for (int m = 0; m < 4; ++m) { EPI_OPAQUE(); const int t = t0 + ai * 128 + wr * 64 + m * 16 + fr_; const int col = wc * 32 + fq_ * 8;
                        f32x4 v0 = acc[ai][0][m][0] * asc, v1 = acc[ai][0][m][1] * asc;
                        const f32x4 c4 = *(const f32x4*)(COSM + (size_t)t * 32 + (col >> 1)), s4 = *(const f32x4*)(SINM + (size_t)t * 32 + (col >> 1));
                        rope8(v0, v1, c4, s4);
#if ATT_FP8
                        u32x2 w8; w8.x = cvt4_fp8(v0[0], v0[1], v0[2], v0[3]); w8.y = cvt4_fp8(v1[0], v1[1], v1[2], v1[3]);
#pragma unroll
                        for (int h = 0; h < 8; ++h) *(u32x2*)((unsigned char*)KBUF + (size_t)t * 1536 + h * 192 + 128 + col) = w8; }
#else
                        const u32x4 w = pack8(v0, v1);
#pragma unroll
                        for (int h = 0; h < 8; ++h) *(u32x4*)(KBUF + (size_t)t * 1536 + h * 192 + 128 + col) = w; }
#endif
            }
        }
    }
};
struct EpiKVB {
    bf16_t* KBUF; bf16_t* VBUF; const float* SSQ;
    __device__ __forceinline__ void operator()(const Acc& acc, const Unit& u, int wr, int wc, int fr, int fq) const {
        const int t0 = u.pm * 256, head = u.pn;
        EPI_OPAQUE(); const int rbase = t0 + wr * 64 + fr_, c = wc * 32 + fq_ * 8;
        f32x4 sq[8];
#pragma unroll
        for (int it = 0; it < 8; ++it) sq[it] = *(const f32x4*)(SSQ + (size_t)(rbase + (it >> 2) * 128 + (it & 3) * 16) * 4);
#pragma unroll
        for (int it = 0; it < 8; ++it) { const int ai = it >> 2, m = it & 3, t = rbase + ai * 128 + m * 16;
            const float rstd = rsqrtf(((sq[it][0] + sq[it][1]) + (sq[it][2] + sq[it][3])) * (1.0f / 256.0f) + RMS_EPS);
#if ATT_FP8
            { const f32x4 k0 = acc[ai][0][m][0] * rstd, k1 = acc[ai][0][m][1] * rstd; u32x2 w8; w8.x = cvt4_fp8(k0[0], k0[1], k0[2], k0[3]); w8.y = cvt4_fp8(k1[0], k1[1], k1[2], k1[3]);
              *(u32x2*)((unsigned char*)KBUF + (size_t)t * 1536 + head * 192 + c) = w8;
              const int sq_ = t & 8191, kk = sq_ & 63, k5 = kk & 31, pos = (((k5 >> 2) & 1) << 5) + (k5 & 3) + 4 * (k5 >> 3) + 16 * (kk >> 5);
              unsigned char* vp = (unsigned char*)VBUF + ((size_t)(((t >> 13) * 8 + head) * 128 + (sq_ >> 6)) * 128 + c) * 64 + pos;
              const float vs_ = rstd * ATT_VS; const f32x4 v0 = acc[ai][1][m][0] * vs_, v1 = acc[ai][1][m][1] * vs_;
              const unsigned wa = cvt4_fp8(v0[0], v0[1], v0[2], v0[3]), wb = cvt4_fp8(v1[0], v1[1], v1[2], v1[3]);
              vp[0 * 64] = (unsigned char)(wa); vp[1 * 64] = (unsigned char)(wa >> 8); vp[2 * 64] = (unsigned char)(wa >> 16); vp[3 * 64] = (unsigned char)(wa >> 24);
              vp[4 * 64] = (unsigned char)(wb); vp[5 * 64] = (unsigned char)(wb >> 8); vp[6 * 64] = (unsigned char)(wb >> 16); vp[7 * 64] = (unsigned char)(wb >> 24); } }
#else
            *(u32x4*)(KBUF + (size_t)t * 1536 + head * 192 + c) = pack8(acc[ai][0][m][0] * rstd, acc[ai][0][m][1] * rstd);
            *(u32x4*)(VBUF + (size_t)t * 1024 + head * 128 + c) = pack8(acc[ai][1][m][0] * rstd, acc[ai][1][m][1] * rstd); }
#endif
    }
};
struct EpiQA {
    bf16_t* QLAT; float* SSQ2; float asc;
    __device__ __forceinline__ void operator()(const Acc& acc, const Unit& u, int wr, int wc, int fr, int fq) const {
        const int t0 = u.pm * 256;
#pragma unroll
        for (int ai = 0; ai < 2; ++ai)
#pragma unroll
            for (int m = 0; m < 4; ++m) { EPI_OPAQUE(); const int t = t0 + ai * 128 + wr * 64 + m * 16 + fr_; float ss = 0.f;
#pragma unroll
                for (int bj = 0; bj < 2; ++bj) { const int col = bj * 128 + wc * 32 + fq_ * 8; const f32x4 v0 = acc[ai][bj][m][0] * asc, v1 = acc[ai][bj][m][1] * asc;
                    ss += (v0[0] * v0[0] + v0[1] * v0[1]) + (v0[2] * v0[2] + v0[3] * v0[3]) + (v1[0] * v1[0] + v1[1] * v1[1]) + (v1[2] * v1[2] + v1[3] * v1[3]);
                    *(u32x4*)(QLAT + (size_t)t * 256 + col) = pack8(v0, v1); }
                ss += __shfl_xor(ss, 16); ss += __shfl_xor(ss, 32);
                if (fq_ == 0) SSQ2[(size_t)t * 4 + wc] = ss; }
    }
};
struct EpiQB {
    bf16_t* QBUF; const float* SSQ2; const float* COSM; const float* SINM;
    __device__ __forceinline__ void operator()(const Acc& acc, const Unit& u, int wr, int wc, int fr, int fq) const {
        const int t0 = u.pm * 256, pn = u.pn;
        EPI_OPAQUE(); const int rbase = t0 + wr * 64 + fr_, cb = wc * 32 + fq_ * 8;
        float scv[8];
        { f32x4 sq[8];
#pragma unroll
          for (int it = 0; it < 8; ++it) sq[it] = *(const f32x4*)(SSQ2 + (size_t)(rbase + (it >> 2) * 128 + (it & 3) * 16) * 4);
#pragma unroll
          for (int it = 0; it < 8; ++it) scv[it] = rsqrtf(((sq[it][0] + sq[it][1]) + (sq[it][2] + sq[it][3])) * (1.0f / 256.0f) + RMS_EPS) * 0.10411767f; }
        if (pn < 4) {
#pragma unroll
            for (int it = 0; it < 8; ++it) { const int ai = it >> 2, m = it & 3, t = rbase + ai * 128 + m * 16;
                const float sc = scv[it];
#pragma unroll
#if ATT_FP8
                for (int bj = 0; bj < 2; ++bj) { const f32x4 a0 = acc[ai][bj][m][0] * (sc * ATT_QS), a1 = acc[ai][bj][m][1] * (sc * ATT_QS); u32x2 w8; w8.x = cvt4_fp8(a0[0], a0[1], a0[2], a0[3]); w8.y = cvt4_fp8(a1[0], a1[1], a1[2], a1[3]);
                    *(u32x2*)((unsigned char*)QBUF + (size_t)t * 1536 + (2 * pn + bj) * 192 + cb) = w8; } }
#else
                for (int bj = 0; bj < 2; ++bj) *(u32x4*)(QBUF + (size_t)t * 1536 + (2 * pn + bj) * 192 + cb) = pack8(acc[ai][bj][m][0] * sc, acc[ai][bj][m][1] * sc); }
#endif
        } else {
            f32x4 cc[2], ss[2], cn[2], sn[2];
#define QROPE_LD(it, C_, S_) do { const size_t o_ = (size_t)(rbase + ((it) >> 2) * 128 + ((it) & 3) * 16) * 32 + ((cb & 63) >> 1); \
                C_[0] = *(const f32x4*)(COSM + o_); S_[0] = *(const f32x4*)(SINM + o_); C_[1] = C_[0]; S_[1] = S_[0]; } while (0)
            QROPE_LD(0, cc, ss);
#pragma unroll
            for (int it = 0; it < 8; ++it) { const int ai = it >> 2, m = it & 3, t = rbase + ai * 128 + m * 16;
                if (it < 7) QROPE_LD(it + 1, cn, sn);
                const float sc = scv[it];
#pragma unroll
                for (int bj = 0; bj < 2; ++bj) { const int col = bj * 128 + cb, head = 4 * (pn - 4) + (col >> 6), rr = col & 63;
                    f32x4 v0 = acc[ai][bj][m][0] * sc, v1 = acc[ai][bj][m][1] * sc;
                    rope8(v0, v1, cc[bj], ss[bj]);
#if ATT_FP8
                    { u32x2 w8; w8.x = cvt4_fp8(v0[0] * ATT_QS, v0[1] * ATT_QS, v0[2] * ATT_QS, v0[3] * ATT_QS); w8.y = cvt4_fp8(v1[0] * ATT_QS, v1[1] * ATT_QS, v1[2] * ATT_QS, v1[3] * ATT_QS);
                      *(u32x2*)((unsigned char*)QBUF + (size_t)t * 1536 + head * 192 + 128 + rr) = w8; } }
#else
                    *(u32x4*)(QBUF + (size_t)t * 1536 + head * 192 + 128 + rr) = pack8(v0, v1); }
#endif
                cc[0] = cn[0]; cc[1] = cn[1]; ss[0] = sn[0]; ss[1] = sn[1]; }
#undef QROPE_LD
        }
    }
};
__device__ __forceinline__ void st_pair8(unsigned char* p, size_t rs, int fq, u32x2 a, u32x2 b) {
    const auto x = __builtin_amdgcn_permlane16_swap(a.x, b.x, false, false), y = __builtin_amdgcn_permlane16_swap(a.y, b.y, false, false);
    const u32x4 o = {x[0], y[0], x[1], y[1]};
    unsigned char* q = (fq & 1) ? p + rs - 8 : p;
    *(u32x4*)q = o;
}
__device__ __forceinline__ f32x2 swiglu2(f32x2 ag, f32x2 au, f32x2 bg, f32x2 bu) {
    constexpr float ws_ = 1.0f / WGU_SCALE, ka = -SWIGLU_ALPHA * 1.4426950408889634f;
    f32x2 g = __builtin_elementwise_fma(ag, (f32x2){ws_, ws_}, bg), u = __builtin_elementwise_fma(au, (f32x2){ws_, ws_}, bu);
    g[0] = __builtin_amdgcn_fmed3f(g[0], -24.0f, SWIGLU_LIMIT); g[1] = __builtin_amdgcn_fmed3f(g[1], -24.0f, SWIGLU_LIMIT);
    u[0] = __builtin_amdgcn_fmed3f(u[0], -SWIGLU_LIMIT, SWIGLU_LIMIT); u[1] = __builtin_amdgcn_fmed3f(u[1], -SWIGLU_LIMIT, SWIGLU_LIMIT);
    const f32x2 t = g * (f32x2){ka, ka};
    f32x2 e = {__builtin_amdgcn_exp2f(t[0]), __builtin_amdgcn_exp2f(t[1])}; e = e + (f32x2){1.0f, 1.0f};
    const float rp = __builtin_amdgcn_rcpf(e[0] * e[1]);
    const f32x2 sg = (f32x2){e[1], e[0]} * (f32x2){rp, rp};
    const f32x2 w = __builtin_elementwise_fma(u, (f32x2){ACT_SCALE, ACT_SCALE}, (f32x2){ACT_SCALE, ACT_SCALE});
    return (g * sg) * w;
}
struct EpiGU {
    static constexpr int NVM = 8;
    unsigned char* ACT; const float* bias;
    __device__ __forceinline__ void operator()(const Acc& acc, const Unit& u, int wr, int wc, int fr, int fq) const {
        int fq0 = fq; asm volatile("" : "+v"(fq0));
        const int c = u.pn * 128 + wc * 32 + fq0 * 8; const float* bg = bias + (size_t)u.e * 2048 + c;
        const f32x4 bg0 = *(const f32x4*)bg, bg1 = *(const f32x4*)(bg + 4), bu0 = *(const f32x4*)(bg + 1024), bu1 = *(const f32x4*)(bg + 1028);
#define LO2(v) __builtin_shufflevector(v, v, 0, 1)
#define HI2(v) __builtin_shufflevector(v, v, 2, 3)
#pragma unroll
        for (int ai = 0; ai < 2; ++ai)
#pragma unroll
            for (int mp = 0; mp < 2; ++mp) { EPI_OPAQUE(); const int slot = u.pm * 256 + ai * 128 + wr * 64 + mp * 32 + fr_; u32x2 w[2];
#pragma unroll
                for (int mm = 0; mm < 2; ++mm) { const int m = 2 * mp + mm;
                    const f32x4 ag0 = acc[ai][0][m][0], ag1 = acc[ai][0][m][1], au0 = acc[ai][1][m][0], au1 = acc[ai][1][m][1];
                    const f32x2 r0 = swiglu2(LO2(ag0), LO2(au0), LO2(bg0), LO2(bu0)), r1 = swiglu2(HI2(ag0), HI2(au0), HI2(bg0), HI2(bu0));
                    const f32x2 r2 = swiglu2(LO2(ag1), LO2(au1), LO2(bg1), LO2(bu1)), r3 = swiglu2(HI2(ag1), HI2(au1), HI2(bg1), HI2(bu1));
                    w[mm].x = cvt4_fp8(r0[0], r0[1], r1[0], r1[1]); w[mm].y = cvt4_fp8(r2[0], r2[1], r3[0], r3[1]); }
                st_pair8(ACT + (size_t)slot * 1024 + u.pn * 128 + wc * 32 + fq_ * 8, (size_t)16 * 1024, fq_, w[0], w[1]); }
#undef LO2
#undef HI2
    }
};
struct EpiDN {
    static constexpr int NVM = 12;
    unsigned char* YS; const float* bias;
    __device__ __forceinline__ void operator()(const Acc& acc, const Unit& u, int wr, int wc, int fr, int fq) const {
        int fq0 = fq; asm volatile("" : "+v"(fq0));
        const float* be = bias + (size_t)u.e * 1024 + u.pn * 256 + wc * 32 + fq0 * 8;
        f32x4 bb[2][2];
#pragma unroll
        for (int bj = 0; bj < 2; ++bj) { bb[bj][0] = *(const f32x4*)(be + bj * 128) * YS_SCALE; bb[bj][1] = *(const f32x4*)(be + bj * 128 + 4) * YS_SCALE; }
        constexpr float ws_ = YS_SCALE / (WDN_SCALE * ACT_SCALE);
#pragma unroll
        for (int ai = 0; ai < 2; ++ai)
#pragma unroll
            for (int mp = 0; mp < 2; ++mp) { EPI_OPAQUE(); const int row = ai * 128 + wr * 64 + mp * 32 + fr_;
#pragma unroll
                for (int bj = 0; bj < 2; ++bj) { u32x2 w[2];
#pragma unroll
                    for (int mm = 0; mm < 2; ++mm) { const int m = 2 * mp + mm; const f32x4 r0 = acc[ai][bj][m][0] * ws_ + bb[bj][0], r1 = acc[ai][bj][m][1] * ws_ + bb[bj][1];
                        w[mm].x = cvt4_fp8(r0[0], r0[1], r0[2], r0[3]); w[mm].y = cvt4_fp8(r1[0], r1[1], r1[2], r1[3]); }
                    st_pair8(YS + (size_t)(u.pm * 256 + row) * 1024 + u.pn * 256 + bj * 128 + wc * 32 + fq_ * 8, (size_t)16 * 1024, fq_, w[0], w[1]); } }
    }
};
template <bool HAS_OUT> struct EpiPLE {
    static constexpr int NVM = 48;
    const bf16_t* HB; float* OUT; bf16_t* XB; const bf16_t* PP; unsigned char* XF;
    __device__ __forceinline__ void operator()(const Acc& acc, const Unit& u, int wr, int wc, int fr, int fq) const {
        EPI_OPAQUE();
        const size_t base = (size_t)(u.pm * 256 + wr * 64 + fr_) * 1024 + u.pn * 256 + wc * 32 + fq_ * 8;
        u32x4 hw[2], pw[2], hn[2], pn_[2];
#define PLE_LD1(D_, P_) asm volatile("global_load_dwordx4 %0, %1, off" : "=&v"(D_) : "v"(P_) : "memory")
#define PLE_LD(it, H_, P_) do { const size_t o_ = base + (size_t)(((it) >> 2) * 128 + ((it) & 3) * 16) * 1024; \
            PLE_LD1(H_[0], HB + o_); PLE_LD1(H_[1], HB + o_ + 128); PLE_LD1(P_[0], PP + o_); PLE_LD1(P_[1], PP + o_ + 128); } while (0)
#define PLE_WAIT(N_) asm volatile("s_waitcnt vmcnt(" #N_ ")" : "+v"(hw[0]), "+v"(hw[1]), "+v"(pw[0]), "+v"(pw[1]) :: "memory")
        PLE_LD(0, hw, pw);
#pragma unroll
        for (int it = 0; it < 8; ++it) { const int ai = it >> 2, m = it & 3;
            if (it < 7) PLE_LD(it + 1, hn, pn_);
            if (it == 0) PLE_WAIT(4); else if (it < 7) { if constexpr (HAS_OUT) PLE_WAIT(12); else PLE_WAIT(8); } else { if constexpr (HAS_OUT) PLE_WAIT(8); else PLE_WAIT(4); }
            const size_t o0 = base + (size_t)(ai * 128 + m * 16) * 1024;
#pragma unroll
            for (int bj = 0; bj < 2; ++bj) { const f32x4 v0 = acc[ai][bj][m][0], v1 = acc[ai][bj][m][1]; const u32x4 h_ = hw[bj], p_ = pw[bj]; const size_t o = o0 + bj * 128;
                auto ple2 = [](f32x2 a, unsigned hw_, unsigned pw_) -> f32x2 {
                    const f32x2 t = a * (f32x2){-1.4426950408889634f, -1.4426950408889634f};
                    f32x2 e = {__builtin_amdgcn_exp2f(t[0]), __builtin_amdgcn_exp2f(t[1])}; e = e + (f32x2){1.0f, 1.0f};
                    const f32x2 sg = {__builtin_amdgcn_rcpf(e[0]), __builtin_amdgcn_rcpf(e[1])};
                    return __builtin_elementwise_fma(sg, (f32x2){bflo(pw_), bfhi(pw_)}, (f32x2){bflo(hw_), bfhi(hw_)}); };
                const f32x2 q0 = ple2(__builtin_shufflevector(v0, v0, 0, 1), h_.x, p_.x), q1 = ple2(__builtin_shufflevector(v0, v0, 2, 3), h_.y, p_.y);
                const f32x2 q2 = ple2(__builtin_shufflevector(v1, v1, 0, 1), h_.z, p_.z), q3 = ple2(__builtin_shufflevector(v1, v1, 2, 3), h_.w, p_.w);
                const f32x4 r0 = {q0[0], q0[1], q1[0], q1[1]}, r1 = {q2[0], q2[1], q3[0], q3[1]};
                if constexpr (HAS_OUT) { *(f32x4*)(OUT + o) = r0; *(f32x4*)(OUT + o + 4) = r1; }
                *(u32x4*)(XB + o) = pack8(r0, r1);
                { u32x2 w8; w8.x = cvt4_fp8(r0[0], r0[1], r0[2], r0[3]); w8.y = cvt4_fp8(r1[0], r1[1], r1[2], r1[3]); *(u32x2*)(XF + o) = w8; } }
            hw[0] = hn[0]; hw[1] = hn[1]; pw[0] = pn_[0]; pw[1] = pn_[1]; }
#undef PLE_LD
#undef PLE_LD1
#undef PLE_WAIT
    }
};
__device__ __forceinline__ int ropeperm(int d, int half) { return d < half ? 2 * d : 2 * (d - half) + 1; }
__device__ __forceinline__ int rowmap_rt(int map, int n) {
    if (map == 1) {
        if (n < 1024) return (n & ~255) + ropeperm(n & 255, 128);
        if (n < 2048) return 3072 + ((n - 1024) & ~255) + ropeperm(n & 255, 128);
        if (n < 4096) return 4096 + (n - 2048);
        return 1024 + (n - 4096);
    } else if (map == 2) {
        return n < 256 ? n : 256 + ropeperm(n - 256, 32);
    } else if (map == 3) {
        const int hh = n / 192, d = n - hh * 192;
        return d < 128 ? hh * 128 + d : 1024 + hh * 64 + ropeperm(d - 128, 32);
    } else if (map == 4) {
        return n < 1024 ? ((n >> 7) * 256 + (n & 127)) : (((n - 1024) >> 7) * 256 + 128 + ((n - 1024) & 127));
    }
    return n;
}
struct TJob { const float* src; size_t sstride; int nmat, K, N; unsigned char* dst; size_t dstride; int map; const float* kscale; int ksstride; int fp8; float wscale; int sp; };
constexpr int NTJOBS = 11 + G1B_FP8;
__device__ __forceinline__ TJob get_tjob(int j, KPtr p, unsigned char* ws) {
    TJob t; t.kscale = nullptr; t.ksstride = 0; t.fp8 = 0; t.wscale = 1.0f; t.map = 0; t.sp = 0;
    switch (j) {
    case 0:  t.src = p->in[20]; t.sstride = (size_t)1024 * 2048; t.nmat = 128; t.K = 1024; t.N = 2048; t.dst = ws + WS_WGU; t.dstride = (size_t)2048 * 1024; t.map = 4; t.fp8 = 1; t.wscale = WGU_SCALE; break;
    case 1:  t.src = p->in[22]; t.sstride = (size_t)1024 * 1024; t.nmat = 128; t.K = 1024; t.N = 1024; t.dst = ws + WS_WDN; t.dstride = (size_t)1024 * 1024; t.fp8 = 1; t.wscale = WDN_SCALE; break;
    case 2:  t.src = p->in[3];  t.sstride = (size_t)1024 * 6144; t.nmat = 2;   t.K = 1024; t.N = 6144; t.dst = ws + WS_WRIN; t.dstride = (size_t)6144 * 1024 * 2; t.map = 1; break;
    case 3:  t.src = p->in[6];  t.sstride = (size_t)2048 * 1024; t.nmat = 2;   t.K = 2048; t.N = 1024; t.dst = ws + WS_WROUT; t.dstride = (size_t)1024 * 2048 * (G5_FP8 ? 1 : 2); t.fp8 = G5_FP8; t.wscale = G5_FP8 ? WROUT_SCALE : 1.0f; break;
    case 4:  t.src = p->in[10]; t.sstride = (size_t)1024 * 256;  t.nmat = 2;   t.K = 1024; t.N = 256;  t.dst = ws + WS_WQA; t.dstride = (size_t)256 * 1024; t.fp8 = ATT_FP8; t.wscale = ATT_FP8 ? WQA_SCALE : 1.0f; if (!ATT_FP8) t.dstride *= 2; break;
    case 5:  t.src = p->in[12]; t.sstride = (size_t)256 * 1536;  t.nmat = 2;   t.K = 256;  t.N = 1536; t.dst = ws + WS_WQB; t.dstride = (size_t)1536 * 256 * 2; t.map = 3; t.kscale = p->in[11]; t.ksstride = 256; break;
    case 6:  t.src = p->in[13]; t.sstride = (size_t)1024 * 1024; t.nmat = 2;   t.K = 1024; t.N = 1024; t.dst = ws + WS_WO; t.dstride = (size_t)1024 * 1024; t.fp8 = ATT_FP8; t.wscale = ATT_FP8 ? WO_SCALE : 1.0f; if (!ATT_FP8) t.dstride *= 2; break;
    case 7:  t.src = p->in[7];  t.sstride = 0;                   t.nmat = 1;   t.K = 1024; t.N = 320;  t.dst = ws + WS_WKVA; t.dstride = 0; t.map = 2; t.fp8 = ATT_FP8; t.wscale = ATT_FP8 ? WKVA_SCALE : 1.0f; break;
    case 8:  t.src = p->in[9];  t.sstride = 0;                   t.nmat = 1;   t.K = 256;  t.N = 2048; t.dst = ws + WS_WKVB; t.dstride = 0; t.kscale = p->in[8]; break;
    case 9:  t.src = p->in[24]; t.sstride = (size_t)1024 * 1024; t.nmat = 4;   t.K = 1024; t.N = 1024; t.dst = ws + WS_WPG; t.dstride = (size_t)1024 * 1024 * 2; break;
    case 10: t.src = p->in[25]; t.sstride = (size_t)256 * 1024;  t.nmat = 4;   t.K = 256;  t.N = 1024; t.dst = ws + WS_WPP; t.dstride = (size_t)1024 * 256 * 2; break;
    default: t.src = p->in[3] + 2048; t.sstride = (size_t)1024 * 6144; t.nmat = 2; t.K = 1024; t.N = 2048; t.sp = 6144; t.dst = ws + WS_WV8; t.dstride = (size_t)2048 * 1024; t.fp8 = 1; t.wscale = WV_SCALE; break;
    }
    if (t.sp == 0) t.sp = t.N;
    return t;
}
struct TTile { const float* src; unsigned char* dst; const float* kscale; int K, N, k0, n0, map, fp8; float wscale; bool valid; int SP; };
__device__ __forceinline__ TTile get_ttile(int t, KPtr p, unsigned char* ws, int jlo, int jhi) {
    TTile r; r.valid = false;
    int base = 0;
    for (int j = jlo; j < jhi; ++j) { const TJob jb = get_tjob(j, p, ws); const int nnb = (jb.N + 255) >> 8, tpm = (jb.K >> 8) * nnb, nt = jb.nmat * tpm;
        if (t < base + nt) { const int rr = t - base, mat = rr / tpm, q = rr - mat * tpm, kb = q / nnb, nb = q - kb * nnb;
            r.src = jb.src + (size_t)mat * jb.sstride; r.dst = jb.dst + (size_t)mat * jb.dstride; r.kscale = jb.kscale ? jb.kscale + mat * jb.ksstride : nullptr;
            r.K = jb.K; r.N = jb.N; r.k0 = kb << 8; r.n0 = nb << 8; r.map = jb.map; r.fp8 = jb.fp8; r.wscale = jb.wscale; r.SP = jb.sp; r.valid = true; return r; }
        base += nt; }
    return r;
}
__device__ __forceinline__ int ttile_total(KPtr p, unsigned char* ws, int jlo, int jhi) { int n = 0; for (int j = jlo; j < jhi; ++j) { const TJob jb = get_tjob(j, p, ws); n += jb.nmat * (jb.K >> 8) * ((jb.N + 255) >> 8); } return n; }
__device__ __forceinline__ void prologue_phase(KPtr p, unsigned char* ws, LAS unsigned char* lds, int tid, int vcu, int G, int gw, int NGW, int lane, int jlo, int jhi, bool misc) {
    const int wave = __builtin_amdgcn_readfirstlane(tid >> 6);
    const int total = ttile_total(p, ws, jlo, jhi);
    f32x4 R[32];
    TTile cur = get_ttile(vcu, p, ws, jlo, jhi);
#define TT_LOAD(tt) do { const bool ok_ = (tt).n0 + 4 * lane < (tt).N; const float* sp_ = (tt).src + (size_t)((tt).k0 + 32 * wave) * (tt).SP + (tt).n0 + 4 * lane; \
        _Pragma("unroll") for (int i = 0; i < 32; ++i) R[i] = ok_ ? *(const f32x4*)(sp_ + (size_t)i * (tt).SP) : (f32x4){0.f, 0.f, 0.f, 0.f}; } while (0)
    if (vcu < total) TT_LOAD(cur);
    for (int t = vcu; t < total; t += G) {
        const float sc = cur.wscale;
        if (cur.kscale) {
#pragma unroll
            for (int i = 0; i < 32; ++i) R[i] = R[i] * cur.kscale[cur.k0 + 32 * wave + i]; }
        if (!cur.fp8) {
#pragma unroll
            for (int q = 0; q < 4; ++q) { const int row = 4 * lane + q;
#pragma unroll
                for (int ci = 0; ci < 4; ++ci) { u32x4 w; w.x = cvt_pk_bf16(R[ci * 8 + 0][q], R[ci * 8 + 1][q]); w.y = cvt_pk_bf16(R[ci * 8 + 2][q], R[ci * 8 + 3][q]); w.z = cvt_pk_bf16(R[ci * 8 + 4][q], R[ci * 8 + 5][q]); w.w = cvt_pk_bf16(R[ci * 8 + 6][q], R[ci * 8 + 7][q]);
                    *(LAS u32x4*)(lds + row * 512 + (((4 * wave + ci) ^ (lane & 31)) << 4)) = w; } }
        } else {
#pragma unroll
            for (int q = 0; q < 4; ++q) { const int row = 4 * lane + q;
#pragma unroll
                for (int ci = 0; ci < 2; ++ci) { u32x4 w; const int b = ci * 16;
                    w.x = cvt4_fp8(R[b + 0][q] * sc, R[b + 1][q] * sc, R[b + 2][q] * sc, R[b + 3][q] * sc); w.y = cvt4_fp8(R[b + 4][q] * sc, R[b + 5][q] * sc, R[b + 6][q] * sc, R[b + 7][q] * sc);
                    w.z = cvt4_fp8(R[b + 8][q] * sc, R[b + 9][q] * sc, R[b + 10][q] * sc, R[b + 11][q] * sc); w.w = cvt4_fp8(R[b + 12][q] * sc, R[b + 13][q] * sc, R[b + 14][q] * sc, R[b + 15][q] * sc);
                    *(LAS u32x4*)(lds + row * 256 + (((2 * wave + ci) ^ (lane & 15)) << 4)) = w; } }
        }
        __syncthreads();
        const TTile nxt = get_ttile(t + G, p, ws, jlo, jhi);
        if (t + G < total) TT_LOAD(nxt);
        if (!cur.fp8) {
#pragma unroll 4
            for (int i = 0; i < 16; ++i) { const int row = (tid >> 5) + 16 * i, ch = tid & 31;
                if (cur.n0 + row < cur.N) { const u32x4 w = *(const LAS u32x4*)(lds + row * 512 + ((ch ^ ((row >> 2) & 31)) << 4));
                    *(u32x4*)(cur.dst + ((size_t)rowmap_rt(cur.map, cur.n0 + row) * cur.K + cur.k0) * 2 + ch * 16) = w; } }
        } else {
#pragma unroll 4
            for (int i = 0; i < 8; ++i) { const int row = (tid >> 4) + 32 * i, ch = tid & 15;
                if (cur.n0 + row < cur.N) { const u32x4 w = *(const LAS u32x4*)(lds + row * 256 + ((ch ^ ((row >> 2) & 15)) << 4));
                    *(u32x4*)(cur.dst + ((size_t)rowmap_rt(cur.map, cur.n0 + row) * cur.K + cur.k0) + ch * 16) = w; } }
        }
        __syncthreads();
        cur = nxt;
    }
#undef TT_LOAD
    if (!misc) return;
    const size_t gt = (size_t)gw * 64 + lane, NT_ = (size_t)NGW * 64;
    for (size_t i = gt; i < (size_t)192 * 1024 * (ATT_FP8 ? 1 : 2) / 16; i += NT_) *(u32x4*)(ws + WS_WKVA + (size_t)320 * 1024 * (ATT_FP8 ? 1 : 2) + i * 16) = (u32x4){0u, 0u, 0u, 0u};
    for (size_t i = gt; i < (size_t)4 * 32768; i += NT_) { const int l = (int)(i >> 15), r = (int)(i & 32767), e = r >> 10, k = r & 1023; ((float*)(ws + WS_WRT))[i] = p->in[18][(size_t)l * 32768 + k * 32 + e]; }
    for (size_t i = gt; i < (size_t)T * 1024 / 8; i += NT_) { const f32x4 a = *(const f32x4*)(p->in[0] + i * 8), b = *(const f32x4*)(p->in[0] + i * 8 + 4); *(u32x4*)((bf16_t*)(ws + WS_XBA) + i * 8) = pack8(a, b);
        if (G1B_FP8) { u32x2 w8; w8.x = cvt4_fp8(a[0], a[1], a[2], a[3]); w8.y = cvt4_fp8(b[0], b[1], b[2], b[3]); *(u32x2*)(ws + WS_XF8 + i * 8) = w8; } }
    for (size_t i = gt; i < (size_t)4 * T * 256 / 8; i += NT_) { const f32x4 a = *(const f32x4*)(p->in[1] + i * 8), b = *(const f32x4*)(p->in[1] + i * 8 + 4); *(u32x4*)((bf16_t*)(ws + WS_PB) + i * 8) = pack8(a, b); }
    const int* pos = (const int*)p->in[2];
    if ((NT_ & 127) == 0) {
        { const int j = (int)(gt & 127); const double inv = exp(-(double)j * (2.0 / 256.0) * 9.210340371976184);
          for (size_t i = gt; i < (size_t)T * 128; i += NT_) { double sn, cs; sincos((double)pos[i >> 7] * inv, &sn, &cs); ((float*)(ws + WS_COSR))[i] = (float)cs; ((float*)(ws + WS_SINR))[i] = (float)sn; } }
        { const int j = (int)(gt & 31); const double inv = exp(-(double)j * (2.0 / 64.0) * 9.210340371976184);
          for (size_t i = gt; i < (size_t)T * 32; i += NT_) { double sn, cs; sincos((double)pos[i >> 5] * inv, &sn, &cs); ((float*)(ws + WS_COSM))[i] = (float)cs; ((float*)(ws + WS_SINM))[i] = (float)sn; } }
    } else {
    for (size_t i = gt; i < (size_t)T * 128; i += NT_) { const int t = (int)(i >> 7), j = (int)(i & 127);
        const double inv = exp(-(double)j * (2.0 / 256.0) * 9.210340371976184), ang = (double)pos[t] * inv; const float c = (float)cos(ang), s = (float)sin(ang);
        ((float*)(ws + WS_COSR))[i] = c; ((float*)(ws + WS_SINR))[i] = s; }
    for (size_t i = gt; i < (size_t)T * 32; i += NT_) { const int t = (int)(i >> 5), j = (int)(i & 31);
        const double inv = exp(-(double)j * (2.0 / 64.0) * 9.210340371976184), ang = (double)pos[t] * inv;
        ((float*)(ws + WS_COSM))[i] = (float)cos(ang); ((float*)(ws + WS_SINM))[i] = (float)sin(ang); }
    }
}

template <int N> __device__ __forceinline__ void tr_step(float (&pa)[32], float (&pb)[32], int lane, int mask) {
    const bool up = (lane & mask) != 0; float ra[N], rb[N];
#pragma unroll
    for (int i = 0; i < N; ++i) { ra[i] = __shfl_xor(up ? pa[i] : pa[i + N], mask); rb[i] = __shfl_xor(up ? pb[i] : pb[i + N], mask); }
    __builtin_amdgcn_sched_barrier(0);
#pragma unroll
    for (int i = 0; i < N; ++i) { pa[i] = (up ? pa[i + N] : pa[i]) + ra[i]; pb[i] = (up ? pb[i + N] : pb[i]) + rb[i]; }
    __builtin_amdgcn_sched_barrier(0);
}
__device__ __forceinline__ void ln1_router_phase(KPtr p, unsigned char* ws, LAS unsigned char* lds, int layer, const bf16_t* hin, int tid, int wave, int lane, int G, bool dry = false) {
    LAS float* wrt = (LAS float*)lds;
    volatile LAS unsigned* misc = (volatile LAS unsigned*)(lds + MISC_OFF);
    const float* wr = p->in[18] + (size_t)layer * 1024 * 32; const float* br = p->in[19] + layer * 32;
    const float* lg = p->in[14] + layer * 1024; const float* lb = p->in[15] + layer * 1024;
    u32x2 nh[2][4], nm[2][4];
    if ((int)blockIdx.x < T / 128) {
#pragma unroll
        for (int q = 0; q < 2; ++q) { const size_t ro = (size_t)((int)blockIdx.x * 128 + wave * 16 + q) * 1024;
#pragma unroll
            for (int j = 0; j < 4; ++j) { nh[q][j] = *(const u32x2*)(hin + ro + 256 * j + 4 * lane); nm[q][j] = *(const u32x2*)(((const bf16_t*)(ws + WS_MIX)) + ro + 256 * j + 4 * lane); } } }
    { const f32x4* wt4 = (const f32x4*)(ws + WS_WRT) + (size_t)layer * 8192;
#pragma unroll 4
      for (int i = tid; i < 8192; i += 512) *(LAS f32x4*)(wrt + (i >> 8) * 1028 + 4 * (i & 255)) = wt4[i]; }
    bf16_t* H = (bf16_t*)(ws + (dry ? WS_END : WS_H)); const bf16_t* MIX = (const bf16_t*)(ws + WS_MIX); bf16_t* XBB = (bf16_t*)(ws + (dry ? WS_END + ((size_t)T * 4096) : WS_XBB));
    int* EIDX = (int*)(ws + (dry ? WS_END + ((size_t)T * 6144) : WS_EIDX)); float* GATE = (float*)(ws + (dry ? WS_END + ((size_t)T * 6144) + (size_t)T * 16 : WS_GATE)); int* POS = (int*)(ws + (dry ? WS_END + ((size_t)T * 6144) + (size_t)T * 32 : WS_POS));
    unsigned* gcnt = (unsigned*)(ws + WS_CTL) + CW_CNT + (dry ? 4 : layer) * 32 * 64;
    int* TOKL = (int*)(ws + (dry ? WS_END + ((size_t)100 << 20) : WS_XG));
    LAS float* gl = (LAS float*)(lds + GB_OFF);
    if (tid < 256) *(LAS f32x4*)(gl + 4 * tid) = *(const f32x4*)(lg + 4 * tid); else *(LAS f32x4*)(gl + 4 * tid) = *(const f32x4*)(lb + 4 * (tid - 256));
    const float mybias = br[lane >> 1];
    for (int tb = blockIdx.x; tb < T / 128; tb += G) {
        if (tid < 32) misc[MW_LCNT + tid] = 0u;
        __syncthreads();
        const int base = tb * 128;
        if (tb != (int)blockIdx.x)
#pragma unroll
        for (int q = 0; q < 2; ++q) { const size_t ro = (size_t)(base + wave * 16 + q) * 1024;
#pragma unroll
            for (int j = 0; j < 4; ++j) { nh[q][j] = *(const u32x2*)(hin + ro + 256 * j + 4 * lane); nm[q][j] = *(const u32x2*)(MIX + ro + 256 * j + 4 * lane); } }
        for (int pr = 0; pr < 8; ++pr) {
            const int tl = wave * 16 + pr * 2;
            f32x4 y[2][4];
#pragma unroll
            for (int q = 0; q < 2; ++q)
#pragma unroll
                for (int j = 0; j < 4; ++j) { const u32x2 a = nh[q][j], b = nm[q][j];
                    y[q][j] = (f32x4){bflo(a.x), bfhi(a.x), bflo(a.y), bfhi(a.y)} * DN_ALPHA + (f32x4){bflo(b.x), bfhi(b.x), bflo(b.y), bfhi(b.y)}; }
            if (pr < 7) {
#pragma unroll
                for (int q = 0; q < 2; ++q) { const size_t ro = (size_t)(base + tl + 2 + q) * 1024;
#pragma unroll
                    for (int j = 0; j < 4; ++j) { nh[q][j] = *(const u32x2*)(hin + ro + 256 * j + 4 * lane); nm[q][j] = *(const u32x2*)(MIX + ro + 256 * j + 4 * lane); } } }
            f32x4 g4[4], b4[4];
#pragma unroll
            for (int j = 0; j < 4; ++j) { g4[j] = *(const LAS f32x4*)(gl + 256 * j + 4 * lane); b4[j] = *(const LAS f32x4*)(gl + 1024 + 256 * j + 4 * lane); }
#pragma unroll
            for (int q = 0; q < 2; ++q) { const size_t ro = (size_t)(base + tl + q) * 1024; float s = 0.f;
#pragma unroll
                for (int j = 0; j < 4; ++j) s += (y[q][j][0] + y[q][j][1]) + (y[q][j][2] + y[q][j][3]);
                const float mean = wave_sum(s) * (1.0f / 1024.0f); float s2 = 0.f;
#pragma unroll
                for (int j = 0; j < 4; ++j) { y[q][j] = y[q][j] - mean; s2 += (y[q][j][0] * y[q][j][0] + y[q][j][1] * y[q][j][1]) + (y[q][j][2] * y[q][j][2] + y[q][j][3] * y[q][j][3]); }
                const float rstd = rsqrtf(wave_sum(s2) * (1.0f / 1024.0f) + LN_EPS);
#pragma unroll
                for (int j = 0; j < 4; ++j) { y[q][j] = y[q][j] * rstd * g4[j] + b4[j];
                    { u32x2 w; w.x = cvt_pk_bf16(y[q][j][0], y[q][j][1]); w.y = cvt_pk_bf16(y[q][j][2], y[q][j][3]); *(u32x2*)(H + ro + 256 * j + 4 * lane) = w; }
                    *(unsigned*)((unsigned char*)XBB + ro + 256 * j + 4 * lane) = cvt4_fp8(y[q][j][0], y[q][j][1], y[q][j][2], y[q][j][3]); }
            }
            float pa[32], pb[32];
            f32x4 wq[2][4];
#pragma unroll
            for (int j = 0; j < 4; ++j) wq[0][j] = *(const LAS f32x4*)(wrt + 256 * j + 4 * lane);
#pragma unroll
            for (int e = 0; e < 32; ++e) { const int cb = e & 1;
                if (e + 1 < 32) {
#pragma unroll
                    for (int j = 0; j < 4; ++j) wq[cb ^ 1][j] = *(const LAS f32x4*)(wrt + (e + 1) * 1028 + 256 * j + 4 * lane); }
                __builtin_amdgcn_sched_barrier(0);
                f32x2 sa = {0.f, 0.f}, sb = {0.f, 0.f};
#pragma unroll
                for (int j = 0; j < 4; ++j) { const f32x4 w4 = wq[cb][j];
                    const f32x2 wl = __builtin_shufflevector(w4, w4, 0, 1), wh = __builtin_shufflevector(w4, w4, 2, 3);
                    sa = __builtin_elementwise_fma(__builtin_shufflevector(y[0][j], y[0][j], 0, 1), wl, sa); sa = __builtin_elementwise_fma(__builtin_shufflevector(y[0][j], y[0][j], 2, 3), wh, sa);
                    sb = __builtin_elementwise_fma(__builtin_shufflevector(y[1][j], y[1][j], 0, 1), wl, sb); sb = __builtin_elementwise_fma(__builtin_shufflevector(y[1][j], y[1][j], 2, 3), wh, sb); }
                pa[e] = sa[0] + sa[1]; pb[e] = sb[0] + sb[1];
                __builtin_amdgcn_sched_barrier(0); }
            tr_step<16>(pa, pb, lane, 32); tr_step<8>(pa, pb, lane, 16); tr_step<4>(pa, pb, lane, 8); tr_step<2>(pa, pb, lane, 4); tr_step<1>(pa, pb, lane, 2);
            float lv[2]; lv[0] = pa[0] + __shfl_xor(pa[0], 1) + mybias; lv[1] = pb[0] + __shfl_xor(pb[0], 1) + mybias;
            const int myexp = lane >> 1;
#pragma unroll
            for (int q = 0; q < 2; ++q) { float tv[4]; int ti[4];
                const unsigned ub = __float_as_uint(lv[q]); unsigned key = (((ub & 0x80000000u) ? ~ub : (ub | 0x80000000u)) & ~31u) | (unsigned)(31 - myexp);
#pragma unroll
                for (int r = 0; r < 4; ++r) { const unsigned best = wave_umax(key); const int bi = 31 - (int)(best & 31u);
                    ti[r] = bi; tv[r] = __uint_as_float(__builtin_amdgcn_readlane(__float_as_uint(lv[q]), 2 * bi)); if (myexp == bi) key = 0u; }
                const float e1 = __expf(tv[1] - tv[0]), e2 = __expf(tv[2] - tv[0]), e3 = __expf(tv[3] - tv[0]), inv = 1.0f / (1.0f + e1 + e2 + e3);
                if (lane < 4) { const int ek = lane == 0 ? ti[0] : lane == 1 ? ti[1] : lane == 2 ? ti[2] : ti[3];
                    const float gk = (lane == 0 ? 1.0f : lane == 1 ? e1 : lane == 2 ? e2 : e3) * inv;
                    const int t = base + tl + q; EIDX[t * 4 + lane] = ek; GATE[t * 4 + lane] = gk;
                    const unsigned lp = __hip_atomic_fetch_add((LAS unsigned*)&misc[MW_LCNT + ek], 1u, __ATOMIC_RELAXED, __HIP_MEMORY_SCOPE_WORKGROUP);
                    misc[MW_TOK + (tl + q) * 4 + lane] = (unsigned)ek | (lp << 8); }
            }
        }
        __syncthreads();
        if (tid < 32) misc[MW_LBASE + tid] = __hip_atomic_fetch_add(gcnt + tid * 64, misc[MW_LCNT + tid], __ATOMIC_RELAXED, __HIP_MEMORY_SCOPE_AGENT);
        __syncthreads();
        { const unsigned v = misc[MW_TOK + tid]; const unsigned e = v & 255u; const int pos = (int)(misc[MW_LBASE + e] + (v >> 8));
          POS[base * 4 + tid] = pos; TOKL[(size_t)e * T + pos] = base + (tid >> 2); }
        __syncthreads();
    }
}
__device__ __forceinline__ void plan_phase(unsigned char* ws, LAS unsigned char* lds, int layer, int tid) {
    volatile LAS unsigned* misc = (volatile LAS unsigned*)(lds + MISC_OFF);
    unsigned* gcnt = (unsigned*)(ws + WS_CTL) + CW_CNT + layer * 32 * 64;
    if (tid < 32) misc[MW_CNT + tid] = __hip_atomic_load(gcnt + tid * 64, __ATOMIC_RELAXED, __HIP_MEMORY_SCOPE_AGENT);
    __syncthreads();
    if (tid < 32) {
        volatile LAS unsigned char* rbe = (volatile LAS unsigned char*)(misc + MW_RBEXP);
        const unsigned nb = (misc[MW_CNT + tid] + 255u) >> 8; unsigned inc = nb;
#pragma unroll
        for (int d = 1; d < 32; d <<= 1) { const unsigned v = (unsigned)__shfl_up((int)inc, d, 32); if (tid >= d) inc += v; }
        const unsigned first = inc - nb;
        misc[MW_PSTART + tid] = first << 8; for (unsigned r = 0; r < nb; ++r) rbe[first + r] = (unsigned char)tid;
        if (tid == 31) misc[MW_NRB] = inc; }
    __syncthreads();
}
__device__ __forceinline__ void ln2_phase(KPtr p, unsigned char* ws, LAS unsigned char* lds, int layer, int lane, int gw, int NGW, bool dry = false) {
    const bf16_t* H = (const bf16_t*)(ws + WS_H); bf16_t* XBB = (bf16_t*)(ws + (dry ? WS_END + ((size_t)T * 4096) : WS_XBB)); const unsigned char* YS = (const unsigned char*)(ws + WS_YS);
    const int* EIDX = (const int*)(ws + WS_EIDX); const int* POS = (const int*)(ws + WS_POS); const float* GATE = (const float*)(ws + WS_GATE);
    volatile LAS unsigned* misc = (volatile LAS unsigned*)(lds + MISC_OFF);
    const float* lg = p->in[16] + layer * 1024; const float* lb = p->in[17] + layer * 1024;
    f32x4 gam[2][2], bet[2][2];
#pragma unroll
    for (int j = 0; j < 2; ++j) { const int c = j * 512 + lane * 8; gam[j][0] = *(const f32x4*)(lg + c); gam[j][1] = *(const f32x4*)(lg + c + 4); bet[j][0] = *(const f32x4*)(lb + c); bet[j][1] = *(const f32x4*)(lb + c + 4); }
    int sl = 0, sln = 0; float gt = 0.f, gtn = 0.f; u32x4 hr[2]; u32x2 ys[4][2];
#define LN2_SLOTS(tt, S_, G_) do { if ((tt) < T && lane < 4) { S_ = (int)misc[MW_PSTART + EIDX[(tt) * 4 + lane]] + POS[(tt) * 4 + lane]; G_ = GATE[(tt) * 4 + lane]; } } while (0)
#define LN2_ROWS(tt, S_) do { if ((tt) < T) { _Pragma("unroll") for (int k = 0; k < 4; ++k) { const int sk = __builtin_amdgcn_readlane(S_, k); \
            _Pragma("unroll") for (int j = 0; j < 2; ++j) ys[k][j] = *(const u32x2*)(YS + (size_t)sk * 1024 + j * 512 + lane * 8); } \
        _Pragma("unroll") for (int j = 0; j < 2; ++j) hr[j] = *(const u32x4*)(H + (size_t)(tt) * 1024 + j * 512 + lane * 8); } } while (0)
    LN2_SLOTS(gw, sl, gt); LN2_SLOTS(gw + NGW, sln, gtn);
    LN2_ROWS(gw, sl);
    for (int t = gw; t < T; t += NGW) {
        u32x2 cy[4][2]; u32x4 ch[2]; float gk[4];
#pragma unroll
        for (int k = 0; k < 4; ++k) { cy[k][0] = ys[k][0]; cy[k][1] = ys[k][1]; gk[k] = __uint_as_float(__builtin_amdgcn_readlane(__float_as_uint(gt), k)); }
        ch[0] = hr[0]; ch[1] = hr[1];
        sl = sln; gt = gtn;
        LN2_ROWS(t + NGW, sl);
        LN2_SLOTS(t + 2 * NGW, sln, gtn);
        float x[16];
#pragma unroll
        for (int j = 0; j < 2; ++j) { const u32x4 w = ch[j];
            x[j * 8 + 0] = bflo(w.x) * DN_ALPHA; x[j * 8 + 1] = bfhi(w.x) * DN_ALPHA; x[j * 8 + 2] = bflo(w.y) * DN_ALPHA; x[j * 8 + 3] = bfhi(w.y) * DN_ALPHA;
            x[j * 8 + 4] = bflo(w.z) * DN_ALPHA; x[j * 8 + 5] = bfhi(w.z) * DN_ALPHA; x[j * 8 + 6] = bflo(w.w) * DN_ALPHA; x[j * 8 + 7] = bfhi(w.w) * DN_ALPHA; }
        float s = 0.f;
#pragma unroll
        for (int k = 0; k < 4; ++k)
#pragma unroll
            for (int j = 0; j < 2; ++j) { const u32x2 w = cy[k][j]; const float g_ = gk[k] * (1.0f / YS_SCALE);
                const f32x2 a = __builtin_amdgcn_cvt_pk_f32_fp8((int)w.x, false), b = __builtin_amdgcn_cvt_pk_f32_fp8((int)w.x, true);
                const f32x2 c = __builtin_amdgcn_cvt_pk_f32_fp8((int)w.y, false), d = __builtin_amdgcn_cvt_pk_f32_fp8((int)w.y, true);
                x[j * 8 + 0] += g_ * a[0]; x[j * 8 + 1] += g_ * a[1]; x[j * 8 + 2] += g_ * b[0]; x[j * 8 + 3] += g_ * b[1];
                x[j * 8 + 4] += g_ * c[0]; x[j * 8 + 5] += g_ * c[1]; x[j * 8 + 6] += g_ * d[0]; x[j * 8 + 7] += g_ * d[1]; }
#pragma unroll
        for (int i = 0; i < 16; ++i) s += x[i];
        const float mean = wave_sum(s) * (1.0f / 1024.0f); float s2 = 0.f;
#pragma unroll
        for (int i = 0; i < 16; ++i) { x[i] -= mean; s2 += x[i] * x[i]; }
        const float rstd = rsqrtf(wave_sum(s2) * (1.0f / 1024.0f) + LN_EPS);
#pragma unroll
        for (int j = 0; j < 2; ++j) { const int c = j * 512 + lane * 8; const size_t o = (size_t)t * 1024 + c;
            const f32x4 ga = gam[j][0], gb = gam[j][1], ba = bet[j][0], bb = bet[j][1];
            f32x4 ya, yb;
#pragma unroll
            for (int i = 0; i < 4; ++i) { ya[i] = x[j * 8 + i] * rstd * ga[i] + ba[i]; yb[i] = x[j * 8 + 4 + i] * rstd * gb[i] + bb[i]; }
            *(u32x4*)(XBB + o) = pack8(ya, yb); }
    }
#undef LN2_SLOTS
#undef LN2_ROWS
}
__device__ __forceinline__ void ret_scan_phase(unsigned char* ws, int gthread, int nthreads, bool dry = false) {
    bf16_t* VS = (bf16_t*)(ws + WS_VS); const size_t wofs = dry ? (WS_END - WS_VS) / 2 : 0;
    for (int it = gthread; it < 16 * 512 * 32; it += nthreads) {
        const int dk8 = it & 31, dv = (it >> 5) & 511, bh = it >> 14;
        const float g256 = exp2f(log2gamma(bh & 3) * 256.0f);
        bf16_t* ptr = VS + (size_t)bh * 32 * 262144 + (size_t)dv * 512 + 256 + dk8 * 8;
        float s[8];
#pragma unroll
        for (int i = 0; i < 8; ++i) s[i] = 0.f;
        u32x4 ua[32];
#pragma unroll
        for (int n = 0; n < 32; ++n) ua[n] = *(const u32x4*)(ptr + (size_t)n * 262144);
#pragma unroll
        for (int n = 0; n < 32; ++n) {
            const u32x4 uw = ua[n];
            f32x4 a, b; a[0] = s[0]; a[1] = s[1]; a[2] = s[2]; a[3] = s[3]; b[0] = s[4]; b[1] = s[5]; b[2] = s[6]; b[3] = s[7];
            *(u32x4*)(ptr + wofs + (size_t)n * 262144) = pack8(a, b);
            s[0] = s[0] * g256 + bflo(uw.x); s[1] = s[1] * g256 + bfhi(uw.x); s[2] = s[2] * g256 + bflo(uw.y); s[3] = s[3] * g256 + bfhi(uw.y);
            s[4] = s[4] * g256 + bflo(uw.z); s[5] = s[5] * g256 + bfhi(uw.z); s[6] = s[6] * g256 + bflo(uw.w); s[7] = s[7] * g256 + bfhi(uw.w);
        }
    }
}
__device__ __forceinline__ void ret_gn_phase(KPtr p, unsigned char* ws, int layer, int lane, int gw, int NGW) {
    const bf16_t* Y = (const bf16_t*)(ws + WS_Y); const bf16_t* GB = (const bf16_t*)(ws + WS_GB); bf16_t* Z = (bf16_t*)(ws + WS_Z);
    const float* gg = p->in[4] + layer * 2048; const float* gb = p->in[5] + layer * 2048;
    f32x4 gam[4][2], bet[4][2];
#pragma unroll
    for (int hh = 0; hh < 4; ++hh) { const int c = hh * 512 + lane * 8;
        gam[hh][0] = *(const f32x4*)(gg + c); gam[hh][1] = *(const f32x4*)(gg + c + 4); bet[hh][0] = *(const f32x4*)(gb + c); bet[hh][1] = *(const f32x4*)(gb + c + 4); }
    u32x4 ny[4], ng[4];
    if (gw < T) {
#pragma unroll
        for (int hh = 0; hh < 4; ++hh) { const size_t o = (size_t)gw * 2048 + hh * 512 + lane * 8; ny[hh] = *(const u32x4*)(Y + o); ng[hh] = *(const u32x4*)(GB + o); } }
    for (int t = gw; t < T; t += NGW) {
        u32x4 cy[4], cg[4];
#pragma unroll
        for (int hh = 0; hh < 4; ++hh) { cy[hh] = ny[hh]; cg[hh] = ng[hh]; }
        if (t + NGW < T) {
#pragma unroll
            for (int hh = 0; hh < 4; ++hh) { const size_t o = (size_t)(t + NGW) * 2048 + hh * 512 + lane * 8; ny[hh] = *(const u32x4*)(Y + o); ng[hh] = *(const u32x4*)(GB + o); } }
#pragma unroll
        for (int hh = 0; hh < 4; ++hh) { const int c = hh * 512 + lane * 8; const size_t o = (size_t)t * 2048 + c;
            const u32x4 w = cy[hh], gw4 = cg[hh];
            float x[8] = {bflo(w.x), bfhi(w.x), bflo(w.y), bfhi(w.y), bflo(w.z), bfhi(w.z), bflo(w.w), bfhi(w.w)};
            float gv[8] = {bflo(gw4.x), bfhi(gw4.x), bflo(gw4.y), bfhi(gw4.y), bflo(gw4.z), bfhi(gw4.z), bflo(gw4.w), bfhi(gw4.w)};
#pragma unroll
            for (int i = 0; i < 8; i += 2) {
                const f32x2 g2 = {gv[i], gv[i + 1]}; const f32x2 t2 = g2 * (f32x2){-1.4426950408889634f, -1.4426950408889634f};
                f32x2 e2 = {__builtin_amdgcn_exp2f(t2[0]), __builtin_amdgcn_exp2f(t2[1])}; e2 = e2 + (f32x2){1.0f, 1.0f};
                const f32x2 r2 = g2 * (f32x2){__builtin_amdgcn_rcpf(e2[0]), __builtin_amdgcn_rcpf(e2[1])}; gv[i] = r2[0]; gv[i + 1] = r2[1]; }
            float s = 0.f;
#pragma unroll
            for (int i = 0; i < 8; ++i) s += x[i];
            const float mean = wave_sum(s) * (1.0f / 512.0f); float s2 = 0.f;
#pragma unroll
            for (int i = 0; i < 8; ++i) { x[i] -= mean; s2 += x[i] * x[i]; }
            const float rstd = rsqrtf(wave_sum(s2) * (1.0f / 512.0f) + GN_EPS);
            const f32x4 ga = gam[hh][0], gbv = gam[hh][1], ba = bet[hh][0], bb = bet[hh][1];
            f32x4 ya, yb;
#pragma unroll
            for (int i = 0; i < 4; ++i) { ya[i] = (x[i] * rstd * ga[i] + ba[i]) * gv[i]; yb[i] = (x[4 + i] * rstd * gbv[i] + bb[i]) * gv[4 + i]; }
#if G5_FP8
            { u32x2 w8; w8.x = cvt4_fp8(ya[0] * Z_SCALE, ya[1] * Z_SCALE, ya[2] * Z_SCALE, ya[3] * Z_SCALE); w8.y = cvt4_fp8(yb[0] * Z_SCALE, yb[1] * Z_SCALE, yb[2] * Z_SCALE, yb[3] * Z_SCALE); *(u32x2*)((unsigned char*)Z + o) = w8; } }
#else
            *(u32x4*)(Z + o) = pack8(ya, yb); }
#endif
    }
}

namespace att {
constexpr int SHM_V = 64 * 128 * 2, SHM_K = 64 * 192 * 2;
constexpr int OFF_V = 0, OFF_K = 2 * SHM_V, OFF_WS = 2 * SHM_V + 2 * SHM_K;
constexpr float THR = 8.f;
#define KSWZ192(row, colB) ((row) * 384 + ((colB) ^ (((row) & 7) << 4)))
#define SBAR() __builtin_amdgcn_sched_barrier(0)
__device__ __forceinline__ int v_st(int k, int c) { const int kk = (k & ~0xC) | ((k & 4) << 1) | ((k & 8) >> 1); return ((kk >> 3) * 4 + (c >> 5)) * 512 + ((kk & 7) * 32 + (c & 31)) * 2; }
__device__ __forceinline__ int v_rd_base(int lane) { return ((lane & 3) << 3) | (((lane >> 2) & 3) << 6) | (((lane >> 4) & 1) << 5) | (((lane >> 5) & 1) << 8); }
constexpr int v_rd_off(int d0, int ks, int half) { return d0 * 512 + ks * 4096 + half * 2048; }
__device__ __forceinline__ int crow(int r, int hi) { return (r & 3) + 8 * (r >> 2) + 4 * hi; }
__device__ __forceinline__ void mask_tile(f32x16& p0, f32x16& p1, int dq) {
    const float NEG = -__builtin_inff();
#pragma unroll
    for (int r = 0; r < 16; ++r) { const int c = (r & 3) + 8 * (r >> 2);
        if (dq - c < 0) p0[r] = NEG;
        if (dq - c - 32 < 0) p1[r] = NEG; }
}
__device__ __forceinline__ void partialSM(f32x16& p0, f32x16& p1, float& m_reg, float& alpha) {
    float pmax = p0[0];
#pragma unroll
    for (int r = 1; r < 16; ++r) pmax = fmaxf(pmax, p0[r]);
#pragma unroll
    for (int r = 0; r < 16; ++r) pmax = fmaxf(pmax, p1[r]);
    { auto rr = __builtin_amdgcn_permlane32_swap(__float_as_uint(pmax), __float_as_uint(pmax), false, false);
      pmax = fmaxf(__uint_as_float(rr[0]), __uint_as_float(rr[1])); }
    float mn;
    if (__builtin_expect(__all((pmax - m_reg) <= THR), 1)) { mn = m_reg; alpha = 1.f; }
    else { mn = fmaxf(m_reg, pmax); alpha = __builtin_amdgcn_exp2f(m_reg - mn); m_reg = mn; }
#pragma unroll
    for (int r = 0; r < 16; ++r) p0[r] = __builtin_amdgcn_exp2f(p0[r] - mn);
#pragma unroll
    for (int r = 0; r < 16; ++r) p1[r] = __builtin_amdgcn_exp2f(p1[r] - mn);
}
__device__ __forceinline__ void finishSM(const f32x16& p0, const f32x16& p1, float alpha, float& l_reg, bf16x8& pa0, bf16x8& pa1, bf16x8& pa2, bf16x8& pa3) {
    float ps = 0;
#pragma unroll
    for (int r = 0; r < 16; ++r) ps += p0[r];
#pragma unroll
    for (int r = 0; r < 16; ++r) ps += p1[r];
    { auto rr = __builtin_amdgcn_permlane32_swap(__float_as_uint(ps), __float_as_uint(ps), false, false);
      ps = __uint_as_float(rr[0]) + __uint_as_float(rr[1]); }
    l_reg = l_reg * alpha + ps;
#define PK4(P, B_, OUT) do { unsigned a0 = cvt_pk_bf16(P[B_+0], P[B_+1]), a1 = cvt_pk_bf16(P[B_+2], P[B_+3]); \
        unsigned b0 = cvt_pk_bf16(P[B_+4], P[B_+5]), b1 = cvt_pk_bf16(P[B_+6], P[B_+7]); \
        auto r0 = __builtin_amdgcn_permlane32_swap(a0, b0, false, false); auto r1 = __builtin_amdgcn_permlane32_swap(a1, b1, false, false); \
        u32x4 w = {r0[0], r1[0], r0[1], r1[1]}; OUT = __builtin_bit_cast(bf16x8, w); } while (0)
    PK4(p0, 0, pa0); PK4(p0, 8, pa1); PK4(p1, 0, pa2); PK4(p1, 8, pa3);
#undef PK4
}
template <int KB>
__device__ __forceinline__ void qkt(f32x16& p0, f32x16& p1, const LAS char* K_lds, int r32, int hi, const bf16x8* qr) {
    p0 = f32x16{}; p1 = f32x16{};
    const LAS char* kb[4];
#pragma unroll
    for (int dd = 0; dd < 4; ++dd) kb[dd] = K_lds + KB * SHM_K + KSWZ192(r32, (dd * 16 + hi * 8) * 2);
#pragma unroll
    for (int d0 = 0; d0 < 12; ++d0) { const LAS char* a = kb[d0 & 3] + (d0 >> 2) * 128;
        const bf16x8 b0 = *(const LAS bf16x8*)a;
        const bf16x8 b1 = *(const LAS bf16x8*)(a + 32 * 384);
        p0 = __builtin_amdgcn_mfma_f32_32x32x16_bf16(b0, qr[d0], p0, 0, 0, 0);
        p1 = __builtin_amdgcn_mfma_f32_32x32x16_bf16(b1, qr[d0], p1, 0, 0, 0); }
}
template <int VB>
__device__ __forceinline__ void pv_tile(f32x16* o, unsigned vb0, bf16x8 pa0, bf16x8 pa1, bf16x8 pa2, bf16x8 pa3) {
#define TRRD(dst, off) asm volatile("ds_read_b64_tr_b16 %0, %1 offset:%2" : "=&v"(dst) : "v"(vb0), "i"(off) : "memory")
#define PV_D0(d0) do { s16x4 l0, l1, l2, l3, h0, h1, h2, h3; constexpr int b_ = VB * SHM_V + v_rd_off(d0, 0, 0); \
        TRRD(l0, b_); TRRD(h0, b_ + 2048); TRRD(l1, b_ + 4096); TRRD(h1, b_ + 6144); TRRD(l2, b_ + 8192); TRRD(h2, b_ + 10240); TRRD(l3, b_ + 12288); TRRD(h3, b_ + 14336); \
        asm volatile("s_waitcnt lgkmcnt(0)" ::: "memory"); SBAR(); \
        o[d0] = __builtin_amdgcn_mfma_f32_32x32x16_bf16(pa0, (bf16x8){l0[0], l0[1], l0[2], l0[3], h0[0], h0[1], h0[2], h0[3]}, o[d0], 0, 0, 0); \
        o[d0] = __builtin_amdgcn_mfma_f32_32x32x16_bf16(pa1, (bf16x8){l1[0], l1[1], l1[2], l1[3], h1[0], h1[1], h1[2], h1[3]}, o[d0], 0, 0, 0); \
        o[d0] = __builtin_amdgcn_mfma_f32_32x32x16_bf16(pa2, (bf16x8){l2[0], l2[1], l2[2], l2[3], h2[0], h2[1], h2[2], h2[3]}, o[d0], 0, 0, 0); \
        o[d0] = __builtin_amdgcn_mfma_f32_32x32x16_bf16(pa3, (bf16x8){l3[0], l3[1], l3[2], l3[3], h3[0], h3[1], h3[2], h3[3]}, o[d0], 0, 0, 0); } while (0)
    PV_D0(0); PV_D0(1); PV_D0(2); PV_D0(3);
#undef PV_D0
#undef TRRD
}
struct Stage { u32x4 a, b, c; };
__device__ __forceinline__ void attn_block(const bf16_t* __restrict__ Q, const bf16_t* __restrict__ K, const bf16_t* __restrict__ V, bf16_t* __restrict__ O, int b, int h, int qb, LAS char* lds, int tid) {
    asm volatile("" : "+v"(tid));
    const int wid = __builtin_amdgcn_readfirstlane(tid >> 6), lane = tid & 63, r32 = lane & 31, hi = lane >> 5;
    const int P0 = qb * 256, NT = 4 * qb + 4, qlo = P0 + wid * 32, qm = qlo + r32 - 4 * hi;
    const size_t tb = (size_t)b * 8192;
    LAS char* V_lds = lds + OFF_V; LAS char* K_lds = lds + OFF_K;
    LAS float* wsf = (LAS float*)(lds + OFF_WS) + wid * 64; LAS float* li_l = wsf; LAS float* al_l = wsf + 32;
    const int sr = tid >> 4, sc = (tid & 15) * 8, vst0 = v_st(sr, sc), vst1 = v_st(32 + sr, sc);
#define KMAP(i, kr, kc) const int c_##i = tz_ + 512 * (i); const int kr = c_##i / 24, kc = c_##i - kr * 24
    const unsigned vgo = (unsigned)(sr * 1024 + sc);
    const unsigned vb0 = (unsigned)(uintptr_t)V_lds + (unsigned)v_rd_base(lane);
    const bf16_t* Kh = K + tb * 1536 + h * 192; const bf16_t* Vh = V + tb * 1024 + h * 128;
    bf16x8 qr[12];
    { const bf16_t* qp = Q + (tb + qlo + r32) * 1536 + h * 192 + hi * 8;
#pragma unroll
      for (int d0 = 0; d0 < 12; ++d0) qr[d0] = *(const bf16x8*)(qp + d0 * 16); }
    Stage S;
#define SLOAD_K(k0_) do { int tz_ = tid; asm volatile("" : "+v"(tz_)); KMAP(0, r0_, c0_); KMAP(1, r1_, c1_); KMAP(2, r2_, c2_); const bf16_t* kp_ = Kh + (size_t)(k0_) * 1536; \
        S.a = *(const u32x4*)(kp_ + (r0_ * 1536 + c0_ * 8)); S.b = *(const u32x4*)(kp_ + (r1_ * 1536 + c1_ * 8)); S.c = *(const u32x4*)(kp_ + (r2_ * 1536 + c2_ * 8)); } while (0)
#define SWRITE_K(bf) do { int tz_ = tid; asm volatile("" : "+v"(tz_)); KMAP(0, r0_, c0_); KMAP(1, r1_, c1_); KMAP(2, r2_, c2_); \
        *(LAS u32x4*)(K_lds + (bf) * SHM_K + KSWZ192(r0_, c0_ * 16)) = S.a; *(LAS u32x4*)(K_lds + (bf) * SHM_K + KSWZ192(r1_, c1_ * 16)) = S.b; *(LAS u32x4*)(K_lds + (bf) * SHM_K + KSWZ192(r2_, c2_ * 16)) = S.c; } while (0)
#define SLOAD_V(k0_) do { const bf16_t* vp_ = Vh + (size_t)(k0_) * 1024 + vgo; S.a = *(const u32x4*)(vp_); S.b = *(const u32x4*)(vp_ + 32 * 1024); } while (0)
#define SWRITE_V(bf) do { *(LAS u32x4*)(V_lds + (bf) * SHM_V + vst0) = S.a; *(LAS u32x4*)(V_lds + (bf) * SHM_V + vst1) = S.b; } while (0)
    float m_reg = -1e30f, l_reg = 0.f; f32x16 o[4] = {};
    SLOAD_K(0); SWRITE_K(0); SBAR(); SLOAD_V(0); SWRITE_V(0);
    __syncthreads();
    f32x16 p0, p1; float alpha; bf16x8 pa0, pa1, pa2, pa3;
#define TILE_STEP(t, BUF) do { \
        const int kb_ = (t) * 64; const bool act_ = kb_ <= qlo + 31;     \
        if ((t) + 1 < NT) SLOAD_K(kb_ + 64); \
        SBAR(); if (act_) { __builtin_amdgcn_s_setprio(1); qkt<BUF>(p0, p1, K_lds, r32, hi, qr); __builtin_amdgcn_s_setprio(0); } SBAR(); \
        if ((t) + 1 < NT) { SWRITE_K(1 - BUF); SBAR(); SLOAD_V(kb_ + 64); SBAR(); } \
        if (act_) { \
        if (kb_ + 63 > qlo) mask_tile(p0, p1, qm - kb_); \
        partialSM(p0, p1, m_reg, alpha); \
        if (__any(alpha < 1.f)) { if (hi == 0) al_l[r32] = alpha; asm volatile("s_waitcnt lgkmcnt(0)" ::: "memory"); \
            _Pragma("unroll") for (int d_ = 0; d_ < 4; ++d_) _Pragma("unroll") for (int r = 0; r < 16; ++r) o[d_][r] *= al_l[crow(r, hi)]; } \
        finishSM(p0, p1, alpha, l_reg, pa0, pa1, pa2, pa3); SBAR(); \
        __builtin_amdgcn_s_setprio(1); pv_tile<BUF>(o, vb0, pa0, pa1, pa2, pa3); __builtin_amdgcn_s_setprio(0); } \
        if ((t) + 1 < NT) { SWRITE_V(1 - BUF); } \
        __syncthreads(); } while (0)
    for (int t = 0; t < NT; t += 2) { TILE_STEP(t, 0); TILE_STEP(t + 1, 1); }
#undef TILE_STEP
#undef SLOAD_K
#undef KMAP
#undef SWRITE_K
#undef SLOAD_V
#undef SWRITE_V
    int lz = lane; asm volatile("" : "+v"(lz)); const int r32e = lz & 31, hie = lz >> 5;
    if (hie == 0) li_l[r32e] = l_reg; asm volatile("s_waitcnt lgkmcnt(0)" ::: "memory");
    bf16_t* Ow = O + (tb + qlo) * 1024 + h * 128 + r32e;
#pragma unroll
    for (int r = 0; r < 16; ++r) { const int orow = crow(r, hie); const float rl = __builtin_amdgcn_rcpf(li_l[orow]);
#pragma unroll
        for (int d0 = 0; d0 < 4; ++d0) { const float v = o[d0][r] * rl; const float vn = __shfl_xor(v, 1);
            if ((r32e & 1) == 0) *(unsigned*)(Ow + (size_t)orow * 1024 + d0 * 32) = cvt_pk_bf16(v, vn); } }
    __syncthreads();
}
__device__ __forceinline__ void attn_phase(const bf16_t* Q, const bf16_t* K, const bf16_t* V, bf16_t* O, LAS char* lds, int G, int vcu, int tid) {
    for (int L = vcu; L < 512; L += G) {
        const int bh = L >> 4, x = L & 15, b = bh >> 3, h = bh & 7;
#pragma unroll 1
        for (int pass = 0; pass < 2; ++pass) attn_block(Q, K, V, O, b, h, pass ? 31 - x : x, lds, tid);
    }
}
#undef KSWZ192
#undef SBAR
}


namespace att8 {
constexpr int SHM_K = 64 * 192, SHM_V = 128 * 64;
constexpr int OFF_V = 0, OFF_K = 2 * SHM_V, OFF_WS = 2 * SHM_V + 2 * SHM_K;
constexpr float THR = 4.f * ATT_QS;
#define SBAR() __builtin_amdgcn_sched_barrier(0)
__device__ __forceinline__ int crow(int r, int hi) { return (r & 3) + 8 * (r >> 2) + 4 * hi; }
__device__ __forceinline__ void mfma8(f32x16& acc, pg8::v8i32 a, pg8::v8i32 b, int sc) {
    asm volatile("s_nop 1\n\tv_mfma_scale_f32_32x32x64_f8f6f4 %0, %1, %2, %0, %3, %3 op_sel_hi:[0,0,0]" : "+v"(acc) : "v"(a), "v"(b), "v"(sc)); }
__device__ __forceinline__ pg8::v8i32 cat8u(u32x4 x, u32x4 y) { return (pg8::v8i32){(int)x.x, (int)x.y, (int)x.z, (int)x.w, (int)y.x, (int)y.y, (int)y.z, (int)y.w}; }
__device__ __forceinline__ float max3f(float a, float b, float c) { float r; asm("v_max3_f32 %0, %1, %2, %3" : "=v"(r) : "v"(a), "v"(b), "v"(c)); return r; }
__device__ __forceinline__ unsigned exp2_fp8x4(float a, float b, float c, float d, f32x2 c2, f32x2 o2) {
    const f32x2 t0 = __builtin_elementwise_fma((f32x2){a, b}, c2, o2), t1 = __builtin_elementwise_fma((f32x2){c, d}, c2, o2);
    unsigned w = __builtin_amdgcn_cvt_pk_u8_f32(t0[0], 0u, 0u); w = __builtin_amdgcn_cvt_pk_u8_f32(t0[1], 1u, w);
    w = __builtin_amdgcn_cvt_pk_u8_f32(t1[0], 2u, w); w = __builtin_amdgcn_cvt_pk_u8_f32(t1[1], 3u, w); return w; }
__device__ __forceinline__ void mask_tile(f32x16& p0, f32x16& p1, int dq) {
    const float NEG = -__builtin_inff();
#pragma unroll
    for (int r = 0; r < 16; ++r) { const int c = (r & 3) + 8 * (r >> 2);
        if (dq - c < 0) p0[r] = NEG;
        if (dq - c - 32 < 0) p1[r] = NEG; }
}
#define K8SWZ(row, ch) ((row) * 192 + ((((ch)) ^ (((row) >> 2) & 3)) << 4))
#define V8SWZ(row, ch) ((row) * 64 + ((((ch)) ^ (((row) >> 2) & 3)) << 4))
template <int KB>
__device__ __forceinline__ void qkt(f32x16& p0, f32x16& p1, const LAS char* K_lds, int r32, int hi, const pg8::v8i32* qf, int sc) {
    p0 = f32x16{}; p1 = f32x16{};
#pragma unroll
    for (int st = 0; st < 3; ++st) { const int ch = 4 * st + 2 * hi;
        const LAS char* ka = K_lds + KB * SHM_K;
        const u32x4 a0 = *(const LAS u32x4*)(ka + K8SWZ(r32, ch)), a1 = *(const LAS u32x4*)(ka + K8SWZ(r32, ch + 1));
        const u32x4 b0 = *(const LAS u32x4*)(ka + K8SWZ(32 + r32, ch)), b1 = *(const LAS u32x4*)(ka + K8SWZ(32 + r32, ch + 1));
        mfma8(p0, cat8u(a0, a1), qf[st], sc);
        mfma8(p1, cat8u(b0, b1), qf[st], sc); }
    asm volatile("s_nop 15\n\ts_nop 7" ::: "memory");
}
template <int VB>
__device__ __forceinline__ void pv_tile(f32x16* o, const LAS char* V_lds, int r32, int hi, pg8::v8i32 pa, int sc) {
#pragma unroll
    for (int d0 = 0; d0 < 4; ++d0) { const int row = d0 * 32 + r32; const LAS char* va = V_lds + VB * SHM_V;
        const u32x4 v0 = *(const LAS u32x4*)(va + V8SWZ(row, 2 * hi)), v1 = *(const LAS u32x4*)(va + V8SWZ(row, 2 * hi + 1));
        mfma8(o[d0], pa, cat8u(v0, v1), sc); }
}
struct Stage { u32x4 k0, k1, k2, v0, v1; };
constexpr int SHM_K2 = 128 * 192, SHM_V2 = 2 * SHM_V;
constexpr int NBUF = 3;
constexpr int OFF_K2 = NBUF * SHM_V2, OFF_WS2 = NBUF * SHM_V2 + NBUF * SHM_K2;
__device__ __forceinline__ void mfma8z(f32x16& acc, pg8::v8i32 a, pg8::v8i32 b, int sc) {
    asm volatile("s_nop 1\n\tv_mfma_scale_f32_32x32x64_f8f6f4 %0, %1, %2, 0, %3, %3 op_sel_hi:[0,0,0]" : "=&v"(acc) : "v"(a), "v"(b), "v"(sc)); }
#define KFRAG(ka_, st_, j_, rw_) (*(const LAS u32x4*)((ka_) + kof[j_] + 64 * (st_) + 192 * (rw_)))
#define VFRAG(va_, d0_, j_) (*(const LAS u32x4*)((va_) + vof[j_] + 2048 * (d0_)))
__device__ __forceinline__ void qkt2z(f32x16& p0, f32x16& p1, const LAS char* ka, const int* kof, const pg8::v8i32* qf, int sc) {
#pragma unroll
    for (int st = 0; st < 3; ++st) {
        const u32x4 a0 = KFRAG(ka, st, 0, 0), a1 = KFRAG(ka, st, 1, 0), b0 = KFRAG(ka, st, 0, 32), b1 = KFRAG(ka, st, 1, 32);
        if (st == 0) { mfma8z(p0, cat8u(a0, a1), qf[st], sc); mfma8z(p1, cat8u(b0, b1), qf[st], sc); }
        else { mfma8(p0, cat8u(a0, a1), qf[st], sc); mfma8(p1, cat8u(b0, b1), qf[st], sc); } }
}
__device__ __forceinline__ void pv2(f32x16* o, const LAS char* va, const int* vof, pg8::v8i32 pa, int sc) {
#pragma unroll
    for (int d0 = 0; d0 < 4; ++d0) mfma8(o[d0], pa, cat8u(VFRAG(va, d0, 0), VFRAG(va, d0, 1)), sc);
}
template <int I> __device__ __forceinline__ void cvt_ch(pg8::v8i32& pa, const f32x16& p0, const f32x16& p1, f32x2 c2, f32x2 o2) {
    constexpr int j = 4 * (I & 3);
    int w; if (I < 4) w = (int)exp2_fp8x4(p0[j], p0[j + 1], p0[j + 2], p0[j + 3], c2, o2); else w = (int)exp2_fp8x4(p1[j], p1[j + 1], p1[j + 2], p1[j + 3], c2, o2);
    asm volatile("" : "+v"(w)); pa[I] = w; }
template <int G> __device__ __forceinline__ float max_grp(float m, const f32x16& p0, const f32x16& p1) {
    const f32x16& p = G < 2 ? p0 : p1; constexpr int j = 8 * (G & 1);
    if (G == 0) { m = max3f(p[0], p[1], p[2]); m = max3f(m, p[3], p[4]); m = max3f(m, p[5], p[6]); m = max3f(m, p[7], p[7]); }
    else { m = max3f(m, p[j], p[j + 1]); m = max3f(m, p[j + 2], p[j + 3]); m = max3f(m, p[j + 4], p[j + 5]); m = max3f(m, p[j + 6], p[j + 7]); }
    return m; }
__device__ __forceinline__ void attn_block(const unsigned char* __restrict__ Q, const unsigned char* __restrict__ K, const unsigned char* __restrict__ VT, bf16_t* __restrict__ O, int b, int h, int qb, LAS char* lds, int tid) {
    asm volatile("" : "+v"(tid));
    const int wid = __builtin_amdgcn_readfirstlane(tid >> 6), lane = tid & 63, r32 = lane & 31, hi = lane >> 5;
    const int P0 = qb * 256, NS = 2 * qb + 2, qlo = P0 + wid * 32, qm = qlo + r32 - 4 * hi;
    const size_t tb = (size_t)b * 8192;
    LAS char* V_lds = lds; LAS char* K_lds = lds + OFF_K2;
    LAS float* wsf = (LAS float*)(lds + OFF_WS2) + wid * 64; LAS float* al_l = wsf + 32;
    const unsigned char* Kh = K + tb * 1536 + h * 192; const unsigned char* Vh = VT + (size_t)((b * 8 + h) * 128) * 8192;
    int sc = 0x7F7F7F7F; asm volatile("" : "+v"(sc));
    pg8::v8i32 qf[3];
    { const unsigned char* qp = Q + (tb + qlo + r32) * 1536 + h * 192 + hi * 32;
#pragma unroll
      for (int st = 0; st < 3; ++st) qf[st] = cat8u(*(const u32x4*)(qp + st * 64), *(const u32x4*)(qp + st * 64 + 16)); }
    const int swz_ = (r32 >> 2) & 3;
    const int kof[2] = {r32 * 192 + (((2 * hi) ^ swz_) << 4), r32 * 192 + (((2 * hi + 1) ^ swz_) << 4)}, vof[2] = {r32 * 64 + (((2 * hi) ^ swz_) << 4), r32 * 64 + (((2 * hi + 1) ^ swz_) << 4)};
    unsigned kgo[3], vgo;
#pragma unroll
    for (int i = 0; i < 3; ++i) { const int c = (wid * 3 + i) * 64 + lane, rw = c / 12, x = c - rw * 12; kgo[i] = (unsigned)(rw * 1536 + (((x & ~3) | ((x & 3) ^ ((rw >> 2) & 3))) << 4)); }
    { const int c = wid * 64 + lane, rw = c >> 2; vgo = (unsigned)((rw * 4 + ((c & 3) ^ ((rw >> 2) & 3))) << 4); }
#define SDMA_K(s_, bf) do { const unsigned char* kp_ = Kh + (size_t)(s_) * (128 * 1536); LAS char* kd_ = K_lds + (bf) * SHM_K2 + wid * 3072; \
        _Pragma("unroll") for (int i_ = 0; i_ < 3; ++i_) __builtin_amdgcn_global_load_lds((const unsigned*)(kp_ + kgo[i_]), (LAS unsigned*)(kd_ + i_ * 1024), 16, 0, 0); } while (0)
#define SDMA_V(s_, bf) do { const unsigned char* vp_ = Vh + (size_t)(s_) * 16384 + vgo; LAS char* vd_ = V_lds + (bf) * SHM_V2 + wid * 1024; \
        __builtin_amdgcn_global_load_lds((const unsigned*)vp_, (LAS unsigned*)vd_, 16, 0, 0); __builtin_amdgcn_global_load_lds((const unsigned*)(vp_ + 8192), (LAS unsigned*)(vd_ + SHM_V), 16, 0, 0); } while (0)
#define SDMA_WAIT() asm volatile("s_waitcnt vmcnt(0)" ::: "memory")
    LAS char* ones_l = lds + OFF_WS2 + 2048;
    if (tid < 8) ((LAS unsigned*)ones_l)[tid] = 0x38383838u;
    float m_reg = -1e30f; f32x16 o[4] = {}; f32x16 lacc = {};
#define ONES8() cat8u(*(const LAS u32x4*)ones_l, *(const LAS u32x4*)(ones_l + 16))
    SDMA_K(0, 0); SDMA_V(0, 0); SDMA_K(1, 1); SDMA_V(1, 1);
    asm volatile("s_waitcnt vmcnt(5) lgkmcnt(0)" ::: "memory");
    __builtin_amdgcn_s_barrier();
    f32x16 pA0, pA1, pB0, pB1;
    constexpr float ISQ = 1.0f / ATT_QS;
#define SM_DECIDE(PM_, O2_, RESC_) do { float pmax = (PM_); \
        { auto rr = __builtin_amdgcn_permlane32_swap(__float_as_uint(pmax), __float_as_uint(pmax), false, false); pmax = fmaxf(__uint_as_float(rr[0]), __uint_as_float(rr[1])); } \
        float mn, alpha; \
        if (__builtin_expect(__all((pmax - m_reg) <= THR), 1)) { mn = m_reg; alpha = 1.f; RESC_ = false; } \
        else { mn = fmaxf(m_reg, pmax); alpha = __builtin_amdgcn_exp2f((m_reg - mn) * ISQ); m_reg = mn; RESC_ = true; } \
        const float off8_ = 88.0f - mn * (8.0f * ISQ); O2_ = (f32x2){off8_, off8_}; \
        if (__any(alpha < 1.f)) { if (hi == 0) al_l[r32] = alpha; asm volatile("s_nop 15\n\ts_nop 7\n\ts_waitcnt lgkmcnt(0)" ::: "memory");     \
            _Pragma("unroll") for (int r = 0; r < 16; ++r) { const float a_ = al_l[crow(r, hi)]; o[0][r] *= a_; o[1][r] *= a_; o[2][r] *= a_; o[3][r] *= a_; lacc[r] *= a_; } } } while (0)
#define CVT_ALL(PA_, P0_, P1_, O2_) do { cvt_ch<0>(PA_, P0_, P1_, c2_, O2_); cvt_ch<1>(PA_, P0_, P1_, c2_, O2_); cvt_ch<2>(PA_, P0_, P1_, c2_, O2_); cvt_ch<3>(PA_, P0_, P1_, c2_, O2_); \
        cvt_ch<4>(PA_, P0_, P1_, c2_, O2_); cvt_ch<5>(PA_, P0_, P1_, c2_, O2_); cvt_ch<6>(PA_, P0_, P1_, c2_, O2_); cvt_ch<7>(PA_, P0_, P1_, c2_, O2_); } while (0)
    const f32x2 c2_ = {8.0f * ISQ, 8.0f * ISQ};
    struct KF { u32x4 a0, a1, b0, b1; }; struct VF { u32x4 v0, v1; };
#define LDK(ka_, st_) KF{KFRAG(ka_, st_, 0, 0), KFRAG(ka_, st_, 1, 0), KFRAG(ka_, st_, 0, 32), KFRAG(ka_, st_, 1, 32)}
#define LDV(va_, d0_) VF{VFRAG(va_, d0_, 0), VFRAG(va_, d0_, 1)}
#define STEP(s_, BUF) do { \
        const int kb0_ = (s_) * 128, kb1_ = kb0_ + 64;     \
        const int sn_ = (s_) + 2 < NS ? (s_) + 2 : NS - 1;     \
        const LAS char* kbuf_ = K_lds + BUF * SHM_K2; const LAS char* vbuf_ = V_lds + BUF * SHM_V2; const LAS char* kb_ = kbuf_ + 64 * 192; const LAS char* vb_ = vbuf_ + SHM_V; \
        KF f0 = LDK(kbuf_, 0), f1 = LDK(kbuf_, 1);             \
        { \
            pg8::v8i32 pa, pb; float pmb_ = 0.f; f32x2 o2a_, o2b_; VF v0, v1, w0, w1; bool ra_, rb_; \
            { SBAR(); mfma8z(pA0, cat8u(f0.a0, f0.a1), qf[0], sc); mfma8z(pA1, cat8u(f0.b0, f0.b1), qf[0], sc); SBAR(); \
              KF f2 = LDK(kbuf_, 2); SBAR(); SDMA_K(sn_, (BUF + 2) % NBUF);     \
              SBAR(); mfma8(pA0, cat8u(f1.a0, f1.a1), qf[1], sc); mfma8(pA1, cat8u(f1.b0, f1.b1), qf[1], sc); SBAR(); \
              KF g0 = LDK(kb_, 0); SBAR(); SDMA_V(sn_, (BUF + 2) % NBUF); \
              SBAR(); mfma8(pA0, cat8u(f2.a0, f2.a1), qf[2], sc); mfma8(pA1, cat8u(f2.b0, f2.b1), qf[2], sc); SBAR(); \
              KF g1 = LDK(kb_, 1); \
                \
                \
              SBAR(); mfma8z(pB0, cat8u(g0.a0, g0.a1), qf[0], sc); mfma8z(pB1, cat8u(g0.b0, g0.b1), qf[0], sc); SBAR(); \
              asm volatile("s_nop 7" ::: "memory"); \
              if (kb0_ + 63 > qlo) mask_tile(pA0, pA1, qm - kb0_); \
              float pm_ = 0.f; pm_ = max_grp<0>(pm_, pA0, pA1); pm_ = max_grp<1>(pm_, pA0, pA1); pm_ = max_grp<2>(pm_, pA0, pA1); pm_ = max_grp<3>(pm_, pA0, pA1); \
              SM_DECIDE(pm_, o2a_, ra_); \
                \
              KF g2 = LDK(kb_, 2); \
              SBAR(); mfma8(pB0, cat8u(g1.a0, g1.a1), qf[1], sc); SBAR(); cvt_ch<0>(pa, pA0, pA1, c2_, o2a_); cvt_ch<1>(pa, pA0, pA1, c2_, o2a_); cvt_ch<2>(pa, pA0, pA1, c2_, o2a_); \
              SBAR(); mfma8(pB1, cat8u(g1.b0, g1.b1), qf[1], sc); SBAR(); cvt_ch<3>(pa, pA0, pA1, c2_, o2a_); cvt_ch<4>(pa, pA0, pA1, c2_, o2a_); \
              v0 = LDV(vbuf_, 0); v1 = LDV(vbuf_, 1); \
              SBAR(); mfma8(pB0, cat8u(g2.a0, g2.a1), qf[2], sc); SBAR(); cvt_ch<5>(pa, pA0, pA1, c2_, o2a_); cvt_ch<6>(pa, pA0, pA1, c2_, o2a_); \
              SBAR(); mfma8(pB1, cat8u(g2.b0, g2.b1), qf[2], sc); SBAR(); cvt_ch<7>(pa, pA0, pA1, c2_, o2a_); } \
              \
            if (kb1_ + 63 > qlo) { asm volatile("s_nop 15\n\ts_nop 7" ::: "memory"); mask_tile(pB0, pB1, qm - kb1_); } \
              \
            { SBAR(); mfma8(o[0], pa, cat8u(v0.v0, v0.v1), sc); asm volatile("s_nop 7" ::: "memory"); SBAR(); \
              VF v2 = LDV(vbuf_, 2); pmb_ = max_grp<0>(pmb_, pB0, pB1); cvt_ch<0>(pb, pB0, pB1, c2_, o2a_); cvt_ch<1>(pb, pB0, pB1, c2_, o2a_); \
              SBAR(); mfma8(o[1], pa, cat8u(v1.v0, v1.v1), sc); SBAR(); \
              VF v3 = LDV(vbuf_, 3); pmb_ = max_grp<1>(pmb_, pB0, pB1); cvt_ch<2>(pb, pB0, pB1, c2_, o2a_); cvt_ch<3>(pb, pB0, pB1, c2_, o2a_); \
              SBAR(); mfma8(o[2], pa, cat8u(v2.v0, v2.v1), sc); SBAR(); \
              const pg8::v8i32 on_ = ONES8(); pmb_ = max_grp<2>(pmb_, pB0, pB1); cvt_ch<4>(pb, pB0, pB1, c2_, o2a_); cvt_ch<5>(pb, pB0, pB1, c2_, o2a_); \
              SBAR(); mfma8(o[3], pa, cat8u(v3.v0, v3.v1), sc); SBAR(); \
              w0 = LDV(vb_, 0); w1 = LDV(vb_, 1); pmb_ = max_grp<3>(pmb_, pB0, pB1); cvt_ch<6>(pb, pB0, pB1, c2_, o2a_); cvt_ch<7>(pb, pB0, pB1, c2_, o2a_); \
              SBAR(); mfma8(lacc, pa, on_, sc); SBAR(); } \
            SM_DECIDE(pmb_, o2b_, rb_); \
            if (rb_) CVT_ALL(pb, pB0, pB1, o2b_); \
            { SBAR(); mfma8(o[0], pb, cat8u(w0.v0, w0.v1), sc); SBAR(); \
              VF w2 = LDV(vb_, 2); \
              SBAR(); mfma8(o[1], pb, cat8u(w1.v0, w1.v1), sc); SBAR(); \
              VF w3 = LDV(vb_, 3); \
              SBAR(); mfma8(o[2], pb, cat8u(w2.v0, w2.v1), sc); SBAR(); \
              const pg8::v8i32 on_ = ONES8(); \
              SBAR(); mfma8(o[3], pb, cat8u(w3.v0, w3.v1), sc); mfma8(lacc, pb, on_, sc); SBAR(); } \
        } \
        asm volatile("s_waitcnt vmcnt(5) lgkmcnt(0)" ::: "memory");     \
        __builtin_amdgcn_s_barrier(); } while (0)
    for (int s_i = 0; s_i < NS; s_i += 3) { STEP(s_i, 0); if (s_i + 1 < NS) STEP(s_i + 1, 1); if (s_i + 2 < NS) STEP(s_i + 2, 2); }
    SDMA_WAIT();
#undef STEP
#undef SM_DECIDE
#undef CVT_ALL
#undef SDMA_K
#undef SDMA_V
#undef SDMA_WAIT
#undef ONES8
#undef LDK
#undef LDV
    int lz = lane; asm volatile("" : "+v"(lz)); const int r32e = lz & 31, hie = lz >> 5;
    asm volatile("s_nop 15\n\ts_nop 7" ::: "memory");
    LAS unsigned char* stg = (LAS unsigned char*)lds + OFF_WS2 + 2112 + wid * 1152;
    unsigned char* Ob = (unsigned char*)O + (tb + qlo) * 1024 + h * 128;
#pragma unroll
    for (int q = 0; q < 4; ++q) {
#pragma unroll
        for (int rr = 0; rr < 4; ++rr) { const int r = 4 * q + rr, lrow = rr + 4 * hie;
            const float rl = __builtin_amdgcn_rcpf(lacc[r] * (ATT_VS / OB_SCALE));
#pragma unroll
            for (int d0 = 0; d0 < 4; ++d0) { const float v = o[d0][r] * rl; const float vn = DPP_F(v, 0xB1);
                if ((r32e & 1) == 0) *(LAS unsigned short*)(stg + lrow * 144 + d0 * 32 + r32e) = (unsigned short)__builtin_amdgcn_cvt_pk_fp8_f32(v, vn, 0, false); } }
        asm volatile("s_waitcnt lgkmcnt(0)" ::: "memory");
        { const int row = lz >> 3, ch = lz & 7; const u32x4 w = *(const LAS u32x4*)(stg + row * 144 + ch * 16);
          *(u32x4*)(Ob + (size_t)(8 * q + row) * 1024 + ch * 16) = w; }
        __builtin_amdgcn_sched_barrier(0); }
    __syncthreads();
}
#undef KFRAG
#undef VFRAG
__device__ __forceinline__ void attn_phase(const unsigned char* Q, const unsigned char* K, const unsigned char* VT, bf16_t* O, LAS char* lds, int G, int vcu, int tid) {
    for (int L = vcu; L < 512; L += G) {
        const int bh = L >> 4, x = L & 15, b = bh >> 3, h = bh & 7;
#pragma unroll 1
        for (int pass = 0; pass < 2; ++pass) attn_block(Q, K, VT, O, b, h, pass ? 31 - x : x, lds, tid);
    }
}
#undef K8SWZ
#undef V8SWZ
#undef SBAR
}

#ifndef PH_MASK
#define PH_MASK 0xffffffffu
#endif
#define PH_ON(n) (((PH_MASK) >> (n)) & 1u)
#ifndef REP_MASK
#define REP_MASK 0u
#endif
#define REP(n) (1 + (int)(((REP_MASK) >> (n)) & 1u))
__global__ void __launch_bounds__(512, 2) yoco_fwd(const Params p) {
    extern __shared__ __attribute__((aligned(16))) unsigned char lds_raw[];
    LAS unsigned char* lds = (LAS unsigned char*)lds_raw;
    const int G0 = gridDim.x, bx0 = blockIdx.x, vcu0 = (G0 % 8 == 0) ? (bx0 % 8) * (G0 / 8) + bx0 / 8 : bx0;
    volatile LAS unsigned* misc = (volatile LAS unsigned*)(lds + MISC_OFF);
    for (int i = threadIdx.x; i < (LDS_BYTES - MISC_OFF) / 4; i += 512) misc[i] = 0u;
    __syncthreads();
    XcdBarrier bar = xcd_barrier_post((unsigned*)(p.ws + WS_CTL) + CW_BAR, misc + MW_BAR);
#define GRID_BAR() xcd_barrier(bar)
#define PHASE_VARS() KPtr pp = (KPtr)__builtin_amdgcn_kernarg_segment_ptr(); asm volatile("" : "+s"(pp)); unsigned char* ws = pp->ws; (void)pp; \
    int G = G0, bx = bx0, vcu = vcu0; asm volatile("" : "+s"(G), "+s"(bx), "+s"(vcu)); const int NGW = G * 8; (void)NGW; (void)bx; int tid = bar.wave * 64 + lane_id(); asm volatile("" : "+v"(tid)); \
    const int lane = tid & 63, wave = bar.wave, gw = vcu * 8 + wave; (void)lane; (void)gw; (void)ws

    { PHASE_VARS(); if (PH_ON(0)) prologue_phase(pp, ws, lds, tid, vcu, G, gw, NGW, lane, 2, NTJOBS, true); }
    GRID_BAR();
    { PHASE_VARS(); if (PH_ON(0) && (vcu & 1)) prologue_phase(pp, ws, lds, tid, vcu, G, gw, NGW, lane, 0, 2, false); }
    for (int l = 0; l < 4; ++l) { PHASE_VARS();
        DenseSched S; S.init((const bf16_t*)(ws + WS_PB) + (size_t)l * T * 256, (const bf16_t*)(ws + WS_WPP) + (size_t)l * 1024 * 256, T, 1024, 256, 256, G, bx);
        EpiBf16 E{(bf16_t*)(ws + WS_PP) + (size_t)l * T * 1024, 1024};
        if (PH_ON(1)) for (int r_ = 0; r_ < REP(1); ++r_) pg8::gemm_phase(lds, tid, 256, 256, 256, S, E);
    }

    for (int l = 0; l < 4; ++l) {
        if (l < 2) {
            { PHASE_VARS(); DenseSched S; S.init((const bf16_t*)(ws + WS_XBA), (const bf16_t*)(ws + WS_WRIN) + (size_t)l * 6144 * 1024, T, 4096, 1024, 1024, G, bx);
              EpiRetA E{(bf16_t*)(ws + WS_QB), (bf16_t*)(ws + WS_ACAT), (bf16_t*)(ws + WS_GB), (bf16_t*)(ws + WS_KB), (const float*)(ws + WS_COSR), (const float*)(ws + WS_SINR), (bf16_t*)(ws + WS_KDT)};
              if (PH_ON(2)) for (int r_ = 0; r_ < REP(2); ++r_) pg8::gemm_phase(lds, tid, 1024, 1024, 1024, S, E); }
#if G1B_FP8
            { PHASE_VARS(); DenseSched S; S.init((const bf16_t*)(ws + WS_WV8 + (size_t)l * 2048 * 1024), (const bf16_t*)(ws + WS_XF8), 2048, T, 512, 512, G, bx);
              EpiRetB E{(bf16_t*)(ws + WS_VS), 1.0f / WV_SCALE};
              if (PH_ON(3)) for (int r_ = 0; r_ < REP(3); ++r_) pg8::gemm_phase<true>(lds, tid, 512, 512, 512, S, E); }
#else
            { PHASE_VARS(); DenseSched S; S.init((const bf16_t*)(ws + WS_WRIN) + (size_t)l * 6144 * 1024 + (size_t)4096 * 1024, (const bf16_t*)(ws + WS_XBA), 2048, T, 1024, 1024, G, bx);
              EpiRetB E{(bf16_t*)(ws + WS_VS)};
              if (PH_ON(3)) for (int r_ = 0; r_ < REP(3); ++r_) pg8::gemm_phase(lds, tid, 1024, 1024, 1024, S, E); }
#endif
            if (l == 0) { PHASE_VARS(); if (PH_ON(0) && !(vcu & 1)) prologue_phase(pp, ws, lds, tid, vcu, G, gw, NGW, lane, 0, 2, false); }
            GRID_BAR();
            { PHASE_VARS(); SchedG2 S{(const char*)(ws + WS_ACAT), (const char*)(ws + WS_KB), G, bx}; EpiRetP E{(bf16_t*)(ws + WS_ACAT)};
              if (PH_ON(4)) for (int r_ = 0; r_ < REP(4); ++r_) pg8::gemm_phase(lds, tid, 2048, 1024, 256, S, E); }
            { PHASE_VARS(); SchedG3 S{(const char*)(ws + WS_VS), (const char*)(ws + WS_KDT), G, bx}; EpiRetU E{(bf16_t*)(ws + WS_VS)};
              if (PH_ON(5)) for (int r_ = 0; r_ < REP(5); ++r_) pg8::gemm_phase(lds, tid, 512, 256, 256, S, E); }
            GRID_BAR();
            { PHASE_VARS(); if (PH_ON(6)) for (int r_ = REP(6) - 1; r_ >= 0; --r_) ret_scan_phase(ws, gw * 64 + lane, NGW * 64, r_ != 0); }
            GRID_BAR();
            { PHASE_VARS(); SchedG4 S{(const char*)(ws + WS_ACAT), (const char*)(ws + WS_VS), G, bx}; EpiBf16 E{(bf16_t*)(ws + WS_Y), 2048};
              if (PH_ON(7)) for (int r_ = 0; r_ < REP(7); ++r_) pg8::gemm_phase(lds, tid, 2048, 512, 512, S, E); }
            GRID_BAR();
            { PHASE_VARS(); if (PH_ON(8)) for (int r_ = 0; r_ < REP(8); ++r_) ret_gn_phase(pp, ws, l, lane, gw, NGW); }
            GRID_BAR();
#if G5_FP8
            { PHASE_VARS(); DenseSched S; S.init((const bf16_t*)(ws + WS_Z), (const bf16_t*)((unsigned char*)(ws + WS_WROUT) + (size_t)l * 1024 * 2048), T, 1024, 1024, 1024, G, bx);
              EpiBf16 E{(bf16_t*)(ws + WS_MIX), 1024, 1.0f / (WROUT_SCALE * Z_SCALE)};
              if (PH_ON(9)) for (int r_ = 0; r_ < REP(9); ++r_) pg8::gemm_phase<true>(lds, tid, 1024, 1024, 1024, S, E); }
#else
            { PHASE_VARS(); DenseSched S; S.init((const bf16_t*)(ws + WS_Z), (const bf16_t*)(ws + WS_WROUT) + (size_t)l * 1024 * 2048, T, 1024, 2048, 2048, G, bx);
              EpiBf16 E{(bf16_t*)(ws + WS_MIX), 1024};
              if (PH_ON(9)) for (int r_ = 0; r_ < REP(9); ++r_) pg8::gemm_phase(lds, tid, 2048, 2048, 2048, S, E); }
#endif
            GRID_BAR();
        } else {
            const int j = l - 2;
#if ATT_FP8
            if (l == 2) { PHASE_VARS(); DenseSched S; S.init((const bf16_t*)(ws + WS_XF8), (const bf16_t*)(ws + WS_WKVA), T, 512, 512, 512, G, bx);
              EpiKVA E{(bf16_t*)(ws + WS_CKV), (float*)(ws + WS_SSQ), (bf16_t*)(ws + WS_KBUF), (const float*)(ws + WS_COSM), (const float*)(ws + WS_SINM), 1.0f / WKVA_SCALE};
              if (PH_ON(10)) for (int r_ = 0; r_ < REP(10); ++r_) pg8::gemm_phase<true>(lds, tid, 512, 512, 512, S, E); }
            { PHASE_VARS(); DenseSched S; S.init((const bf16_t*)(ws + WS_XF8), (const bf16_t*)((unsigned char*)(ws + WS_WQA) + (size_t)j * 256 * 1024), T, 256, 512, 512, G, bx);
              EpiQA E{(bf16_t*)(ws + WS_QLAT), (float*)(ws + WS_SSQ2), 1.0f / WQA_SCALE};
              if (PH_ON(11)) for (int r_ = 0; r_ < REP(11); ++r_) pg8::gemm_phase<true>(lds, tid, 512, 512, 512, S, E); }
#else
            if (l == 2) { PHASE_VARS(); DenseSched S; S.init((const bf16_t*)(ws + WS_XBA), (const bf16_t*)(ws + WS_WKVA), T, 512, 1024, 1024, G, bx);
              EpiKVA E{(bf16_t*)(ws + WS_CKV), (float*)(ws + WS_SSQ), (bf16_t*)(ws + WS_KBUF), (const float*)(ws + WS_COSM), (const float*)(ws + WS_SINM), 1.0f};
              if (PH_ON(10)) for (int r_ = 0; r_ < REP(10); ++r_) pg8::gemm_phase(lds, tid, 1024, 1024, 1024, S, E); }
            { PHASE_VARS(); DenseSched S; S.init((const bf16_t*)(ws + WS_XBA), (const bf16_t*)(ws + WS_WQA) + (size_t)j * 256 * 1024, T, 256, 1024, 1024, G, bx);
              EpiQA E{(bf16_t*)(ws + WS_QLAT), (float*)(ws + WS_SSQ2), 1.0f};
              if (PH_ON(11)) for (int r_ = 0; r_ < REP(11); ++r_) pg8::gemm_phase(lds, tid, 1024, 1024, 1024, S, E); }
#endif
            GRID_BAR();
            if (l == 2) { PHASE_VARS(); DenseSched S; S.init((const bf16_t*)(ws + WS_CKV), (const bf16_t*)(ws + WS_WKVB), T, 2048, 256, 256, G, bx);
              EpiKVB E{(bf16_t*)(ws + WS_KBUF), (bf16_t*)(ws + WS_VBUF), (const float*)(ws + WS_SSQ)};
              if (PH_ON(12)) for (int r_ = 0; r_ < REP(12); ++r_) pg8::gemm_phase(lds, tid, 256, 256, 256, S, E); }
            { PHASE_VARS(); DenseSched S; S.init((const bf16_t*)(ws + WS_QLAT), (const bf16_t*)(ws + WS_WQB) + (size_t)j * 1536 * 256, T, 1536, 256, 256, G, bx);
              EpiQB E{(bf16_t*)(ws + WS_QBUF), (const float*)(ws + WS_SSQ2), (const float*)(ws + WS_COSM), (const float*)(ws + WS_SINM)};
              if (PH_ON(13)) for (int r_ = 0; r_ < REP(13); ++r_) pg8::gemm_phase(lds, tid, 256, 256, 256, S, E); }
            GRID_BAR();
            { PHASE_VARS(); if (PH_ON(14)) for (int r_ = 0; r_ < REP(14); ++r_)
#if ATT_FP8
              att8::attn_phase((const unsigned char*)(ws + WS_QBUF), (const unsigned char*)(ws + WS_KBUF), (const unsigned char*)(ws + WS_VBUF), (bf16_t*)(ws + WS_OB), (LAS char*)lds, G, vcu, tid); }
#else
              att::attn_phase((const bf16_t*)(ws + WS_QBUF), (const bf16_t*)(ws + WS_KBUF), (const bf16_t*)(ws + WS_VBUF), (bf16_t*)(ws + WS_OB), (LAS char*)lds, G, vcu, tid); }
#endif
            GRID_BAR();
#if ATT_FP8
            { PHASE_VARS(); DenseSched S; S.init((const bf16_t*)(ws + WS_OB), (const bf16_t*)((unsigned char*)(ws + WS_WO) + (size_t)j * 1024 * 1024), T, 1024, 512, 512, G, bx);
              EpiBf16 E{(bf16_t*)(ws + WS_MIX), 1024, 1.0f / (WO_SCALE * OB_SCALE)};
              if (PH_ON(15)) for (int r_ = 0; r_ < REP(15); ++r_) pg8::gemm_phase<true>(lds, tid, 512, 512, 512, S, E); }
#else
            { PHASE_VARS(); DenseSched S; S.init((const bf16_t*)(ws + WS_OB), (const bf16_t*)(ws + WS_WO) + (size_t)j * 1024 * 1024, T, 1024, 1024, 1024, G, bx);
              EpiBf16 E{(bf16_t*)(ws + WS_MIX), 1024};
              if (PH_ON(15)) for (int r_ = 0; r_ < REP(15); ++r_) pg8::gemm_phase(lds, tid, 1024, 1024, 1024, S, E); }
#endif
            GRID_BAR();
        }
        { PHASE_VARS(); const bf16_t* hin = (const bf16_t*)(ws + WS_XBA);
          if (PH_ON(16)) for (int r_ = REP(16) - 1; r_ >= 0; --r_) ln1_router_phase(pp, ws, lds, l, hin, tid, wave, lane, G, r_ != 0); }
        GRID_BAR();
        { PHASE_VARS(); if (PH_ON(17)) plan_phase(ws, lds, l, tid);
          MoeSched S{nullptr, (const char*)(ws + WS_WGU) + (size_t)l * 32 * 2048 * 1024, (size_t)2048 * 1024, 8, G, vcu, misc, (const char*)(ws + WS_XBB), (const int*)(ws + WS_XG)};
          EpiGU E{(unsigned char*)(ws + WS_ACT), pp->in[21] + (size_t)l * 32 * 2048};
          if (PH_ON(18)) for (int r_ = 0; r_ < REP(18); ++r_) pg8::gemm_phase<true, true, true>(lds, tid, 512, 512, 512, S, E); }
        GRID_BAR();
        { PHASE_VARS(); MoeSched S{(const char*)(ws + WS_ACT), (const char*)(ws + WS_WDN) + (size_t)l * 32 * 1024 * 1024, (size_t)1024 * 1024, 4, G, vcu, misc, nullptr, nullptr};
          EpiDN E{(unsigned char*)(ws + WS_YS), pp->in[23] + (size_t)l * 32 * 1024};
          if (PH_ON(19)) for (int r_ = 0; r_ < REP(19); ++r_) pg8::gemm_phase<true>(lds, tid, 512, 512, 512, S, E); }
        GRID_BAR();
        { PHASE_VARS(); if (PH_ON(20)) for (int r_ = REP(20) - 1; r_ >= 0; --r_) ln2_phase(pp, ws, lds, l, lane, gw, NGW, r_ != 0); }
        GRID_BAR();
        { PHASE_VARS(); DenseSched S; S.init((const bf16_t*)(ws + WS_XBB), (const bf16_t*)(ws + WS_WPG) + (size_t)l * 1024 * 1024, T, 1024, 1024, 1024, G, bx);
          if (l == 3) { EpiPLE<true> E{(const bf16_t*)(ws + WS_XBB), pp->out, (bf16_t*)(ws + WS_XBA), (const bf16_t*)(ws + WS_PP) + (size_t)l * T * 1024, (unsigned char*)(ws + WS_XF8)};
            if (PH_ON(21)) pg8::gemm_phase(lds, tid, 1024, 1024, 1024, S, E); }
          else { EpiPLE<false> E{(const bf16_t*)(ws + WS_XBB), nullptr, (bf16_t*)(ws + WS_XBA), (const bf16_t*)(ws + WS_PP) + (size_t)l * T * 1024, (unsigned char*)(ws + WS_XF8)};
            if (PH_ON(21)) pg8::gemm_phase(lds, tid, 1024, 1024, 1024, S, E); } }
        GRID_BAR();
    }
}

extern "C" void kernel_launch(void* const* d_in, const int* in_sizes, int n_in, void* d_out, int out_size, void* d_ws, size_t ws_size, hipStream_t stream) {
    static int grid = 0;
    if (grid == 0) {
        if (n_in != 26 || in_sizes[0] != T * D || out_size != T * D || ws_size < WS_END + ((size_t)300 << 20)) {
            fprintf(stderr, "kernel_launch: unexpected shapes (n_in %d, in0 %d, out %d, ws %zu need %zu); nothing launched\n", n_in, n_in > 0 ? in_sizes[0] : -1, out_size, ws_size, (size_t)WS_END); grid = -1; return; }
        int dev = 0, cus = 0, per_cu = 0;
        if (hipGetDevice(&dev) != hipSuccess || hipDeviceGetAttribute(&cus, hipDeviceAttributeMultiprocessorCount, dev) != hipSuccess) { grid = -1; return; }
        if (hipFuncSetAttribute((const void*)yoco_fwd, hipFuncAttributeMaxDynamicSharedMemorySize, LDS_BYTES) != hipSuccess) { fprintf(stderr, "kernel_launch: hipFuncSetAttribute failed\n"); grid = -1; return; }
        if (hipOccupancyMaxActiveBlocksPerMultiprocessor(&per_cu, (const void*)yoco_fwd, 512, LDS_BYTES) != hipSuccess || per_cu < 1)
            fprintf(stderr, "kernel_launch: note: occupancy query reports %d workgroups per CU\n", per_cu);
        (void)hipGetLastError();
        grid = cus;
    }
    if (grid < 0) return;
    if (hipMemsetAsync((char*)d_ws + WS_CTL, 0, CTL_BYTES, stream) != hipSuccess) { fprintf(stderr, "kernel_launch: memset failed\n"); return; }
    Params a{};
    for (int i = 0; i < 26; ++i) a.in[i] = (const float*)d_in[i];
    a.out = (float*)d_out; a.ws = (unsigned char*)d_ws;
    hipLaunchKernelGGL(yoco_fwd, dim3(grid), dim3(512), LDS_BYTES, stream, a);
    const hipError_t le = hipPeekAtLastError();
    if (le != hipSuccess) fprintf(stderr, "kernel_launch: launch failed: %s\n", hipGetErrorName(le));
}
```

```cpp
#include <hip/hip_runtime.h>
#include <cstdio>
#include <cstdint>

#define LAS __attribute__((address_space(3)))
#define GAS __attribute__((address_space(1)))
typedef unsigned short bf16_t;
typedef short bf16x8 __attribute__((ext_vector_type(8)));
typedef short s16x4 __attribute__((ext_vector_type(4)));
typedef float f32x4 __attribute__((ext_vector_type(4)));
typedef float f32x2 __attribute__((ext_vector_type(2)));
typedef float f32x16 __attribute__((ext_vector_type(16)));
typedef unsigned u32x4 __attribute__((ext_vector_type(4)));
typedef unsigned u32x2 __attribute__((ext_vector_type(2)));

constexpr int T = 32768, SEQ = 8192, NB = 4, D = 1024, DEPTH = 4, NE = 32;
constexpr int NSLOT = T * 4 + NE * 256;
constexpr float DN_ALPHA = 1.6817928305074290f;
constexpr float LN_EPS = 1e-5f, GN_EPS = 1e-6f, RMS_EPS = 1e-6f;
constexpr float SWIGLU_LIMIT = 7.0f, SWIGLU_ALPHA = 1.702f;
#ifndef ATT_FP8
#define ATT_FP8 1
#endif
constexpr float ATT_QS = 8.0f, ATT_VS = 2.0f, ATT_PS = 16.0f;
#ifndef G5_FP8
#define G5_FP8 1
#endif
constexpr float WROUT_SCALE = 128.0f, Z_SCALE = 4.0f;
#ifndef G1B_FP8
#define G1B_FP8 1
#endif
constexpr float WV_SCALE = 32.0f;
constexpr float WQA_SCALE = 32.0f, WKVA_SCALE = 32.0f, WO_SCALE = 64.0f, OB_SCALE = 16.0f;
constexpr float WGU_SCALE = 32.0f, WDN_SCALE = 64.0f, ACT_SCALE = 4.0f, YS_SCALE = 16.0f;

constexpr size_t al256(size_t x) { return (x + 255) & ~(size_t)255; }
constexpr size_t WS_CTL = 0, CTL_BYTES = 1u << 20;
constexpr size_t WS_WRT = WS_CTL + (512u << 10);
constexpr size_t WS_WRIN  = WS_CTL + CTL_BYTES;
constexpr size_t WS_WROUT = WS_WRIN  + (size_t)2 * 6144 * 1024 * 2;
constexpr size_t WS_WKVA  = WS_WROUT + (size_t)2 * 1024 * 2048 * 2;
constexpr size_t WS_WKVB  = WS_WKVA  + (size_t)512 * 1024 * 2;
constexpr size_t WS_WQA   = WS_WKVB  + (size_t)2048 * 256 * 2;
constexpr size_t WS_WQB   = WS_WQA   + (size_t)2 * 256 * 1024 * 2;
constexpr size_t WS_WO    = WS_WQB   + (size_t)2 * 1536 * 256 * 2;
constexpr size_t WS_WGU   = WS_WO    + (size_t)2 * 1024 * 1024 * 2;
constexpr size_t WS_WDN   = WS_WGU   + (size_t)4 * 32 * 2048 * 1024 * 2;
constexpr size_t WS_WPG   = WS_WDN   + (size_t)4 * 32 * 1024 * 1024 * 2;
constexpr size_t WS_WPP   = WS_WPG   + (size_t)4 * 1024 * 1024 * 2;
constexpr size_t WS_COSR  = WS_WPP   + (size_t)4 * 1024 * 256 * 2;
constexpr size_t WS_SINR  = WS_COSR  + (size_t)T * 128 * 4;
constexpr size_t WS_COSRT = WS_SINR  + (size_t)T * 128 * 4;
constexpr size_t WS_SINRT = WS_COSRT + (size_t)T * 128 * 4;
constexpr size_t WS_COSM  = WS_SINRT + (size_t)T * 128 * 4;
constexpr size_t WS_SINM  = WS_COSM  + (size_t)T * 32 * 4;
constexpr size_t WS_XBA   = WS_SINM  + (size_t)T * 32 * 4;
constexpr size_t WS_XBB   = WS_XBA   + (size_t)T * 1024 * 2;
constexpr size_t WS_H     = WS_XBB   + (size_t)T * 1024 * 2;
constexpr size_t WS_XF8   = WS_H     + (size_t)T * 1024 * 2;
constexpr size_t WS_MIX   = WS_H     + (size_t)T * 1024 * 4;
constexpr size_t WS_PB    = WS_MIX   + (size_t)T * 1024 * 4;
constexpr size_t WS_PP    = WS_PB    + (size_t)4 * T * 256 * 2;
constexpr size_t WS_MIXER = WS_PP    + (size_t)4 * T * 1024 * 2;
constexpr size_t WS_QB    = WS_MIXER;
constexpr size_t WS_KB    = WS_QB    + (size_t)T * 1024 * 2;
constexpr size_t WS_ACAT  = WS_KB    + (size_t)T * 1024 * 2;
constexpr size_t WS_KDT   = WS_ACAT  + (size_t)T * 2048 * 2;
constexpr size_t WS_VS    = WS_KDT   + (size_t)T * 1024 * 2;
constexpr size_t WS_GB    = WS_VS    + (size_t)16 * 32 * 512 * 512 * 2;
constexpr size_t WS_Y     = WS_GB    + (size_t)T * 2048 * 2;
constexpr size_t WS_Z     = WS_Y     + (size_t)T * 2048 * 2;
constexpr size_t WS_MIXER_END = WS_Z + (size_t)T * 2048 * 2;
constexpr size_t WS_CKV   = WS_MIXER;
constexpr size_t WS_SSQ   = WS_CKV   + (size_t)T * 256 * 2;
constexpr size_t WS_SSQ2  = WS_SSQ   + (size_t)T * 4 * 4;
constexpr size_t WS_KBUF  = WS_SSQ2  + (size_t)T * 4 * 4;
constexpr size_t WS_VBUF  = WS_KBUF  + (size_t)T * 1536 * 2;
constexpr size_t WS_QLAT  = WS_VBUF  + (size_t)T * 1024 * 2;
constexpr size_t WS_QBUF  = WS_QLAT  + (size_t)T * 256 * 2;
constexpr size_t WS_OB    = WS_QBUF  + (size_t)T * 1536 * 2;
static_assert(WS_OB + (size_t)T * 1024 * 2 <= WS_MIXER_END, "MLA overlay fits");
constexpr size_t WS_XG    = WS_MIXER_END;
constexpr size_t WS_ACT   = WS_XG    + (size_t)NSLOT * 1024 * 2;
constexpr size_t WS_YS    = WS_ACT   + (size_t)NSLOT * 1024 * 2;
constexpr size_t WS_EIDX  = WS_YS    + (size_t)NSLOT * 1024 * 2;
constexpr size_t WS_GATE  = WS_EIDX  + (size_t)T * 16;
constexpr size_t WS_POS   = WS_GATE  + (size_t)T * 16;
constexpr size_t WS_SLOT  = WS_POS   + (size_t)T * 16;
constexpr size_t WS_END   = WS_SLOT  + (size_t)T * 16;
constexpr size_t WS_WV8   = WS_END + ((size_t)200 << 20);
constexpr int CW_BAR = 4096;
constexpr int CW_CNT = 8192;

constexpr int RING_BYTES = 131072;
constexpr int MISC_OFF = 139264;
constexpr int GB_OFF = 147456;
constexpr int LDS_BYTES = 155648;
constexpr int MW_BAR = 0, MW_PSTART = 16, MW_CNT = 48, MW_GIDX = 1024, MW_NRB = 80, MW_RBEXP = 128, MW_LCNT = 320, MW_LBASE = 352, MW_TOK = 384;

__device__ __forceinline__ unsigned cvt_pk_bf16(float lo, float hi) { unsigned r; asm volatile("v_cvt_pk_bf16_f32 %0, %1, %2" : "=v"(r) : "v"(lo), "v"(hi)); return r; }
__device__ __forceinline__ u32x4 pack8(f32x4 a, f32x4 b) { u32x4 w; w.x = cvt_pk_bf16(a[0], a[1]); w.y = cvt_pk_bf16(a[2], a[3]); w.z = cvt_pk_bf16(b[0], b[1]); w.w = cvt_pk_bf16(b[2], b[3]); return w; }
__device__ __forceinline__ unsigned cvt4_fp8(float a, float b, float c, float d) { int w = 0; w = __builtin_amdgcn_cvt_pk_fp8_f32(a, b, w, false); w = __builtin_amdgcn_cvt_pk_fp8_f32(c, d, w, true); return (unsigned)w; }
__device__ __forceinline__ float bf2f(unsigned short b) { return __uint_as_float(((unsigned)b) << 16); }
__device__ __forceinline__ float bflo(unsigned w) { return __uint_as_float(w << 16); }
__device__ __forceinline__ float bfhi(unsigned w) { return __uint_as_float(w & 0xffff0000u); }
#define DPP_F(v, ctrl) __uint_as_float((unsigned)__builtin_amdgcn_update_dpp(0, (int)__float_as_uint(v), ctrl, 0xF, 0xF, false))
#define DPP_U(v, ctrl) ((unsigned)__builtin_amdgcn_update_dpp(0, (int)(v), ctrl, 0xF, 0xF, false))
__device__ __forceinline__ float wave_sum(float v) {
    v += DPP_F(v, 0xB1); v += DPP_F(v, 0x4E); v += DPP_F(v, 0x141); v += DPP_F(v, 0x140);
    const float r0 = __uint_as_float(__builtin_amdgcn_readlane(__float_as_uint(v), 0)), r1 = __uint_as_float(__builtin_amdgcn_readlane(__float_as_uint(v), 16));
    const float r2 = __uint_as_float(__builtin_amdgcn_readlane(__float_as_uint(v), 32)), r3 = __uint_as_float(__builtin_amdgcn_readlane(__float_as_uint(v), 48));
    return (r0 + r1) + (r2 + r3);
}
__device__ __forceinline__ unsigned wave_umax(unsigned v) {
    v = max(v, DPP_U(v, 0xB1)); v = max(v, DPP_U(v, 0x4E)); v = max(v, DPP_U(v, 0x141)); v = max(v, DPP_U(v, 0x140));
    const unsigned r0 = __builtin_amdgcn_readlane(v, 0), r1 = __builtin_amdgcn_readlane(v, 16), r2 = __builtin_amdgcn_readlane(v, 32), r3 = __builtin_amdgcn_readlane(v, 48);
    return max(max(r0, r1), max(r2, r3));
}
__device__ __forceinline__ void xpose8(float (&x)[8], int lane) {
    const bool b4 = lane & 4, b2 = lane & 2, b1 = lane & 1;
#pragma unroll
    for (int j = 0; j < 4; ++j) { const float a = x[j], b = x[j + 4]; const float snd = b4 ? a : b; const float rcv = DPP_F(DPP_F(snd, 0x141), 0x1B); x[j] = b4 ? rcv : a; x[j + 4] = b4 ? b : rcv; }
#pragma unroll
    for (int j = 0; j < 8; ++j) if ((j & 2) == 0) { const float a = x[j], b = x[j + 2]; const float snd = b2 ? a : b; const float rcv = DPP_F(snd, 0x4E); x[j] = b2 ? rcv : a; x[j + 2] = b2 ? b : rcv; }
#pragma unroll
    for (int j = 0; j < 8; ++j) if ((j & 1) == 0) { const float a = x[j], b = x[j + 1]; const float snd = b1 ? a : b; const float rcv = DPP_F(snd, 0xB1); x[j] = b1 ? rcv : a; x[j + 1] = b1 ? b : rcv; }
}
__device__ __forceinline__ int lane_id() { int l; asm volatile("v_mbcnt_lo_u32_b32 %0, -1, 0\n\tv_mbcnt_hi_u32_b32 %0, -1, %0" : "=v"(l)); return l; }
__device__ __forceinline__ float sigmoidf_(float x) { return __builtin_amdgcn_rcpf(1.0f + __builtin_amdgcn_exp2f(x * -1.4426950408889634f)); }

#define XB_TMO      128
#define XB_XCNT(j)  (256  + 64 * (j))
#define XB_XSUB(j)  (1280 + 64 * (j))
#define XB_XGEN(j)  (2304 + 64 * (j))
#define XB_TOP      3328
#define XB_TOPGEN   3392
#define XCD_BAR_WORDS 3456
#define XB_SPIN_CAP (1u << 18)
__device__ __forceinline__ unsigned xb_ld(unsigned* p)              { return __hip_atomic_load(p, __ATOMIC_RELAXED, __HIP_MEMORY_SCOPE_AGENT); }
__device__ __forceinline__ unsigned xb_add(unsigned* p, unsigned v) { return __hip_atomic_fetch_add(p, v, __ATOMIC_RELAXED, __HIP_MEMORY_SCOPE_AGENT); }
__device__ __forceinline__ unsigned xb_xcc_id() { return (unsigned)__builtin_amdgcn_s_getreg((3 << 11) | 20) & 0xFu; }
#define XB_SPIN(cond, bar) do { unsigned _sp = 0; while (cond) { __builtin_amdgcn_s_sleep(1); \
    if ((++_sp & 255u) == 0u) { if (xb_ld(&(bar)[XB_TMO])) break; if (_sp > XB_SPIN_CAP) { atomicAdd(&(bar)[XB_TMO], 1u); break; } } } } while (0)
struct XcdBarrier { unsigned* bar; unsigned x; volatile LAS unsigned* st; int wave; };
__device__ __forceinline__ XcdBarrier xcd_barrier_post(unsigned* bar, volatile LAS unsigned* st) {
    XcdBarrier b; b.bar = bar; b.x = xb_xcc_id(); b.st = st; b.wave = __builtin_amdgcn_readfirstlane((int)(threadIdx.x >> 6));
    if (threadIdx.x == 0) (void)xb_add(&bar[XB_XCNT(b.x)], 1u);
    return b;
}
__device__ __forceinline__ void xcd_barrier_complete(unsigned* bar, unsigned x, unsigned& nloc, unsigned& nx) {
    const unsigned G = gridDim.x * gridDim.y * gridDim.z;
    unsigned sum, cnt, mine, sp = 0u;
    for (;;) {
        sum = 0u; cnt = 0u; mine = 0u;
#pragma unroll
        for (unsigned j = 0; j < 16; ++j) { const unsigned c = xb_ld(&bar[XB_XCNT(j)]); sum += c; cnt += (c > 0u) ? 1u : 0u; mine = (j == x) ? c : mine; }
        if (sum == G) break;
        __builtin_amdgcn_s_sleep(1);
        if ((++sp & 255u) == 0u) { if (xb_ld(&bar[XB_TMO])) break; if (sp > XB_SPIN_CAP) { atomicAdd(&bar[XB_TMO], 1u); break; } }
    }
    nloc = mine > 0u ? mine : 1u; nx = cnt > 0u ? cnt : 1u;
}
__device__ __forceinline__ void xcd_barrier(const XcdBarrier& b) {
    asm volatile("s_waitcnt vmcnt(0)" ::: "memory");
    __syncthreads();
    if (b.wave == 0 && lane_id() == 0) {
        unsigned* bar = b.bar; asm volatile("" : "+s"(bar));
        __builtin_amdgcn_s_waitcnt(0);
        unsigned nloc = b.st[0], nx = b.st[1];
        if (nloc == 0u) { xcd_barrier_complete(bar, b.x, nloc, nx); b.st[0] = nloc; b.st[1] = nx; }
        const unsigned old = xb_add(&bar[XB_XSUB(b.x)], 1u);
        const unsigned gen = old / nloc;
        if (old + 1u == (gen + 1u) * nloc) {
            __builtin_amdgcn_fence(__ATOMIC_RELEASE, "agent");
            asm volatile("s_waitcnt vmcnt(0)" ::: "memory");
            const unsigned og = xb_add(&bar[XB_TOP], 1u);
            const unsigned tg = og / nx;
            if (og + 1u == (tg + 1u) * nx) xb_add(&bar[XB_TOPGEN], 1u);
            else XB_SPIN(xb_ld(&bar[XB_TOPGEN]) == tg, bar);
            __builtin_amdgcn_fence(__ATOMIC_ACQUIRE, "agent");
            xb_add(&bar[XB_XGEN(b.x)], 1u);
            asm volatile("s_waitcnt vmcnt(0)" ::: "memory");
        } else {
            XB_SPIN(xb_ld(&bar[XB_XGEN(b.x)]) == gen, bar);
            __builtin_amdgcn_fence(__ATOMIC_ACQUIRE, "agent");
            asm volatile("s_waitcnt vmcnt(0)" ::: "memory");
        }
    }
    __syncthreads();
}

namespace pg8 {
constexpr int BM = 256, BK = 64, HALF = 128, HTB = HALF * BK * 2, STAGE_BYTES = 8 * HTB, NXCD = 8, WGM = 8;
__device__ __forceinline__ int lds_byte(int r, int c) { const int st = (r >> 4) * 2 + (c >> 5), rr = r & 15, cc = c & 31, ob = rr * 64 + cc * 2; return st * 1024 + (ob ^ (((ob >> 9) & 1) << 5)); }
__device__ __forceinline__ void stage_rc(int b, int& R, int& C) { const int st = b / 1024, sb = b % 1024, swz = sb ^ (((sb >> 9) & 1) << 5); R = (st >> 1) * 16 + swz / 64; C = (st & 1) * 32 + (swz % 64) / 2; }
__device__ __forceinline__ int perm32(int rho) { const int n = rho >> 4, i = rho & 15; return 8 * (i >> 2) + 4 * n + (i & 3); }

struct Unit { const char* A; const char* B; int pm, pn, e, nv; };
typedef int v8i32 __attribute__((ext_vector_type(8)));
typedef int v4i32 __attribute__((ext_vector_type(4)));
__device__ __forceinline__ void mfma_fp8(f32x4& acc, v8i32 b, v8i32 a, int sc) {
    asm volatile("s_nop 1\n\tv_mfma_scale_f32_16x16x128_f8f6f4 %0, %1, %2, %0, %3, %3 op_sel_hi:[0,0,0]" : "+v"(acc) : "v"(b), "v"(a), "v"(sc)); }
__device__ __forceinline__ void mfma_fp8z(f32x4& acc, v8i32 b, v8i32 a, int sc) {
    asm volatile("s_nop 1\n\tv_mfma_scale_f32_16x16x128_f8f6f4 %0, %1, %2, 0, %3, %3 op_sel_hi:[0,0,0]" : "=&v"(acc) : "v"(b), "v"(a), "v"(sc)); }
__device__ __forceinline__ void mfma_bf16(f32x4& acc, bf16x8 b, bf16x8 a) { asm volatile("v_mfma_f32_16x16x32_bf16 %0, %1, %2, %0" : "+v"(acc) : "v"(b), "v"(a)); }
__device__ __forceinline__ void mfma_bf16z(f32x4& acc, bf16x8 b, bf16x8 a) { asm volatile("v_mfma_f32_16x16x32_bf16 %0, %1, %2, 0" : "=&v"(acc) : "v"(b), "v"(a)); }
__device__ __forceinline__ v8i32 cat8(bf16x8 a, bf16x8 b) { return __builtin_shufflevector(__builtin_bit_cast(v4i32, a), __builtin_bit_cast(v4i32, b), 0, 1, 2, 3, 4, 5, 6, 7); }

template <class E, class = void> struct epi_nvm { static constexpr int value = 0; };
template <class E> struct epi_nvm<E, decltype((void)E::NVM)> { static constexpr int value = E::NVM; };
template <class E, class = void> struct epi_nvm2 { static constexpr int value = 0; static __device__ __forceinline__ bool heavy(int) { return false; } };
template <class E> struct epi_nvm2<E, decltype((void)E::NVM2)> { static constexpr int value = E::NVM2; static __device__ __forceinline__ bool heavy(int pn) { return E::heavy(pn); } };
template <bool FP8 = false, bool SP2 = true, bool GATHER = false, class Epi, class Sched>
__device__ __forceinline__ void gemm_phase(LAS unsigned char* lds, int tid, const int lda, const int ldb, const int K, const Sched& S, const Epi& E) {
    asm volatile("" : "+v"(tid));
    const int wid = __builtin_amdgcn_readfirstlane(tid >> 6), lane = tid & 63, wr = wid >> 2, wc = wid & 3, fr = lane & 15, fq = lane >> 4;
    int Kx = K; asm volatile("" : "+s"(Kx));
    const int nt = Kx / BK;
    unsigned voffA[2], voffB[2];
#pragma unroll
    for (int i = 0; i < 2; ++i) { int R, C; stage_rc(tid * 16 + i * 8192, R, C); const int Rb = (R & ~31) + perm32(R & 31);
        voffA[i] = (unsigned)(R * lda + C) * 2u; voffB[i] = (unsigned)(Rb * ldb + C) * 2u; }
    unsigned vc[2][2], vn[2][2];
    LAS unsigned* gslot = (LAS unsigned*)(lds + MISC_OFF) + MW_GIDX + wid * 64;
#define PG8_GIDX_ISSUE(U, buf) do { int lq_ = lane; asm volatile("" : "+v"(lq_)); const int h_ = lq_ >> 5, i_ = (lq_ >> 4) & 1, r_ = lq_ & 15; int row_ = h_ * 128 + (wid >> 1) * 16 + 64 * i_ + r_; row_ = row_ < (U).nv ? row_ : (U).nv - 1; \
        __builtin_amdgcn_global_load_lds((const unsigned*)(U).A + row_, gslot + (buf) * 512, 4, 0, 0); } while (0)
#define PG8_GIDX_READ(buf, V) do { int tq_ = tid; asm volatile("" : "+v"(tq_));     \
        _Pragma("unroll") for (int i_ = 0; i_ < 2; ++i_) { int R_, C_; stage_rc(tq_ * 16 + i_ * 8192, R_, C_); \
        _Pragma("unroll") for (int h_ = 0; h_ < 2; ++h_) (V)[h_][i_] = gslot[(buf) * 512 + h_ * 32 + i_ * 16 + (R_ & 15)] * 1024u + (unsigned)(C_ * 2); } } while (0)
    const size_t kstep = (size_t)(BK * 2);
    const size_t hstepA = (size_t)HALF * lda * 2, hstepB = (size_t)HALF * ldb * 2;
    const unsigned ldsw = (unsigned)wid * 1024u;
    int aoffk[2], boffk[2];
#pragma unroll
    for (int k = 0; k < 2; ++k) { aoffk[k] = FP8 ? lds_byte(wr * 64 + fr, 16 * fq + 8 * k) : lds_byte(wr * 64 + fr, fq * 8) + k * 1024;
                                  boffk[k] = FP8 ? lds_byte(wc * 32 + fr, 16 * fq + 8 * k) : lds_byte(wc * 32 + fr, fq * 8) + k * 1024; }
#define PG8_SA(b, h) (((b) * 2 + (h)) * HTB)
#define PG8_SB(b, h) ((4 + (b) * 2 + (h)) * HTB)
#define PG8_STAGE(bufoff, gbase, voff) do { _Pragma("unroll") for (int _i = 0; _i < 2; ++_i) \
        __builtin_amdgcn_global_load_lds((const unsigned*)((const char*)(gbase) + (voff)[_i]), (LAS unsigned*)(lds + (bufoff) + ldsw + _i * 8192), 16, 0, 0); } while (0)
#define PG8_STAGE_A(bufoff, abase, half, NX) do { if constexpr (GATHER) { if (NX) PG8_STAGE(bufoff, abase, vn[half]); else PG8_STAGE(bufoff, abase, vc[half]); } \
        else PG8_STAGE(bufoff, (abase) + (half) * hstepA, voffA); } while (0)
#define PG8_LDA(dst, b, h) do { _Pragma("unroll") for (int m = 0; m < 4; ++m) _Pragma("unroll") for (int k = 0; k < 2; ++k) dst[m][k] = *(const LAS bf16x8*)(lds + PG8_SA(b, h) + aoffk[k] + m * 2048); } while (0)
#define PG8_LDB(dst, b, h) do { _Pragma("unroll") for (int n = 0; n < 2; ++n) _Pragma("unroll") for (int k = 0; k < 2; ++k) dst[n][k] = *(const LAS bf16x8*)(lds + PG8_SB(b, h) + boffk[k] + n * 2048); } while (0)
#define PG8_MMA(ai, bj, At, Bt) do { __builtin_amdgcn_s_setprio(1); \
        if constexpr (FP8) { _Pragma("unroll") for (int m = 0; m < 4; ++m) _Pragma("unroll") for (int n = 0; n < 2; ++n) mfma_fp8(acc[ai][bj][m][n], cat8(Bt[n][0], Bt[n][1]), cat8(At[m][0], At[m][1]), sc8); } \
        else { _Pragma("unroll") for (int k = 0; k < 2; ++k) _Pragma("unroll") for (int m = 0; m < 4; ++m) _Pragma("unroll") for (int n = 0; n < 2; ++n) mfma_bf16(acc[ai][bj][m][n], Bt[n][k], At[m][k]); } \
        __builtin_amdgcn_s_setprio(0); } while (0)
#define PG8_MMA0(ai, bj, At, Bt) do { if (first_) { __builtin_amdgcn_s_setprio(1); \
        if constexpr (FP8) { _Pragma("unroll") for (int m = 0; m < 4; ++m) _Pragma("unroll") for (int n = 0; n < 2; ++n) mfma_fp8z(acc[ai][bj][m][n], cat8(Bt[n][0], Bt[n][1]), cat8(At[m][0], At[m][1]), sc8); } \
        else { _Pragma("unroll") for (int m = 0; m < 4; ++m) _Pragma("unroll") for (int n = 0; n < 2; ++n) mfma_bf16z(acc[ai][bj][m][n], Bt[n][0], At[m][0]); \
               _Pragma("unroll") for (int m = 0; m < 4; ++m) _Pragma("unroll") for (int n = 0; n < 2; ++n) mfma_bf16(acc[ai][bj][m][n], Bt[n][1], At[m][1]); } \
        __builtin_amdgcn_s_setprio(0); } else PG8_MMA(ai, bj, At, Bt); } while (0)
#define PG8_ZERO_ACC() do { _Pragma("unroll") for (int a = 0; a < 2; ++a) _Pragma("unroll") for (int b = 0; b < 2; ++b) _Pragma("unroll") for (int m = 0; m < 4; ++m) \
        _Pragma("unroll") for (int n = 0; n < 2; ++n) acc[a][b][m][n] = (f32x4){0.f, 0.f, 0.f, 0.f}; } while (0)
#define PG8_WAIT_V(n) asm volatile("s_waitcnt vmcnt(" #n ")" ::: "memory")
#define PG8_WAIT_L(n) asm volatile("s_waitcnt lgkmcnt(" #n ")" ::: "memory")
#define PG8_BAR __builtin_amdgcn_s_barrier()
#define PG8_SCHED __builtin_amdgcn_sched_barrier(0)
    Unit cur, nxt; int ui = 0, prev_pn = 0;
    if (!S.next(0, cur)) return;
    f32x4 acc[2][2][4][2];
    bf16x8 At[4][2], B0[2][2], B1[2][2];
    int sc8 = 0x7F7F7F7F; if constexpr (FP8) asm volatile("" : "+v"(sc8));
    const char* cA = cur.A; const char* cB = cur.B;
    if constexpr (GATHER) { cA = S.X; PG8_GIDX_ISSUE(cur, 0); asm volatile("s_waitcnt vmcnt(0)" ::: "memory"); PG8_GIDX_READ(0, vc);
#pragma unroll
        for (int h_ = 0; h_ < 2; ++h_) { vn[h_][0] = vc[h_][0]; vn[h_][1] = vc[h_][1]; } }
    if constexpr (SP2) {
        PG8_STAGE(PG8_SB(0, 0), cB, voffB); PG8_STAGE(PG8_SB(0, 1), cB + hstepB, voffB); PG8_STAGE_A(PG8_SA(0, 0), cA, 0, false); PG8_STAGE_A(PG8_SA(0, 1), cA, 1, false);
        if (wr == 1) PG8_BAR;
        PG8_WAIT_V(2); PG8_BAR;
        PG8_STAGE(PG8_SB(1, 0), cB + kstep, voffB); PG8_STAGE_A(PG8_SA(1, 0), cA + kstep, 0, false); PG8_STAGE(PG8_SB(1, 1), cB + hstepB + kstep, voffB);
        PG8_WAIT_V(6); PG8_BAR;
    } else {
    PG8_STAGE(PG8_SB(0, 0), cB, voffB); PG8_STAGE(PG8_SA(0, 0), cA, voffA); PG8_STAGE(PG8_SB(0, 1), cB + hstepB, voffB); PG8_STAGE(PG8_SA(0, 1), cA + hstepA, voffA);
    if (wr == 1) PG8_BAR;
    PG8_WAIT_V(4); PG8_BAR;
    PG8_STAGE(PG8_SB(1, 0), cB + kstep, voffB); PG8_STAGE(PG8_SA(1, 0), cA + kstep, voffA); PG8_STAGE(PG8_SB(1, 1), cB + hstepB + kstep, voffB);
    PG8_WAIT_V(6); PG8_BAR;
    }
    for (;;) {
        const bool has_next = S.next(ui + 1, nxt);
        const char* nA = GATHER ? cA : (has_next ? nxt.A : cA); const char* nB = has_next ? nxt.B : cB;
        if constexpr (GATHER) { if (has_next) PG8_GIDX_ISSUE(nxt, (ui + 1) & 1); }
        for (int t = 0; t < nt; t += 2) {
            const bool last = (t == nt - 2), first_ = (t == 0), relax_ = first_ && ui > 0, relax2_ = relax_ && epi_nvm2<Epi>::heavy(prev_pn);
#define PG8_WAIT_V8R() do { if constexpr (epi_nvm<Epi>::value > 0) { \
            if constexpr (epi_nvm2<Epi>::value > 0) { if (relax2_) asm volatile("s_waitcnt vmcnt(%0)" :: "n"(8 + epi_nvm2<Epi>::value) : "memory"); \
                else if (relax_) asm volatile("s_waitcnt vmcnt(%0)" :: "n"(8 + epi_nvm<Epi>::value) : "memory"); else PG8_WAIT_V(8); } \
            else { if (relax_) asm volatile("s_waitcnt vmcnt(%0)" :: "n"(8 + epi_nvm<Epi>::value) : "memory"); else PG8_WAIT_V(8); } } else PG8_WAIT_V(8); } while (0)
            if constexpr (GATHER) { if (last && has_next) PG8_GIDX_READ((ui + 1) & 1, vn); }
            const char* a1 = cA + (size_t)(t + 1) * kstep;
            const char* a2 = last ? nA : cA + (size_t)(t + 2) * kstep; const char* b2 = last ? nB : cB + (size_t)(t + 2) * kstep;
            const char* a3 = a2 + kstep; const char* b3 = b2 + kstep;
            if constexpr (SP2) {
            PG8_LDB(B0, 0, 0); PG8_LDB(B1, 0, 1); PG8_SCHED; PG8_LDA(At, 0, 0); PG8_STAGE_A(PG8_SA(1, 1), a1, 1, false);
            PG8_WAIT_V8R(); PG8_WAIT_L(0); PG8_BAR; PG8_MMA0(0, 0, At, B0); PG8_MMA0(0, 1, At, B1); PG8_BAR; PG8_SCHED;
            PG8_LDA(At, 0, 1); PG8_STAGE(PG8_SB(0, 0), b2, voffB); PG8_STAGE(PG8_SB(0, 1), b2 + hstepB, voffB); PG8_STAGE_A(PG8_SA(0, 0), a2, 0, last);
            PG8_WAIT_V8R(); PG8_WAIT_L(0); PG8_BAR; PG8_MMA0(1, 0, At, B0); PG8_MMA0(1, 1, At, B1); PG8_BAR; PG8_SCHED;
            PG8_LDB(B0, 1, 0); PG8_LDB(B1, 1, 1); PG8_SCHED; PG8_LDA(At, 1, 0); PG8_STAGE_A(PG8_SA(0, 1), a2, 1, last);
            PG8_WAIT_V8R(); PG8_WAIT_L(0); PG8_BAR; PG8_MMA(0, 0, At, B0); PG8_MMA(0, 1, At, B1); PG8_BAR; PG8_SCHED;
            PG8_LDA(At, 1, 1); PG8_STAGE(PG8_SB(1, 0), b3, voffB); PG8_STAGE(PG8_SB(1, 1), b3 + hstepB, voffB); PG8_STAGE_A(PG8_SA(1, 0), a3, 0, last);
            PG8_WAIT_V(8); PG8_WAIT_L(0); PG8_BAR; PG8_MMA(1, 0, At, B0); PG8_MMA(1, 1, At, B1); PG8_BAR; PG8_SCHED;
            } else {
            PG8_LDB(B0, 0, 0); PG8_SCHED; PG8_LDA(At, 0, 0); PG8_STAGE(PG8_SA(1, 1), a1 + hstepA, voffA);
            PG8_WAIT_L(8); PG8_BAR; PG8_WAIT_L(0); PG8_MMA(0, 0, At, B0); PG8_BAR; PG8_SCHED;
            PG8_LDB(B1, 0, 1); PG8_STAGE(PG8_SB(0, 0), b2, voffB);
            PG8_BAR; PG8_WAIT_L(0); PG8_MMA(0, 1, At, B1); PG8_BAR;
            PG8_LDA(At, 0, 1); PG8_STAGE(PG8_SA(0, 0), a2, voffA);
            PG8_BAR; PG8_WAIT_L(0); PG8_MMA(1, 0, At, B0); PG8_BAR; PG8_SCHED;
            PG8_STAGE(PG8_SB(0, 1), b2 + hstepB, voffB);
            PG8_WAIT_V(6); PG8_BAR; PG8_MMA(1, 1, At, B1); PG8_BAR;
            PG8_LDB(B0, 1, 0); PG8_SCHED; PG8_LDA(At, 1, 0); PG8_STAGE(PG8_SA(0, 1), a2 + hstepA, voffA);
            PG8_WAIT_L(8); PG8_BAR; PG8_WAIT_L(0); PG8_MMA(0, 0, At, B0); PG8_BAR; PG8_SCHED;
            PG8_LDB(B1, 1, 1); PG8_STAGE(PG8_SB(1, 0), b3, voffB);
            PG8_BAR; PG8_WAIT_L(0); PG8_MMA(0, 1, At, B1); PG8_BAR;
            PG8_LDA(At, 1, 1); PG8_STAGE(PG8_SA(1, 0), a3, voffA);
            PG8_BAR; PG8_WAIT_L(0); PG8_MMA(1, 0, At, B0); PG8_BAR; PG8_SCHED;
            PG8_STAGE(PG8_SB(1, 1), b3 + hstepB, voffB);
            PG8_WAIT_V(6); PG8_BAR; PG8_MMA(1, 1, At, B1); PG8_BAR;
            }
        }
        asm volatile("s_nop 15\n\ts_nop 15" ::: "memory");
        E(acc, cur, wr, wc, fr, fq);
        if (!has_next) break;
        prev_pn = cur.pn;
        cur = nxt; cA = nA; cB = nB; ++ui;
        if constexpr (GATHER) {
#pragma unroll
            for (int h_ = 0; h_ < 2; ++h_) { vc[h_][0] = vn[h_][0]; vc[h_][1] = vn[h_][1]; } }
    }
    PG8_WAIT_V(0);
    if (wr == 0) PG8_BAR;
    PG8_BAR;
#undef PG8_SA
#undef PG8_SB
#undef PG8_STAGE
#undef PG8_LDA
#undef PG8_STAGE_A
#undef PG8_GIDX_ISSUE
#undef PG8_GIDX_READ
#undef PG8_LDB
#undef PG8_MMA
#undef PG8_WAIT_V
#undef PG8_WAIT_L
#undef PG8_BAR
#undef PG8_SCHED
}
}
using pg8::Unit;
typedef f32x4 Acc[2][2][4][2];

#define EPI_OPAQUE() int fr_ = fr, fq_ = fq; asm volatile("" : "+v"(fr_), "+v"(fq_))
#define EPI_BEGIN _Pragma("unroll") for (int ai = 0; ai < 2; ++ai) _Pragma("unroll") for (int m = 0; m < 4; ++m) { EPI_OPAQUE(); const int row = ai * 128 + wr * 64 + m * 16 + fr_; \
    _Pragma("unroll") for (int bj = 0; bj < 2; ++bj) { const int col = bj * 128 + wc * 32 + fq_ * 8; f32x4 v0 = acc[ai][bj][m][0], v1 = acc[ai][bj][m][1];
#define EPI_END } }

struct Params {
    const float* in[26];
    float* out;
    unsigned char* ws;
};
typedef const __attribute__((address_space(4))) Params* KPtr;

struct DenseSched {
    const char* A; const char* B; size_t tA, tB; int nM, nN, nwg, G, c;
    __device__ __forceinline__ void init(const void* A_, const void* B_, int M, int N, int lda, int ldb, int G_, int c_) {
        A = (const char*)A_; B = (const char*)B_; tA = (size_t)256 * lda * 2; tB = (size_t)256 * ldb * 2; nM = M / 256; nN = N / 256; nwg = nM * nN; G = G_; c = c_; }
    __device__ __forceinline__ bool next(int i, Unit& u) const {
        const long L = (long)i * G + c; if (L >= nwg) return false;
        int wgid = (int)L; { const int q = nwg / 8, r = nwg % 8, xcd = wgid % 8, off = wgid / 8; wgid = (xcd < r ? xcd * (q + 1) : r * (q + 1) + (xcd - r) * q) + off; }
        const int nig = 8 * nN, gid = wgid / nig, fm = gid * 8, gsz = (nM - fm) < 8 ? (nM - fm) : 8;
        u.pm = fm + ((wgid % nig) % gsz); u.pn = (wgid % nig) / gsz; u.e = 0;
        u.A = A + (size_t)u.pm * tA; u.B = B + (size_t)u.pn * tB; return true;
    }
};
struct SchedG2 {
    const char* Q; const char* K; int G, c;
    __device__ __forceinline__ bool next(int i, Unit& u) const {
        const int L = i * G + c; if (L >= 512) return false;
        const int bh = L >> 5, n = L & 31, b = bh >> 2, h = bh & 3, t0 = b * 8192 + n * 256;
        const size_t off = ((size_t)t0 * 1024 + h * 256) * 2;
        u.A = Q + ((size_t)t0 * 2048 + h * 512 + 256) * 2; u.B = K + off; u.pm = t0 >> 8; u.pn = h; u.e = L; return true;
    }
};
struct SchedG3 {
    const char* VS; const char* KDT; int G, c;
    __device__ __forceinline__ bool next(int i, Unit& u) const {
        const int L = i * G + c; if (L >= 1024) return false;
        const int cidx = L >> 1, half = L & 1;
        u.A = VS + (size_t)cidx * 524288 + (size_t)half * 262144; u.B = KDT + (size_t)cidx * 131072; u.pm = half; u.pn = 0; u.e = cidx; return true;
    }
};
struct SchedG4 {
    const char* ACAT; const char* VS; int G, c;
    __device__ __forceinline__ bool next(int i, Unit& u) const {
        const int L = i * G + c; if (L >= 1024) return false;
        const int cidx = L >> 1, half = L & 1, bh = cidx >> 5, n = cidx & 31, b = bh >> 2, h = bh & 3, t0 = b * 8192 + n * 256;
        u.A = ACAT + ((size_t)t0 * 2048 + h * 512) * 2; u.B = VS + (size_t)cidx * 524288 + (size_t)half * 262144; u.pm = t0 >> 8; u.pn = h * 2 + half; u.e = cidx; return true;
    }
};
struct MoeSched {
    const char* A; const char* W; size_t wstride; int NT, G, c; volatile LAS unsigned* misc; const char* X; const int* TOKL;
    __device__ __forceinline__ bool next(int i, Unit& u) const {
        const int L = i * G + c; const int nrb = __builtin_amdgcn_readfirstlane((int)misc[MW_NRB]); if (L >= nrb * NT) return false;
        const int rb = L / NT, pn = L - rb * NT; const int e = __builtin_amdgcn_readfirstlane((int)((volatile LAS unsigned char*)(misc + MW_RBEXP))[rb]);
        u.B = W + (size_t)e * wstride + (size_t)pn * (256 * 1024); u.pm = rb; u.pn = pn; u.e = e;
        if (TOKL) { const int j0 = rb * 256 - __builtin_amdgcn_readfirstlane((int)misc[MW_PSTART + e]); u.A = (const char*)(TOKL + (size_t)e * T + j0); u.nv = __builtin_amdgcn_readfirstlane((int)misc[MW_CNT + e]) - j0; }
        else { u.A = A + (size_t)rb * (256 * 1024); u.nv = 256; }
        return true;
    }
};

__device__ __forceinline__ float log2gamma(int h) { return __log2f(1.0f - __builtin_amdgcn_exp2f(-5.0f - (float)h)); }
__device__ __forceinline__ void rope8(f32x4& v0, f32x4& v1, const f32x4 c, const f32x4 s) {
    f32x4 a, b;
    a[0] = v0[0] * c[0] - v0[1] * s[0]; a[1] = v0[0] * s[0] + v0[1] * c[0];
    a[2] = v0[2] * c[1] - v0[3] * s[1]; a[3] = v0[2] * s[1] + v0[3] * c[1];
    b[0] = v1[0] * c[2] - v1[1] * s[2]; b[1] = v1[0] * s[2] + v1[1] * c[2];
    b[2] = v1[2] * c[3] - v1[3] * s[3]; b[3] = v1[2] * s[3] + v1[3] * c[3];
    v0 = a; v1 = b;
}
struct EpiRetA {
    static constexpr int NVM = 16;
    static constexpr int NVM2 = 48;
    static __device__ __forceinline__ bool heavy(int pn) { return pn < 4 || pn >= 12; }
    bf16_t* QB; bf16_t* ACAT; bf16_t* GB; bf16_t* KB; const float* COSR; const float* SINR; bf16_t* KDT;
    __device__ __forceinline__ void operator()(const Acc& acc, const Unit& u, int wr, int wc, int fr, int fq) const {
        const int pn = u.pn, t0 = u.pm * 256;
        if (pn < 4 || pn >= 12) {
            const int head = pn < 4 ? pn : pn - 12; const float l2g = log2gamma(head);
            EPI_OPAQUE();
            const int rbase = wr * 64 + fr_, cb = wc * 32 + fq_ * 8;
            f32x4 cc[2], ss[2], cn[2], sn[2];
#define ROPE_LD(it, C_, S_) do { const size_t o_ = (size_t)(t0 + rbase + ((it) >> 2) * 128 + ((it) & 3) * 16) * 128 + (cb >> 1); \
                C_[0] = *(const f32x4*)(COSR + o_); C_[1] = *(const f32x4*)(COSR + o_ + 64); S_[0] = *(const f32x4*)(SINR + o_); S_[1] = *(const f32x4*)(SINR + o_ + 64); } while (0)
            ROPE_LD(0, cc, ss);
#pragma unroll
            for (int it = 0; it < 8; ++it) { const int ai = it >> 2, m = it & 3, row = ai * 128 + m * 16 + rbase, t = t0 + row;
                if (it < 7) ROPE_LD(it + 1, cn, sn);
#pragma unroll
                for (int bj = 0; bj < 2; ++bj) { const int col = bj * 128 + cb; f32x4 v0 = acc[ai][bj][m][0], v1 = acc[ai][bj][m][1];
                    rope8(v0, v1, cc[bj], ss[bj]);
                    if (pn < 4) {
                        const float f = __builtin_amdgcn_exp2f(l2g * (float)(row + 1));
                        *(u32x4*)(ACAT + (size_t)t * 2048 + head * 512 + 256 + col) = pack8(v0 * f, v1 * f);
                    } else {
                        v0 = v0 * 0.0625f; v1 = v1 * 0.0625f;
                        *(u32x4*)(KB + (size_t)t * 1024 + head * 256 + col) = pack8(v0, v1);
                        const float fd = __builtin_amdgcn_exp2f(l2g * (float)(255 - row));
                        float xk[8] = {v0[0] * fd, v0[1] * fd, v0[2] * fd, v0[3] * fd, v1[0] * fd, v1[1] * fd, v1[2] * fd, v1[3] * fd};
                        xpose8(xk, fr_);
                        bf16_t* kd = KDT + ((size_t)(((t0 >> 13) * 4 + head) * 32 + ((t0 >> 8) & 31))) * 65536 + (size_t)(col + (fr_ & 7)) * 256 + (row & ~7);
                        u32x4 w; w.x = cvt_pk_bf16(xk[0], xk[1]); w.y = cvt_pk_bf16(xk[2], xk[3]); w.z = cvt_pk_bf16(xk[4], xk[5]); w.w = cvt_pk_bf16(xk[6], xk[7]);
                        *(u32x4*)kd = w;
                    } }
                cc[0] = cn[0]; cc[1] = cn[1]; ss[0] = sn[0]; ss[1] = sn[1]; }
#undef ROPE_LD
        } else {
            EPI_BEGIN
                const int t = t0 + row;
                *(u32x4*)(GB + (size_t)t * 2048 + (pn - 4) * 256 + col) = pack8(v0, v1);
            EPI_END
        }
    }
};
struct EpiRetB {
    static constexpr int NVM = 16;
    bf16_t* VS; float asc = 1.0f;
    __device__ __forceinline__ void operator()(const Acc& acc, const Unit& u, int wr, int wc, int fr, int fq) const {
        const int pm = u.pm, b = u.pn >> 5, n = u.pn & 31, hh = pm >> 1, dvb = (pm & 1) * 256;
        EPI_BEGIN
            *(u32x4*)(VS + ((size_t)((b * 4 + hh) * 32 + n)) * 262144 + (size_t)(dvb + row) * 512 + col) = pack8(v0 * asc, v1 * asc);
        EPI_END
    }
};
struct EpiRetP {
    static constexpr int NVM = 16;
    bf16_t* ACAT;
    __device__ __forceinline__ void operator()(const Acc& acc, const Unit& u, int wr, int wc, int fr, int fq) const {
        const int t0 = u.pm * 256, h = u.pn; const float l2g = -log2gamma(h);
        f32x4 cf[2][2];
        { int fq1 = fq; asm volatile("" : "+v"(fq1));
#pragma unroll
          for (int bj = 0; bj < 2; ++bj)
#pragma unroll
              for (int j = 0; j < 4; ++j) { const int c0 = bj * 128 + wc * 32 + fq1 * 8 + j; cf[bj][0][j] = __builtin_amdgcn_exp2f(l2g * (float)(c0 + 1)); cf[bj][1][j] = __builtin_amdgcn_exp2f(l2g * (float)(c0 + 5)); } }
        EPI_BEGIN
            v0 = v0 * cf[bj][0]; v1 = v1 * cf[bj][1];
#pragma unroll
            for (int j = 0; j < 4; ++j) { const int d0 = row - (col + j), d1 = row - (col + 4 + j); v0[j] = d0 >= 0 ? v0[j] : 0.f; v1[j] = d1 >= 0 ? v1[j] : 0.f; }
            *(u32x4*)(ACAT + (size_t)(t0 + row) * 2048 + h * 512 + col) = pack8(v0, v1);
        EPI_END
    }
};
struct EpiRetU {
    static constexpr int NVM = 16;
    bf16_t* VS;
    __device__ __forceinline__ void operator()(const Acc& acc, const Unit& u, int wr, int wc, int fr, int fq) const {
        bf16_t* base = VS + (size_t)u.e * 262144 + (size_t)(u.pm * 256) * 512 + 256;
        EPI_BEGIN
            *(u32x4*)(base + (size_t)row * 512 + col) = pack8(v0, v1);
        EPI_END
    }
};
struct EpiBf16 {
    static constexpr int NVM = 16;
    bf16_t* O; int ldc; float asc = 1.0f;
    __device__ __forceinline__ void operator()(const Acc& acc, const Unit& u, int wr, int wc, int fr, int fq) const {
        bf16_t* base = O + (size_t)(u.pm * 256) * ldc + u.pn * 256;
        EPI_BEGIN
            *(u32x4*)(base + (size_t)row * ldc + col) = pack8(v0 * asc, v1 * asc);
        EPI_END
    }
};
struct EpiF32 {
    float* O; int ldc;
    __device__ __forceinline__ void operator()(const Acc& acc, const Unit& u, int wr, int wc, int fr, int fq) const {
        float* base = O + (size_t)(u.pm * 256) * ldc + u.pn * 256;
        EPI_BEGIN
            *(f32x4*)(base + (size_t)row * ldc + col) = v0; *(f32x4*)(base + (size_t)row * ldc + col + 4) = v1;
        EPI_END
    }
};
struct EpiKVA {
    bf16_t* CKV; float* SSQ; bf16_t* KBUF; const float* COSM; const float* SINM; float asc;
    __device__ __forceinline__ void operator()(const Acc& acc, const Unit& u, int wr, int wc, int fr, int fq) const {
        const int t0 = u.pm * 256;
        if (u.pn == 0) {
#pragma unroll
            for (int ai = 0; ai < 2; ++ai)
#pragma unroll
                for (int m = 0; m < 4; ++m) { EPI_OPAQUE(); const int t = t0 + ai * 128 + wr * 64 + m * 16 + fr_; float ss = 0.f;
#pragma unroll
                    for (int bj = 0; bj < 2; ++bj) { const int col = bj * 128 + wc * 32 + fq_ * 8; const f32x4 v0 = acc[ai][bj][m][0] * asc, v1 = acc[ai][bj][m][1] * asc;
                        ss += (v0[0] * v0[0] + v0[1] * v0[1]) + (v0[2] * v0[2] + v0[3] * v0[3]) + (v1[0] * v1[0] + v1[1] * v1[1]) + (v1[2] * v1[2] + v1[3] * v1[3]);
                        *(u32x4*)(CKV + (size_t)t * 256 + col) = pack8(v0, v1); }
                    ss += __shfl_xor(ss, 16); ss += __shfl_xor(ss, 32);
                    if (fq_ == 0) SSQ[(size_t)t * 4 + wc] = ss; }
        } else {
            if (wc < 2) {
#pragma unroll
                for (int ai = 0; ai < 2; ++ai)
#pragma unroll
                    for (int m = 0; m < 4; ++m) { EPI_OPAQUE(); const int t = t0 + ai * 128 + wr * 64 + m * 16 + fr_; const int col = wc * 32 + fq_ * 8;
                        f32x4 v0 = acc[ai][0][m][0] * asc, v1 = acc[ai][0][m][1] * asc;
                        const f32x4 c4 = *(const f32x4*)(COSM + (size_t)t * 32 + (col >> 1)), s4 = *(const f32x4*)(SINM + (size_t)t * 32 + (col >> 1));
                        rope8(v0, v1, c4, s4);
#if ATT_FP8
                        u32x2 w8; w8.x = cvt4_fp8(v0[0], v0[1], v0[2], v0[3]); w8.y = cvt4_fp8(v1[0], v1[1], v1[2], v1[3]);
#pragma unroll
                        for (int h = 0; h < 8; ++h) *(u32x2*)((unsigned char*)KBUF + (size_t)t * 1536 + h * 192 + 128 + col) = w8; }
#else
                        const u32x4 w = pack8(v0, v1);
#pragma unroll
                        for (int h = 0; h < 8; ++h) *(u32x4*)(KBUF + (size_t)t * 1536 + h * 192 + 128 + col) = w; }
#endif
            }
        }
    }
};
struct EpiKVB {
    bf16_t* KBUF; bf16_t* VBUF; const float* SSQ;
    __device__ __forceinline__ void operator()(const Acc& acc, const Unit& u, int wr, int wc, int fr, int fq) const {
        const int t0 = u.pm * 256, head = u.pn;
        EPI_OPAQUE(); const int rbase = t0 + wr * 64 + fr_, c = wc * 32 + fq_ * 8;
        f32x4 sq[8];
#pragma unroll
        for (int it = 0; it < 8; ++it) sq[it] = *(const f32x4*)(SSQ + (size_t)(rbase + (it >> 2) * 128 + (it & 3) * 16) * 4);
#pragma unroll
        for (int it = 0; it < 8; ++it) { const int ai = it >> 2, m = it & 3, t = rbase + ai * 128 + m * 16;
            const float rstd = rsqrtf(((sq[it][0] + sq[it][1]) + (sq[it][2] + sq[it][3])) * (1.0f / 256.0f) + RMS_EPS);
#if ATT_FP8
            { const f32x4 k0 = acc[ai][0][m][0] * rstd, k1 = acc[ai][0][m][1] * rstd; u32x2 w8; w8.x = cvt4_fp8(k0[0], k0[1], k0[2], k0[3]); w8.y = cvt4_fp8(k1[0], k1[1], k1[2], k1[3]);
              *(u32x2*)((unsigned char*)KBUF + (size_t)t * 1536 + head * 192 + c) = w8;
              const int sq_ = t & 8191, kk = sq_ & 63, k5 = kk & 31, pos = (((k5 >> 2) & 1) << 5) + (k5 & 3) + 4 * (k5 >> 3) + 16 * (kk >> 5);
              unsigned char* vp = (unsigned char*)VBUF + ((size_t)(((t >> 13) * 8 + head) * 128 + (sq_ >> 6)) * 128 + c) * 64 + pos;
              const float vs_ = rstd * ATT_VS; const f32x4 v0 = acc[ai][1][m][0] * vs_, v1 = acc[ai][1][m][1] * vs_;
              const unsigned wa = cvt4_fp8(v0[0], v0[1], v0[2], v0[3]), wb = cvt4_fp8(v1[0], v1[1], v1[2], v1[3]);
              vp[0 * 64] = (unsigned char)(wa); vp[1 * 64] = (unsigned char)(wa >> 8); vp[2 * 64] = (unsigned char)(wa >> 16); vp[3 * 64] = (unsigned char)(wa >> 24);
              vp[4 * 64] = (unsigned char)(wb); vp[5 * 64] = (unsigned char)(wb >> 8); vp[6 * 64] = (unsigned char)(wb >> 16); vp[7 * 64] = (unsigned char)(wb >> 24); } }
#else
            *(u32x4*)(KBUF + (size_t)t * 1536 + head * 192 + c) = pack8(acc[ai][0][m][0] * rstd, acc[ai][0][m][1] * rstd);
            *(u32x4*)(VBUF + (size_t)t * 1024 + head * 128 + c) = pack8(acc[ai][1][m][0] * rstd, acc[ai][1][m][1] * rstd); }
#endif
    }
};
struct EpiQA {
    bf16_t* QLAT; float* SSQ2; float asc;
    __device__ __forceinline__ void operator()(const Acc& acc, const Unit& u, int wr, int wc, int fr, int fq) const {
        const int t0 = u.pm * 256;
#pragma unroll
        for (int ai = 0; ai < 2; ++ai)
#pragma unroll
            for (int m = 0; m < 4; ++m) { EPI_OPAQUE(); const int t = t0 + ai * 128 + wr * 64 + m * 16 + fr_; float ss = 0.f;
#pragma unroll
                for (int bj = 0; bj < 2; ++bj) { const int col = bj * 128 + wc * 32 + fq_ * 8; const f32x4 v0 = acc[ai][bj][m][0] * asc, v1 = acc[ai][bj][m][1] * asc;
                    ss += (v0[0] * v0[0] + v0[1] * v0[1]) + (v0[2] * v0[2] + v0[3] * v0[3]) + (v1[0] * v1[0] + v1[1] * v1[1]) + (v1[2] * v1[2] + v1[3] * v1[3]);
                    *(u32x4*)(QLAT + (size_t)t * 256 + col) = pack8(v0, v1); }
                ss += __shfl_xor(ss, 16); ss += __shfl_xor(ss, 32);
                if (fq_ == 0) SSQ2[(size_t)t * 4 + wc] = ss; }
    }
};
struct EpiQB {
    bf16_t* QBUF; const float* SSQ2; const float* COSM; const float* SINM;
    __device__ __forceinline__ void operator()(const Acc& acc, const Unit& u, int wr, int wc, int fr, int fq) const {
        const int t0 = u.pm * 256, pn = u.pn;
        EPI_OPAQUE(); const int rbase = t0 + wr * 64 + fr_, cb = wc * 32 + fq_ * 8;
        float scv[8];
        { f32x4 sq[8];
#pragma unroll
          for (int it = 0; it < 8; ++it) sq[it] = *(const f32x4*)(SSQ2 + (size_t)(rbase + (it >> 2) * 128 + (it & 3) * 16) * 4);
#pragma unroll
          for (int it = 0; it < 8; ++it) scv[it] = rsqrtf(((sq[it][0] + sq[it][1]) + (sq[it][2] + sq[it][3])) * (1.0f / 256.0f) + RMS_EPS) * 0.10411767f; }
        if (pn < 4) {
#pragma unroll
            for (int it = 0; it < 8; ++it) { const int ai = it >> 2, m = it & 3, t = rbase + ai * 128 + m * 16;
                const float sc = scv[it];
#pragma unroll
#if ATT_FP8
                for (int bj = 0; bj < 2; ++bj) { const f32x4 a0 = acc[ai][bj][m][0] * (sc * ATT_QS), a1 = acc[ai][bj][m][1] * (sc * ATT_QS); u32x2 w8; w8.x = cvt4_fp8(a0[0], a0[1], a0[2], a0[3]); w8.y = cvt4_fp8(a1[0], a1[1], a1[2], a1[3]);
                    *(u32x2*)((unsigned char*)QBUF + (size_t)t * 1536 + (2 * pn + bj) * 192 + cb) = w8; } }
#else
                for (int bj = 0; bj < 2; ++bj) *(u32x4*)(QBUF + (size_t)t * 1536 + (2 * pn + bj) * 192 + cb) = pack8(acc[ai][bj][m][0] * sc, acc[ai][bj][m][1] * sc); }
#endif
        } else {
            f32x4 cc[2], ss[2], cn[2], sn[2];
#define QROPE_LD(it, C_, S_) do { const size_t o_ = (size_t)(rbase + ((it) >> 2) * 128 + ((it) & 3) * 16) * 32 + ((cb & 63) >> 1); \
                C_[0] = *(const f32x4*)(COSM + o_); S_[0] = *(const f32x4*)(SINM + o_); C_[1] = C_[0]; S_[1] = S_[0]; } while (0)
            QROPE_LD(0, cc, ss);
#pragma unroll
            for (int it = 0; it < 8; ++it) { const int ai = it >> 2, m = it & 3, t = rbase + ai * 128 + m * 16;
                if (it < 7) QROPE_LD(it + 1, cn, sn);
                const float sc = scv[it];
#pragma unroll
                for (int bj = 0; bj < 2; ++bj) { const int col = bj * 128 + cb, head = 4 * (pn - 4) + (col >> 6), rr = col & 63;
                    f32x4 v0 = acc[ai][bj][m][0] * sc, v1 = acc[ai][bj][m][1] * sc;
                    rope8(v0, v1, cc[bj], ss[bj]);
#if ATT_FP8
                    { u32x2 w8; w8.x = cvt4_fp8(v0[0] * ATT_QS, v0[1] * ATT_QS, v0[2] * ATT_QS, v0[3] * ATT_QS); w8.y = cvt4_fp8(v1[0] * ATT_QS, v1[1] * ATT_QS, v1[2] * ATT_QS, v1[3] * ATT_QS);
                      *(u32x2*)((unsigned char*)QBUF + (size_t)t * 1536 + head * 192 + 128 + rr) = w8; } }
#else
                    *(u32x4*)(QBUF + (size_t)t * 1536 + head * 192 + 128 + rr) = pack8(v0, v1); }
#endif
                cc[0] = cn[0]; cc[1] = cn[1]; ss[0] = sn[0]; ss[1] = sn[1]; }
#undef QROPE_LD
        }
    }
};
__device__ __forceinline__ void st_pair8(unsigned char* p, size_t rs, int fq, u32x2 a, u32x2 b) {
    const auto x = __builtin_amdgcn_permlane16_swap(a.x, b.x, false, false), y = __builtin_amdgcn_permlane16_swap(a.y, b.y, false, false);
    const u32x4 o = {x[0], y[0], x[1], y[1]};
    unsigned char* q = (fq & 1) ? p + rs - 8 : p;
    *(u32x4*)q = o;
}
__device__ __forceinline__ f32x2 swiglu2(f32x2 ag, f32x2 au, f32x2 bg, f32x2 bu) {
    constexpr float ws_ = 1.0f / WGU_SCALE, ka = -SWIGLU_ALPHA * 1.4426950408889634f;
    f32x2 g = __builtin_elementwise_fma(ag, (f32x2){ws_, ws_}, bg), u = __builtin_elementwise_fma(au, (f32x2){ws_, ws_}, bu);
    g[0] = __builtin_amdgcn_fmed3f(g[0], -24.0f, SWIGLU_LIMIT); g[1] = __builtin_amdgcn_fmed3f(g[1], -24.0f, SWIGLU_LIMIT);
    u[0] = __builtin_amdgcn_fmed3f(u[0], -SWIGLU_LIMIT, SWIGLU_LIMIT); u[1] = __builtin_amdgcn_fmed3f(u[1], -SWIGLU_LIMIT, SWIGLU_LIMIT);
    const f32x2 t = g * (f32x2){ka, ka};
    f32x2 e = {__builtin_amdgcn_exp2f(t[0]), __builtin_amdgcn_exp2f(t[1])}; e = e + (f32x2){1.0f, 1.0f};
    const float rp = __builtin_amdgcn_rcpf(e[0] * e[1]);
    const f32x2 sg = (f32x2){e[1], e[0]} * (f32x2){rp, rp};
    const f32x2 w = __builtin_elementwise_fma(u, (f32x2){ACT_SCALE, ACT_SCALE}, (f32x2){ACT_SCALE, ACT_SCALE});
    return (g * sg) * w;
}
struct EpiGU {
    static constexpr int NVM = 8;
    unsigned char* ACT; const float* bias;
    __device__ __forceinline__ void operator()(const Acc& acc, const Unit& u, int wr, int wc, int fr, int fq) const {
        int fq0 = fq; asm volatile("" : "+v"(fq0));
        const int c = u.pn * 128 + wc * 32 + fq0 * 8; const float* bg = bias + (size_t)u.e * 2048 + c;
        const f32x4 bg0 = *(const f32x4*)bg, bg1 = *(const f32x4*)(bg + 4), bu0 = *(const f32x4*)(bg + 1024), bu1 = *(const f32x4*)(bg + 1028);
#define LO2(v) __builtin_shufflevector(v, v, 0, 1)
#define HI2(v) __builtin_shufflevector(v, v, 2, 3)
#pragma unroll
        for (int ai = 0; ai < 2; ++ai)
#pragma unroll
            for (int mp = 0; mp < 2; ++mp) { EPI_OPAQUE(); const int slot = u.pm * 256 + ai * 128 + wr * 64 + mp * 32 + fr_; u32x2 w[2];
#pragma unroll
                for (int mm = 0; mm < 2; ++mm) { const int m = 2 * mp + mm;
                    const f32x4 ag0 = acc[ai][0][m][0], ag1 = acc[ai][0][m][1], au0 = acc[ai][1][m][0], au1 = acc[ai][1][m][1];
                    const f32x2 r0 = swiglu2(LO2(ag0), LO2(au0), LO2(bg0), LO2(bu0)), r1 = swiglu2(HI2(ag0), HI2(au0), HI2(bg0), HI2(bu0));
                    const f32x2 r2 = swiglu2(LO2(ag1), LO2(au1), LO2(bg1), LO2(bu1)), r3 = swiglu2(HI2(ag1), HI2(au1), HI2(bg1), HI2(bu1));
                    w[mm].x = cvt4_fp8(r0[0], r0[1], r1[0], r1[1]); w[mm].y = cvt4_fp8(r2[0], r2[1], r3[0], r3[1]); }
                st_pair8(ACT + (size_t)slot * 1024 + u.pn * 128 + wc * 32 + fq_ * 8, (size_t)16 * 1024, fq_, w[0], w[1]); }
#undef LO2
#undef HI2
    }
};
struct EpiDN {
    static constexpr int NVM = 12;
    unsigned char* YS; const float* bias;
    __device__ __forceinline__ void operator()(const Acc& acc, const Unit& u, int wr, int wc, int fr, int fq) const {
        int fq0 = fq; asm volatile("" : "+v"(fq0));
        const float* be = bias + (size_t)u.e * 1024 + u.pn * 256 + wc * 32 + fq0 * 8;
        f32x4 bb[2][2];
#pragma unroll
        for (int bj = 0; bj < 2; ++bj) { bb[bj][0] = *(const f32x4*)(be + bj * 128) * YS_SCALE; bb[bj][1] = *(const f32x4*)(be + bj * 128 + 4) * YS_SCALE; }
        constexpr float ws_ = YS_SCALE / (WDN_SCALE * ACT_SCALE);
#pragma unroll
        for (int ai = 0; ai < 2; ++ai)
#pragma unroll
            for (int mp = 0; mp < 2; ++mp) { EPI_OPAQUE(); const int row = ai * 128 + wr * 64 + mp * 32 + fr_;
#pragma unroll
                for (int bj = 0; bj < 2; ++bj) { u32x2 w[2];
#pragma unroll
                    for (int mm = 0; mm < 2; ++mm) { const int m = 2 * mp + mm; const f32x4 r0 = acc[ai][bj][m][0] * ws_ + bb[bj][0], r1 = acc[ai][bj][m][1] * ws_ + bb[bj][1];
                        w[mm].x = cvt4_fp8(r0[0], r0[1], r0[2], r0[3]); w[mm].y = cvt4_fp8(r1[0], r1[1], r1[2], r1[3]); }
                    st_pair8(YS + (size_t)(u.pm * 256 + row) * 1024 + u.pn * 256 + bj * 128 + wc * 32 + fq_ * 8, (size_t)16 * 1024, fq_, w[0], w[1]); } }
    }
};
struct EpiPLE {
    static constexpr int NVM = 48;
    const bf16_t* HB; float* OUT; bf16_t* XB; const bf16_t* PP; unsigned char* XF;
    __device__ __forceinline__ void operator()(const Acc& acc, const Unit& u, int wr, int wc, int fr, int fq) const {
        EPI_OPAQUE();
        const size_t base = (size_t)(u.pm * 256 + wr * 64 + fr_) * 1024 + u.pn * 256 + wc * 32 + fq_ * 8;
        u32x4 hw[2], pw[2], hn[2], pn_[2];
#define PLE_LD(it, H_, P_) do { const size_t o_ = base + (size_t)(((it) >> 2) * 128 + ((it) & 3) * 16) * 1024; \
            H_[0] = *(const u32x4*)(HB + o_); H_[1] = *(const u32x4*)(HB + o_ + 128); P_[0] = *(const u32x4*)(PP + o_); P_[1] = *(const u32x4*)(PP + o_ + 128); } while (0)
        PLE_LD(0, hw, pw);
#pragma unroll
        for (int it = 0; it < 8; ++it) { const int ai = it >> 2, m = it & 3;
            if (it < 7) PLE_LD(it + 1, hn, pn_);
            const size_t o0 = base + (size_t)(ai * 128 + m * 16) * 1024;
#pragma unroll
            for (int bj = 0; bj < 2; ++bj) { const f32x4 v0 = acc[ai][bj][m][0], v1 = acc[ai][bj][m][1]; const u32x4 h_ = hw[bj], p_ = pw[bj]; const size_t o = o0 + bj * 128;
                auto ple2 = [](f32x2 a, unsigned hw_, unsigned pw_) -> f32x2 {
                    const f32x2 t = a * (f32x2){-1.4426950408889634f, -1.4426950408889634f};
                    f32x2 e = {__builtin_amdgcn_exp2f(t[0]), __builtin_amdgcn_exp2f(t[1])}; e = e + (f32x2){1.0f, 1.0f};
                    const f32x2 sg = {__builtin_amdgcn_rcpf(e[0]), __builtin_amdgcn_rcpf(e[1])};
                    return __builtin_elementwise_fma(sg, (f32x2){bflo(pw_), bfhi(pw_)}, (f32x2){bflo(hw_), bfhi(hw_)}); };
                const f32x2 q0 = ple2(__builtin_shufflevector(v0, v0, 0, 1), h_.x, p_.x), q1 = ple2(__builtin_shufflevector(v0, v0, 2, 3), h_.y, p_.y);
                const f32x2 q2 = ple2(__builtin_shufflevector(v1, v1, 0, 1), h_.z, p_.z), q3 = ple2(__builtin_shufflevector(v1, v1, 2, 3), h_.w, p_.w);
                const f32x4 r0 = {q0[0], q0[1], q1[0], q1[1]}, r1 = {q2[0], q2[1], q3[0], q3[1]};
                if (OUT) { *(f32x4*)(OUT + o) = r0; *(f32x4*)(OUT + o + 4) = r1; }
                *(u32x4*)(XB + o) = pack8(r0, r1);
                { u32x2 w8; w8.x = cvt4_fp8(r0[0], r0[1], r0[2], r0[3]); w8.y = cvt4_fp8(r1[0], r1[1], r1[2], r1[3]); *(u32x2*)(XF + o) = w8; } }
            hw[0] = hn[0]; hw[1] = hn[1]; pw[0] = pn_[0]; pw[1] = pn_[1]; }
#undef PLE_LD
    }
};
__device__ __forceinline__ int ropeperm(int d, int half) { return d < half ? 2 * d : 2 * (d - half) + 1; }
__device__ __forceinline__ int rowmap_rt(int map, int n) {
    if (map == 1) {
        if (n < 1024) return (n & ~255) + ropeperm(n & 255, 128);
        if (n < 2048) return 3072 + ((n - 1024) & ~255) + ropeperm(n & 255, 128);
        if (n < 4096) return 4096 + (n - 2048);
        return 1024 + (n - 4096);
    } else if (map == 2) {
        return n < 256 ? n : 256 + ropeperm(n - 256, 32);
    } else if (map == 3) {
        const int hh = n / 192, d = n - hh * 192;
        return d < 128 ? hh * 128 + d : 1024 + hh * 64 + ropeperm(d - 128, 32);
    } else if (map == 4) {
        return n < 1024 ? ((n >> 7) * 256 + (n & 127)) : (((n - 1024) >> 7) * 256 + 128 + ((n - 1024) & 127));
    }
    return n;
}
struct TJob { const float* src; size_t sstride; int nmat, K, N; unsigned char* dst; size_t dstride; int map; const float* kscale; int ksstride; int fp8; float wscale; int sp; };
constexpr int NTJOBS = 11 + G1B_FP8;
__device__ __forceinline__ TJob get_tjob(int j, KPtr p, unsigned char* ws) {
    TJob t; t.kscale = nullptr; t.ksstride = 0; t.fp8 = 0; t.wscale = 1.0f; t.map = 0; t.sp = 0;
    switch (j) {
    case 0:  t.src = p->in[20]; t.sstride = (size_t)1024 * 2048; t.nmat = 128; t.K = 1024; t.N = 2048; t.dst = ws + WS_WGU; t.dstride = (size_t)2048 * 1024; t.map = 4; t.fp8 = 1; t.wscale = WGU_SCALE; break;
    case 1:  t.src = p->in[22]; t.sstride = (size_t)1024 * 1024; t.nmat = 128; t.K = 1024; t.N = 1024; t.dst = ws + WS_WDN; t.dstride = (size_t)1024 * 1024; t.fp8 = 1; t.wscale = WDN_SCALE; break;
    case 2:  t.src = p->in[3];  t.sstride = (size_t)1024 * 6144; t.nmat = 2;   t.K = 1024; t.N = 6144; t.dst = ws + WS_WRIN; t.dstride = (size_t)6144 * 1024 * 2; t.map = 1; break;
    case 3:  t.src = p->in[6];  t.sstride = (size_t)2048 * 1024; t.nmat = 2;   t.K = 2048; t.N = 1024; t.dst = ws + WS_WROUT; t.dstride = (size_t)1024 * 2048 * (G5_FP8 ? 1 : 2); t.fp8 = G5_FP8; t.wscale = G5_FP8 ? WROUT_SCALE : 1.0f; break;
    case 4:  t.src = p->in[10]; t.sstride = (size_t)1024 * 256;  t.nmat = 2;   t.K = 1024; t.N = 256;  t.dst = ws + WS_WQA; t.dstride = (size_t)256 * 1024; t.fp8 = ATT_FP8; t.wscale = ATT_FP8 ? WQA_SCALE : 1.0f; if (!ATT_FP8) t.dstride *= 2; break;
    case 5:  t.src = p->in[12]; t.sstride = (size_t)256 * 1536;  t.nmat = 2;   t.K = 256;  t.N = 1536; t.dst = ws + WS_WQB; t.dstride = (size_t)1536 * 256 * 2; t.map = 3; t.kscale = p->in[11]; t.ksstride = 256; break;
    case 6:  t.src = p->in[13]; t.sstride = (size_t)1024 * 1024; t.nmat = 2;   t.K = 1024; t.N = 1024; t.dst = ws + WS_WO; t.dstride = (size_t)1024 * 1024; t.fp8 = ATT_FP8; t.wscale = ATT_FP8 ? WO_SCALE : 1.0f; if (!ATT_FP8) t.dstride *= 2; break;
    case 7:  t.src = p->in[7];  t.sstride = 0;                   t.nmat = 1;   t.K = 1024; t.N = 320;  t.dst = ws + WS_WKVA; t.dstride = 0; t.map = 2; t.fp8 = ATT_FP8; t.wscale = ATT_FP8 ? WKVA_SCALE : 1.0f; break;
    case 8:  t.src = p->in[9];  t.sstride = 0;                   t.nmat = 1;   t.K = 256;  t.N = 2048; t.dst = ws + WS_WKVB; t.dstride = 0; t.kscale = p->in[8]; break;
    case 9:  t.src = p->in[24]; t.sstride = (size_t)1024 * 1024; t.nmat = 4;   t.K = 1024; t.N = 1024; t.dst = ws + WS_WPG; t.dstride = (size_t)1024 * 1024 * 2; break;
    case 10: t.src = p->in[25]; t.sstride = (size_t)256 * 1024;  t.nmat = 4;   t.K = 256;  t.N = 1024; t.dst = ws + WS_WPP; t.dstride = (size_t)1024 * 256 * 2; break;
    default: t.src = p->in[3] + 2048; t.sstride = (size_t)1024 * 6144; t.nmat = 2; t.K = 1024; t.N = 2048; t.sp = 6144; t.dst = ws + WS_WV8; t.dstride = (size_t)2048 * 1024; t.fp8 = 1; t.wscale = WV_SCALE; break;
    }
    if (t.sp == 0) t.sp = t.N;
    return t;
}
struct TTile { const float* src; unsigned char* dst; const float* kscale; int K, N, k0, n0, map, fp8; float wscale; bool valid; int SP; };
__device__ __forceinline__ TTile get_ttile(int t, KPtr p, unsigned char* ws, int jlo, int jhi) {
    TTile r; r.valid = false;
    int base = 0;
    for (int j = jlo; j < jhi; ++j) { const TJob jb = get_tjob(j, p, ws); const int nnb = (jb.N + 255) >> 8, tpm = (jb.K >> 8) * nnb, nt = jb.nmat * tpm;
        if (t < base + nt) { const int rr = t - base, mat = rr / tpm, q = rr - mat * tpm, kb = q / nnb, nb = q - kb * nnb;
            r.src = jb.src + (size_t)mat * jb.sstride; r.dst = jb.dst + (size_t)mat * jb.dstride; r.kscale = jb.kscale ? jb.kscale + mat * jb.ksstride : nullptr;
            r.K = jb.K; r.N = jb.N; r.k0 = kb << 8; r.n0 = nb << 8; r.map = jb.map; r.fp8 = jb.fp8; r.wscale = jb.wscale; r.SP = jb.sp; r.valid = true; return r; }
        base += nt; }
    return r;
}
__device__ __forceinline__ int ttile_total(KPtr p, unsigned char* ws, int jlo, int jhi) { int n = 0; for (int j = jlo; j < jhi; ++j) { const TJob jb = get_tjob(j, p, ws); n += jb.nmat * (jb.K >> 8) * ((jb.N + 255) >> 8); } return n; }
__device__ __forceinline__ void prologue_phase(KPtr p, unsigned char* ws, LAS unsigned char* lds, int tid, int vcu, int G, int gw, int NGW, int lane, int jlo, int jhi, bool misc) {
    const int wave = __builtin_amdgcn_readfirstlane(tid >> 6);
    const int total = ttile_total(p, ws, jlo, jhi);
    f32x4 R[32];
    TTile cur = get_ttile(vcu, p, ws, jlo, jhi);
#define TT_LOAD(tt) do { const bool ok_ = (tt).n0 + 4 * lane < (tt).N; const float* sp_ = (tt).src + (size_t)((tt).k0 + 32 * wave) * (tt).SP + (tt).n0 + 4 * lane; \
        _Pragma("unroll") for (int i = 0; i < 32; ++i) R[i] = ok_ ? *(const f32x4*)(sp_ + (size_t)i * (tt).SP) : (f32x4){0.f, 0.f, 0.f, 0.f}; } while (0)
    if (vcu < total) TT_LOAD(cur);
    for (int t = vcu; t < total; t += G) {
        const float sc = cur.wscale;
        if (cur.kscale) {
#pragma unroll
            for (int i = 0; i < 32; ++i) R[i] = R[i] * cur.kscale[cur.k0 + 32 * wave + i]; }
        if (!cur.fp8) {
#pragma unroll
            for (int q = 0; q < 4; ++q) { const int row = 4 * lane + q;
#pragma unroll
                for (int ci = 0; ci < 4; ++ci) { u32x4 w; w.x = cvt_pk_bf16(R[ci * 8 + 0][q], R[ci * 8 + 1][q]); w.y = cvt_pk_bf16(R[ci * 8 + 2][q], R[ci * 8 + 3][q]); w.z = cvt_pk_bf16(R[ci * 8 + 4][q], R[ci * 8 + 5][q]); w.w = cvt_pk_bf16(R[ci * 8 + 6][q], R[ci * 8 + 7][q]);
                    *(LAS u32x4*)(lds + row * 512 + (((4 * wave + ci) ^ (lane & 31)) << 4)) = w; } }
        } else {
#pragma unroll
            for (int q = 0; q < 4; ++q) { const int row = 4 * lane + q;
#pragma unroll
                for (int ci = 0; ci < 2; ++ci) { u32x4 w; const int b = ci * 16;
                    w.x = cvt4_fp8(R[b + 0][q] * sc, R[b + 1][q] * sc, R[b + 2][q] * sc, R[b + 3][q] * sc); w.y = cvt4_fp8(R[b + 4][q] * sc, R[b + 5][q] * sc, R[b + 6][q] * sc, R[b + 7][q] * sc);
                    w.z = cvt4_fp8(R[b + 8][q] * sc, R[b + 9][q] * sc, R[b + 10][q] * sc, R[b + 11][q] * sc); w.w = cvt4_fp8(R[b + 12][q] * sc, R[b + 13][q] * sc, R[b + 14][q] * sc, R[b + 15][q] * sc);
                    *(LAS u32x4*)(lds + row * 256 + (((2 * wave + ci) ^ (lane & 15)) << 4)) = w; } }
        }
        __syncthreads();
        const TTile nxt = get_ttile(t + G, p, ws, jlo, jhi);
        if (t + G < total) TT_LOAD(nxt);
        if (!cur.fp8) {
#pragma unroll 4
            for (int i = 0; i < 16; ++i) { const int row = (tid >> 5) + 16 * i, ch = tid & 31;
                if (cur.n0 + row < cur.N) { const u32x4 w = *(const LAS u32x4*)(lds + row * 512 + ((ch ^ ((row >> 2) & 31)) << 4));
                    *(u32x4*)(cur.dst + ((size_t)rowmap_rt(cur.map, cur.n0 + row) * cur.K + cur.k0) * 2 + ch * 16) = w; } }
        } else {
#pragma unroll 4
            for (int i = 0; i < 8; ++i) { const int row = (tid >> 4) + 32 * i, ch = tid & 15;
                if (cur.n0 + row < cur.N) { const u32x4 w = *(const LAS u32x4*)(lds + row * 256 + ((ch ^ ((row >> 2) & 15)) << 4));
                    *(u32x4*)(cur.dst + ((size_t)rowmap_rt(cur.map, cur.n0 + row) * cur.K + cur.k0) + ch * 16) = w; } }
        }
        __syncthreads();
        cur = nxt;
    }
#undef TT_LOAD
    if (!misc) return;
    const size_t gt = (size_t)gw * 64 + lane, NT_ = (size_t)NGW * 64;
    for (size_t i = gt; i < (size_t)192 * 1024 * (ATT_FP8 ? 1 : 2) / 16; i += NT_) *(u32x4*)(ws + WS_WKVA + (size_t)320 * 1024 * (ATT_FP8 ? 1 : 2) + i * 16) = (u32x4){0u, 0u, 0u, 0u};
    for (size_t i = gt; i < (size_t)4 * 32768; i += NT_) { const int l = (int)(i >> 15), r = (int)(i & 32767), e = r >> 10, k = r & 1023; ((float*)(ws + WS_WRT))[i] = p->in[18][(size_t)l * 32768 + k * 32 + e]; }
    for (size_t i = gt; i < (size_t)T * 1024 / 8; i += NT_) { const f32x4 a = *(const f32x4*)(p->in[0] + i * 8), b = *(const f32x4*)(p->in[0] + i * 8 + 4); *(u32x4*)((bf16_t*)(ws + WS_XBA) + i * 8) = pack8(a, b);
        if (G1B_FP8) { u32x2 w8; w8.x = cvt4_fp8(a[0], a[1], a[2], a[3]); w8.y = cvt4_fp8(b[0], b[1], b[2], b[3]); *(u32x2*)(ws + WS_XF8 + i * 8) = w8; } }
    for (size_t i = gt; i < (size_t)4 * T * 256 / 8; i += NT_) { const f32x4 a = *(const f32x4*)(p->in[1] + i * 8), b = *(const f32x4*)(p->in[1] + i * 8 + 4); *(u32x4*)((bf16_t*)(ws + WS_PB) + i * 8) = pack8(a, b); }
    const int* pos = (const int*)p->in[2];
    if ((NT_ & 127) == 0) {
        { const int j = (int)(gt & 127); const double inv = exp(-(double)j * (2.0 / 256.0) * 9.210340371976184);
          for (size_t i = gt; i < (size_t)T * 128; i += NT_) { double sn, cs; sincos((double)pos[i >> 7] * inv, &sn, &cs); ((float*)(ws + WS_COSR))[i] = (float)cs; ((float*)(ws + WS_SINR))[i] = (float)sn; } }
        { const int j = (int)(gt & 31); const double inv = exp(-(double)j * (2.0 / 64.0) * 9.210340371976184);
          for (size_t i = gt; i < (size_t)T * 32; i += NT_) { double sn, cs; sincos((double)pos[i >> 5] * inv, &sn, &cs); ((float*)(ws + WS_COSM))[i] = (float)cs; ((float*)(ws + WS_SINM))[i] = (float)sn; } }
    } else {
    for (size_t i = gt; i < (size_t)T * 128; i += NT_) { const int t = (int)(i >> 7), j = (int)(i & 127);
        const double inv = exp(-(double)j * (2.0 / 256.0) * 9.210340371976184), ang = (double)pos[t] * inv; const float c = (float)cos(ang), s = (float)sin(ang);
        ((float*)(ws + WS_COSR))[i] = c; ((float*)(ws + WS_SINR))[i] = s; }
    for (size_t i = gt; i < (size_t)T * 32; i += NT_) { const int t = (int)(i >> 5), j = (int)(i & 31);
        const double inv = exp(-(double)j * (2.0 / 64.0) * 9.210340371976184), ang = (double)pos[t] * inv;
        ((float*)(ws + WS_COSM))[i] = (float)cos(ang); ((float*)(ws + WS_SINM))[i] = (float)sin(ang); }
    }
}

template <int N> __device__ __forceinline__ void tr_step(float (&pa)[32], float (&pb)[32], int lane, int mask) {
    const bool up = (lane & mask) != 0; float ra[N], rb[N];
#pragma unroll
    for (int i = 0; i < N; ++i) { ra[i] = __shfl_xor(up ? pa[i] : pa[i + N], mask); rb[i] = __shfl_xor(up ? pb[i] : pb[i + N], mask); }
    __builtin_amdgcn_sched_barrier(0);
#pragma unroll
    for (int i = 0; i < N; ++i) { pa[i] = (up ? pa[i + N] : pa[i]) + ra[i]; pb[i] = (up ? pb[i + N] : pb[i]) + rb[i]; }
    __builtin_amdgcn_sched_barrier(0);
}
__device__ __forceinline__ void ln1_router_phase(KPtr p, unsigned char* ws, LAS unsigned char* lds, int layer, const bf16_t* hin, int tid, int wave, int lane, int G, bool dry = false) {
    LAS float* wrt = (LAS float*)lds;
    volatile LAS unsigned* misc = (volatile LAS unsigned*)(lds + MISC_OFF);
    const float* wr = p->in[18] + (size_t)layer * 1024 * 32; const float* br = p->in[19] + layer * 32;
    const float* lg = p->in[14] + layer * 1024; const float* lb = p->in[15] + layer * 1024;
    u32x2 nh[2][4], nm[2][4];
    if ((int)blockIdx.x < T / 128) {
#pragma unroll
        for (int q = 0; q < 2; ++q) { const size_t ro = (size_t)((int)blockIdx.x * 128 + wave * 16 + q) * 1024;
#pragma unroll
            for (int j = 0; j < 4; ++j) { nh[q][j] = *(const u32x2*)(hin + ro + 256 * j + 4 * lane); nm[q][j] = *(const u32x2*)(((const bf16_t*)(ws + WS_MIX)) + ro + 256 * j + 4 * lane); } } }
    { const f32x4* wt4 = (const f32x4*)(ws + WS_WRT) + (size_t)layer * 8192;
#pragma unroll 4
      for (int i = tid; i < 8192; i += 512) *(LAS f32x4*)(wrt + (i >> 8) * 1028 + 4 * (i & 255)) = wt4[i]; }
    bf16_t* H = (bf16_t*)(ws + (dry ? WS_END : WS_H)); const bf16_t* MIX = (const bf16_t*)(ws + WS_MIX); bf16_t* XBB = (bf16_t*)(ws + (dry ? WS_END + ((size_t)T * 4096) : WS_XBB));
    int* EIDX = (int*)(ws + (dry ? WS_END + ((size_t)T * 6144) : WS_EIDX)); float* GATE = (float*)(ws + (dry ? WS_END + ((size_t)T * 6144) + (size_t)T * 16 : WS_GATE)); int* POS = (int*)(ws + (dry ? WS_END + ((size_t)T * 6144) + (size_t)T * 32 : WS_POS));
    unsigned* gcnt = (unsigned*)(ws + WS_CTL) + CW_CNT + (dry ? 4 : layer) * 32 * 64;
    int* TOKL = (int*)(ws + (dry ? WS_END + ((size_t)100 << 20) : WS_XG));
    LAS float* gl = (LAS float*)(lds + GB_OFF);
    if (tid < 256) *(LAS f32x4*)(gl + 4 * tid) = *(const f32x4*)(lg + 4 * tid); else *(LAS f32x4*)(gl + 4 * tid) = *(const f32x4*)(lb + 4 * (tid - 256));
    const float mybias = br[lane >> 1];
    for (int tb = blockIdx.x; tb < T / 128; tb += G) {
        if (tid < 32) misc[MW_LCNT + tid] = 0u;
        __syncthreads();
        const int base = tb * 128;
        if (tb != (int)blockIdx.x)
#pragma unroll
        for (int q = 0; q < 2; ++q) { const size_t ro = (size_t)(base + wave * 16 + q) * 1024;
#pragma unroll
            for (int j = 0; j < 4; ++j) { nh[q][j] = *(const u32x2*)(hin + ro + 256 * j + 4 * lane); nm[q][j] = *(const u32x2*)(MIX + ro + 256 * j + 4 * lane); } }
        for (int pr = 0; pr < 8; ++pr) {
            const int tl = wave * 16 + pr * 2;
            f32x4 y[2][4];
#pragma unroll
            for (int q = 0; q < 2; ++q)
#pragma unroll
                for (int j = 0; j < 4; ++j) { const u32x2 a = nh[q][j], b = nm[q][j];
                    y[q][j] = (f32x4){bflo(a.x), bfhi(a.x), bflo(a.y), bfhi(a.y)} * DN_ALPHA + (f32x4){bflo(b.x), bfhi(b.x), bflo(b.y), bfhi(b.y)}; }
            if (pr < 7) {
#pragma unroll
                for (int q = 0; q < 2; ++q) { const size_t ro = (size_t)(base + tl + 2 + q) * 1024;
#pragma unroll
                    for (int j = 0; j < 4; ++j) { nh[q][j] = *(const u32x2*)(hin + ro + 256 * j + 4 * lane); nm[q][j] = *(const u32x2*)(MIX + ro + 256 * j + 4 * lane); } } }
            f32x4 g4[4], b4[4];
#pragma unroll
            for (int j = 0; j < 4; ++j) { g4[j] = *(const LAS f32x4*)(gl + 256 * j + 4 * lane); b4[j] = *(const LAS f32x4*)(gl + 1024 + 256 * j + 4 * lane); }
#pragma unroll
            for (int q = 0; q < 2; ++q) { const size_t ro = (size_t)(base + tl + q) * 1024; float s = 0.f;
#pragma unroll
                for (int j = 0; j < 4; ++j) s += (y[q][j][0] + y[q][j][1]) + (y[q][j][2] + y[q][j][3]);
                const float mean = wave_sum(s) * (1.0f / 1024.0f); float s2 = 0.f;
#pragma unroll
                for (int j = 0; j < 4; ++j) { y[q][j] = y[q][j] - mean; s2 += (y[q][j][0] * y[q][j][0] + y[q][j][1] * y[q][j][1]) + (y[q][j][2] * y[q][j][2] + y[q][j][3] * y[q][j][3]); }
                const float rstd = rsqrtf(wave_sum(s2) * (1.0f / 1024.0f) + LN_EPS);
#pragma unroll
                for (int j = 0; j < 4; ++j) { y[q][j] = y[q][j] * rstd * g4[j] + b4[j];
                    { u32x2 w; w.x = cvt_pk_bf16(y[q][j][0], y[q][j][1]); w.y = cvt_pk_bf16(y[q][j][2], y[q][j][3]); *(u32x2*)(H + ro + 256 * j + 4 * lane) = w; }
                    *(unsigned*)((unsigned char*)XBB + ro + 256 * j + 4 * lane) = cvt4_fp8(y[q][j][0], y[q][j][1], y[q][j][2], y[q][j][3]); }
            }
            float pa[32], pb[32];
            f32x4 wq[2][4];
#pragma unroll
            for (int j = 0; j < 4; ++j) wq[0][j] = *(const LAS f32x4*)(wrt + 256 * j + 4 * lane);
#pragma unroll
            for (int e = 0; e < 32; ++e) { const int cb = e & 1;
                if (e + 1 < 32) {
#pragma unroll
                    for (int j = 0; j < 4; ++j) wq[cb ^ 1][j] = *(const LAS f32x4*)(wrt + (e + 1) * 1028 + 256 * j + 4 * lane); }
                __builtin_amdgcn_sched_barrier(0);
                f32x2 sa = {0.f, 0.f}, sb = {0.f, 0.f};
#pragma unroll
                for (int j = 0; j < 4; ++j) { const f32x4 w4 = wq[cb][j];
                    const f32x2 wl = __builtin_shufflevector(w4, w4, 0, 1), wh = __builtin_shufflevector(w4, w4, 2, 3);
                    sa = __builtin_elementwise_fma(__builtin_shufflevector(y[0][j], y[0][j], 0, 1), wl, sa); sa = __builtin_elementwise_fma(__builtin_shufflevector(y[0][j], y[0][j], 2, 3), wh, sa);
                    sb = __builtin_elementwise_fma(__builtin_shufflevector(y[1][j], y[1][j], 0, 1), wl, sb); sb = __builtin_elementwise_fma(__builtin_shufflevector(y[1][j], y[1][j], 2, 3), wh, sb); }
                pa[e] = sa[0] + sa[1]; pb[e] = sb[0] + sb[1];
                __builtin_amdgcn_sched_barrier(0); }
            tr_step<16>(pa, pb, lane, 32); tr_step<8>(pa, pb, lane, 16); tr_step<4>(pa, pb, lane, 8); tr_step<2>(pa, pb, lane, 4); tr_step<1>(pa, pb, lane, 2);
            float lv[2]; lv[0] = pa[0] + __shfl_xor(pa[0], 1) + mybias; lv[1] = pb[0] + __shfl_xor(pb[0], 1) + mybias;
            const int myexp = lane >> 1;
#pragma unroll
            for (int q = 0; q < 2; ++q) { float tv[4]; int ti[4];
                const unsigned ub = __float_as_uint(lv[q]); unsigned key = (((ub & 0x80000000u) ? ~ub : (ub | 0x80000000u)) & ~31u) | (unsigned)(31 - myexp);
#pragma unroll
                for (int r = 0; r < 4; ++r) { const unsigned best = wave_umax(key); const int bi = 31 - (int)(best & 31u);
                    ti[r] = bi; tv[r] = __uint_as_float(__builtin_amdgcn_readlane(__float_as_uint(lv[q]), 2 * bi)); if (myexp == bi) key = 0u; }
                const float e1 = __expf(tv[1] - tv[0]), e2 = __expf(tv[2] - tv[0]), e3 = __expf(tv[3] - tv[0]), inv = 1.0f / (1.0f + e1 + e2 + e3);
                if (lane < 4) { const int ek = lane == 0 ? ti[0] : lane == 1 ? ti[1] : lane == 2 ? ti[2] : ti[3];
                    const float gk = (lane == 0 ? 1.0f : lane == 1 ? e1 : lane == 2 ? e2 : e3) * inv;
                    const int t = base + tl + q; EIDX[t * 4 + lane] = ek; GATE[t * 4 + lane] = gk;
                    const unsigned lp = __hip_atomic_fetch_add((LAS unsigned*)&misc[MW_LCNT + ek], 1u, __ATOMIC_RELAXED, __HIP_MEMORY_SCOPE_WORKGROUP);
                    misc[MW_TOK + (tl + q) * 4 + lane] = (unsigned)ek | (lp << 8); }
            }
        }
        __syncthreads();
        if (tid < 32) misc[MW_LBASE + tid] = __hip_atomic_fetch_add(gcnt + tid * 64, misc[MW_LCNT + tid], __ATOMIC_RELAXED, __HIP_MEMORY_SCOPE_AGENT);
        __syncthreads();
        { const unsigned v = misc[MW_TOK + tid]; const unsigned e = v & 255u; const int pos = (int)(misc[MW_LBASE + e] + (v >> 8));
          POS[base * 4 + tid] = pos; TOKL[(size_t)e * T + pos] = base + (tid >> 2); }
        __syncthreads();
    }
}
__device__ __forceinline__ void plan_phase(unsigned char* ws, LAS unsigned char* lds, int layer, int tid) {
    volatile LAS unsigned* misc = (volatile LAS unsigned*)(lds + MISC_OFF);
    unsigned* gcnt = (unsigned*)(ws + WS_CTL) + CW_CNT + layer * 32 * 64;
    if (tid < 32) misc[MW_CNT + tid] = __hip_atomic_load(gcnt + tid * 64, __ATOMIC_RELAXED, __HIP_MEMORY_SCOPE_AGENT);
    __syncthreads();
    if (tid < 32) {
        volatile LAS unsigned char* rbe = (volatile LAS unsigned char*)(misc + MW_RBEXP);
        const unsigned nb = (misc[MW_CNT + tid] + 255u) >> 8; unsigned inc = nb;
#pragma unroll
        for (int d = 1; d < 32; d <<= 1) { const unsigned v = (unsigned)__shfl_up((int)inc, d, 32); if (tid >= d) inc += v; }
        const unsigned first = inc - nb;
        misc[MW_PSTART + tid] = first << 8; for (unsigned r = 0; r < nb; ++r) rbe[first + r] = (unsigned char)tid;
        if (tid == 31) misc[MW_NRB] = inc; }
    __syncthreads();
}
__device__ __forceinline__ void ln2_phase(KPtr p, unsigned char* ws, LAS unsigned char* lds, int layer, int lane, int gw, int NGW, bool dry = false) {
    const bf16_t* H = (const bf16_t*)(ws + WS_H); bf16_t* XBB = (bf16_t*)(ws + (dry ? WS_END + ((size_t)T * 4096) : WS_XBB)); const unsigned char* YS = (const unsigned char*)(ws + WS_YS);
    const int* EIDX = (const int*)(ws + WS_EIDX); const int* POS = (const int*)(ws + WS_POS); const float* GATE = (const float*)(ws + WS_GATE);
    volatile LAS unsigned* misc = (volatile LAS unsigned*)(lds + MISC_OFF);
    const float* lg = p->in[16] + layer * 1024; const float* lb = p->in[17] + layer * 1024;
    f32x4 gam[2][2], bet[2][2];
#pragma unroll
    for (int j = 0; j < 2; ++j) { const int c = j * 512 + lane * 8; gam[j][0] = *(const f32x4*)(lg + c); gam[j][1] = *(const f32x4*)(lg + c + 4); bet[j][0] = *(const f32x4*)(lb + c); bet[j][1] = *(const f32x4*)(lb + c + 4); }
    int sl = 0, sln = 0; float gt = 0.f, gtn = 0.f; u32x4 hr[2]; u32x2 ys[4][2];
#define LN2_SLOTS(tt, S_, G_) do { if ((tt) < T && lane < 4) { S_ = (int)misc[MW_PSTART + EIDX[(tt) * 4 + lane]] + POS[(tt) * 4 + lane]; G_ = GATE[(tt) * 4 + lane]; } } while (0)
#define LN2_ROWS(tt, S_) do { if ((tt) < T) { _Pragma("unroll") for (int k = 0; k < 4; ++k) { const int sk = __builtin_amdgcn_readlane(S_, k); \
            _Pragma("unroll") for (int j = 0; j < 2; ++j) ys[k][j] = *(const u32x2*)(YS + (size_t)sk * 1024 + j * 512 + lane * 8); } \
        _Pragma("unroll") for (int j = 0; j < 2; ++j) hr[j] = *(const u32x4*)(H + (size_t)(tt) * 1024 + j * 512 + lane * 8); } } while (0)
    LN2_SLOTS(gw, sl, gt); LN2_SLOTS(gw + NGW, sln, gtn);
    LN2_ROWS(gw, sl);
    for (int t = gw; t < T; t += NGW) {
        u32x2 cy[4][2]; u32x4 ch[2]; float gk[4];
#pragma unroll
        for (int k = 0; k < 4; ++k) { cy[k][0] = ys[k][0]; cy[k][1] = ys[k][1]; gk[k] = __uint_as_float(__builtin_amdgcn_readlane(__float_as_uint(gt), k)); }
        ch[0] = hr[0]; ch[1] = hr[1];
        sl = sln; gt = gtn;
        LN2_ROWS(t + NGW, sl);
        LN2_SLOTS(t + 2 * NGW, sln, gtn);
        float x[16];
#pragma unroll
        for (int j = 0; j < 2; ++j) { const u32x4 w = ch[j];
            x[j * 8 + 0] = bflo(w.x) * DN_ALPHA; x[j * 8 + 1] = bfhi(w.x) * DN_ALPHA; x[j * 8 + 2] = bflo(w.y) * DN_ALPHA; x[j * 8 + 3] = bfhi(w.y) * DN_ALPHA;
            x[j * 8 + 4] = bflo(w.z) * DN_ALPHA; x[j * 8 + 5] = bfhi(w.z) * DN_ALPHA; x[j * 8 + 6] = bflo(w.w) * DN_ALPHA; x[j * 8 + 7] = bfhi(w.w) * DN_ALPHA; }
        float s = 0.f;
#pragma unroll
        for (int k = 0; k < 4; ++k)
#pragma unroll
            for (int j = 0; j < 2; ++j) { const u32x2 w = cy[k][j]; const float g_ = gk[k] * (1.0f / YS_SCALE);
                const f32x2 a = __builtin_amdgcn_cvt_pk_f32_fp8((int)w.x, false), b = __builtin_amdgcn_cvt_pk_f32_fp8((int)w.x, true);
                const f32x2 c = __builtin_amdgcn_cvt_pk_f32_fp8((int)w.y, false), d = __builtin_amdgcn_cvt_pk_f32_fp8((int)w.y, true);
                x[j * 8 + 0] += g_ * a[0]; x[j * 8 + 1] += g_ * a[1]; x[j * 8 + 2] += g_ * b[0]; x[j * 8 + 3] += g_ * b[1];
                x[j * 8 + 4] += g_ * c[0]; x[j * 8 + 5] += g_ * c[1]; x[j * 8 + 6] += g_ * d[0]; x[j * 8 + 7] += g_ * d[1]; }
#pragma unroll
        for (int i = 0; i < 16; ++i) s += x[i];
        const float mean = wave_sum(s) * (1.0f / 1024.0f); float s2 = 0.f;
#pragma unroll
        for (int i = 0; i < 16; ++i) { x[i] -= mean; s2 += x[i] * x[i]; }
        const float rstd = rsqrtf(wave_sum(s2) * (1.0f / 1024.0f) + LN_EPS);
#pragma unroll
        for (int j = 0; j < 2; ++j) { const int c = j * 512 + lane * 8; const size_t o = (size_t)t * 1024 + c;
            const f32x4 ga = gam[j][0], gb = gam[j][1], ba = bet[j][0], bb = bet[j][1];
            f32x4 ya, yb;
#pragma unroll
            for (int i = 0; i < 4; ++i) { ya[i] = x[j * 8 + i] * rstd * ga[i] + ba[i]; yb[i] = x[j * 8 + 4 + i] * rstd * gb[i] + bb[i]; }
            *(u32x4*)(XBB + o) = pack8(ya, yb); }
    }
#undef LN2_SLOTS
#undef LN2_ROWS
}
__device__ __forceinline__ void ret_scan_phase(unsigned char* ws, int gthread, int nthreads, bool dry = false) {
    bf16_t* VS = (bf16_t*)(ws + WS_VS); const size_t wofs = dry ? (WS_END - WS_VS) / 2 : 0;
    for (int it = gthread; it < 16 * 512 * 32; it += nthreads) {
        const int dk8 = it & 31, dv = (it >> 5) & 511, bh = it >> 14;
        const float g256 = exp2f(log2gamma(bh & 3) * 256.0f);
        bf16_t* ptr = VS + (size_t)bh * 32 * 262144 + (size_t)dv * 512 + 256 + dk8 * 8;
        float s[8];
#pragma unroll
        for (int i = 0; i < 8; ++i) s[i] = 0.f;
        u32x4 ua[32];
#pragma unroll
        for (int n = 0; n < 32; ++n) ua[n] = *(const u32x4*)(ptr + (size_t)n * 262144);
#pragma unroll
        for (int n = 0; n < 32; ++n) {
            const u32x4 uw = ua[n];
            f32x4 a, b; a[0] = s[0]; a[1] = s[1]; a[2] = s[2]; a[3] = s[3]; b[0] = s[4]; b[1] = s[5]; b[2] = s[6]; b[3] = s[7];
            *(u32x4*)(ptr + wofs + (size_t)n * 262144) = pack8(a, b);
            s[0] = s[0] * g256 + bflo(uw.x); s[1] = s[1] * g256 + bfhi(uw.x); s[2] = s[2] * g256 + bflo(uw.y); s[3] = s[3] * g256 + bfhi(uw.y);
            s[4] = s[4] * g256 + bflo(uw.z); s[5] = s[5] * g256 + bfhi(uw.z); s[6] = s[6] * g256 + bflo(uw.w); s[7] = s[7] * g256 + bfhi(uw.w);
        }
    }
}
__device__ __forceinline__ void ret_gn_phase(KPtr p, unsigned char* ws, int layer, int lane, int gw, int NGW) {
    const bf16_t* Y = (const bf16_t*)(ws + WS_Y); const bf16_t* GB = (const bf16_t*)(ws + WS_GB); bf16_t* Z = (bf16_t*)(ws + WS_Z);
    const float* gg = p->in[4] + layer * 2048; const float* gb = p->in[5] + layer * 2048;
    f32x4 gam[4][2], bet[4][2];
#pragma unroll
    for (int hh = 0; hh < 4; ++hh) { const int c = hh * 512 + lane * 8;
        gam[hh][0] = *(const f32x4*)(gg + c); gam[hh][1] = *(const f32x4*)(gg + c + 4); bet[hh][0] = *(const f32x4*)(gb + c); bet[hh][1] = *(const f32x4*)(gb + c + 4); }
    u32x4 ny[4], ng[4];
    if (gw < T) {
#pragma unroll
        for (int hh = 0; hh < 4; ++hh) { const size_t o = (size_t)gw * 2048 + hh * 512 + lane * 8; ny[hh] = *(const u32x4*)(Y + o); ng[hh] = *(const u32x4*)(GB + o); } }
    for (int t = gw; t < T; t += NGW) {
        u32x4 cy[4], cg[4];
#pragma unroll
        for (int hh = 0; hh < 4; ++hh) { cy[hh] = ny[hh]; cg[hh] = ng[hh]; }
        if (t + NGW < T) {
#pragma unroll
            for (int hh = 0; hh < 4; ++hh) { const size_t o = (size_t)(t + NGW) * 2048 + hh * 512 + lane * 8; ny[hh] = *(const u32x4*)(Y + o); ng[hh] = *(const u32x4*)(GB + o); } }
#pragma unroll
        for (int hh = 0; hh < 4; ++hh) { const int c = hh * 512 + lane * 8; const size_t o = (size_t)t * 2048 + c;
            const u32x4 w = cy[hh], gw4 = cg[hh];
            float x[8] = {bflo(w.x), bfhi(w.x), bflo(w.y), bfhi(w.y), bflo(w.z), bfhi(w.z), bflo(w.w), bfhi(w.w)};
            float gv[8] = {bflo(gw4.x), bfhi(gw4.x), bflo(gw4.y), bfhi(gw4.y), bflo(gw4.z), bfhi(gw4.z), bflo(gw4.w), bfhi(gw4.w)};
#pragma unroll
            for (int i = 0; i < 8; i += 2) {
                const f32x2 g2 = {gv[i], gv[i + 1]}; const f32x2 t2 = g2 * (f32x2){-1.4426950408889634f, -1.4426950408889634f};
                f32x2 e2 = {__builtin_amdgcn_exp2f(t2[0]), __builtin_amdgcn_exp2f(t2[1])}; e2 = e2 + (f32x2){1.0f, 1.0f};
                const f32x2 r2 = g2 * (f32x2){__builtin_amdgcn_rcpf(e2[0]), __builtin_amdgcn_rcpf(e2[1])}; gv[i] = r2[0]; gv[i + 1] = r2[1]; }
            float s = 0.f;
#pragma unroll
            for (int i = 0; i < 8; ++i) s += x[i];
            const float mean = wave_sum(s) * (1.0f / 512.0f); float s2 = 0.f;
#pragma unroll
            for (int i = 0; i < 8; ++i) { x[i] -= mean; s2 += x[i] * x[i]; }
            const float rstd = rsqrtf(wave_sum(s2) * (1.0f / 512.0f) + GN_EPS);
            const f32x4 ga = gam[hh][0], gbv = gam[hh][1], ba = bet[hh][0], bb = bet[hh][1];
            f32x4 ya, yb;
#pragma unroll
            for (int i = 0; i < 4; ++i) { ya[i] = (x[i] * rstd * ga[i] + ba[i]) * gv[i]; yb[i] = (x[4 + i] * rstd * gbv[i] + bb[i]) * gv[4 + i]; }
#if G5_FP8
            { u32x2 w8; w8.x = cvt4_fp8(ya[0] * Z_SCALE, ya[1] * Z_SCALE, ya[2] * Z_SCALE, ya[3] * Z_SCALE); w8.y = cvt4_fp8(yb[0] * Z_SCALE, yb[1] * Z_SCALE, yb[2] * Z_SCALE, yb[3] * Z_SCALE); *(u32x2*)((unsigned char*)Z + o) = w8; } }
#else
            *(u32x4*)(Z + o) = pack8(ya, yb); }
#endif
    }
}

namespace att {
constexpr int SHM_V = 64 * 128 * 2, SHM_K = 64 * 192 * 2;
constexpr int OFF_V = 0, OFF_K = 2 * SHM_V, OFF_WS = 2 * SHM_V + 2 * SHM_K;
constexpr float THR = 8.f;
#define KSWZ192(row, colB) ((row) * 384 + ((colB) ^ (((row) & 7) << 4)))
#define SBAR() __builtin_amdgcn_sched_barrier(0)
__device__ __forceinline__ int v_st(int k, int c) { const int kk = (k & ~0xC) | ((k & 4) << 1) | ((k & 8) >> 1); return ((kk >> 3) * 4 + (c >> 5)) * 512 + ((kk & 7) * 32 + (c & 31)) * 2; }
__device__ __forceinline__ int v_rd_base(int lane) { return ((lane & 3) << 3) | (((lane >> 2) & 3) << 6) | (((lane >> 4) & 1) << 5) | (((lane >> 5) & 1) << 8); }
constexpr int v_rd_off(int d0, int ks, int half) { return d0 * 512 + ks * 4096 + half * 2048; }
__device__ __forceinline__ int crow(int r, int hi) { return (r & 3) + 8 * (r >> 2) + 4 * hi; }
__device__ __forceinline__ void mask_tile(f32x16& p0, f32x16& p1, int dq) {
    const float NEG = -__builtin_inff();
#pragma unroll
    for (int r = 0; r < 16; ++r) { const int c = (r & 3) + 8 * (r >> 2);
        if (dq - c < 0) p0[r] = NEG;
        if (dq - c - 32 < 0) p1[r] = NEG; }
}
__device__ __forceinline__ void partialSM(f32x16& p0, f32x16& p1, float& m_reg, float& alpha) {
    float pmax = p0[0];
#pragma unroll
    for (int r = 1; r < 16; ++r) pmax = fmaxf(pmax, p0[r]);
#pragma unroll
    for (int r = 0; r < 16; ++r) pmax = fmaxf(pmax, p1[r]);
    { auto rr = __builtin_amdgcn_permlane32_swap(__float_as_uint(pmax), __float_as_uint(pmax), false, false);
      pmax = fmaxf(__uint_as_float(rr[0]), __uint_as_float(rr[1])); }
    float mn;
    if (__builtin_expect(__all((pmax - m_reg) <= THR), 1)) { mn = m_reg; alpha = 1.f; }
    else { mn = fmaxf(m_reg, pmax); alpha = __builtin_amdgcn_exp2f(m_reg - mn); m_reg = mn; }
#pragma unroll
    for (int r = 0; r < 16; ++r) p0[r] = __builtin_amdgcn_exp2f(p0[r] - mn);
#pragma unroll
    for (int r = 0; r < 16; ++r) p1[r] = __builtin_amdgcn_exp2f(p1[r] - mn);
}
__device__ __forceinline__ void finishSM(const f32x16& p0, const f32x16& p1, float alpha, float& l_reg, bf16x8& pa0, bf16x8& pa1, bf16x8& pa2, bf16x8& pa3) {
    float ps = 0;
#pragma unroll
    for (int r = 0; r < 16; ++r) ps += p0[r];
#pragma unroll
    for (int r = 0; r < 16; ++r) ps += p1[r];
    { auto rr = __builtin_amdgcn_permlane32_swap(__float_as_uint(ps), __float_as_uint(ps), false, false);
      ps = __uint_as_float(rr[0]) + __uint_as_float(rr[1]); }
    l_reg = l_reg * alpha + ps;
#define PK4(P, B_, OUT) do { unsigned a0 = cvt_pk_bf16(P[B_+0], P[B_+1]), a1 = cvt_pk_bf16(P[B_+2], P[B_+3]); \
        unsigned b0 = cvt_pk_bf16(P[B_+4], P[B_+5]), b1 = cvt_pk_bf16(P[B_+6], P[B_+7]); \
        auto r0 = __builtin_amdgcn_permlane32_swap(a0, b0, false, false); auto r1 = __builtin_amdgcn_permlane32_swap(a1, b1, false, false); \
        u32x4 w = {r0[0], r1[0], r0[1], r1[1]}; OUT = __builtin_bit_cast(bf16x8, w); } while (0)
    PK4(p0, 0, pa0); PK4(p0, 8, pa1); PK4(p1, 0, pa2); PK4(p1, 8, pa3);
#undef PK4
}
template <int KB>
__device__ __forceinline__ void qkt(f32x16& p0, f32x16& p1, const LAS char* K_lds, int r32, int hi, const bf16x8* qr) {
    p0 = f32x16{}; p1 = f32x16{};
    const LAS char* kb[4];
#pragma unroll
    for (int dd = 0; dd < 4; ++dd) kb[dd] = K_lds + KB * SHM_K + KSWZ192(r32, (dd * 16 + hi * 8) * 2);
#pragma unroll
    for (int d0 = 0; d0 < 12; ++d0) { const LAS char* a = kb[d0 & 3] + (d0 >> 2) * 128;
        const bf16x8 b0 = *(const LAS bf16x8*)a;
        const bf16x8 b1 = *(const LAS bf16x8*)(a + 32 * 384);
        p0 = __builtin_amdgcn_mfma_f32_32x32x16_bf16(b0, qr[d0], p0, 0, 0, 0);
        p1 = __builtin_amdgcn_mfma_f32_32x32x16_bf16(b1, qr[d0], p1, 0, 0, 0); }
}
template <int VB>
__device__ __forceinline__ void pv_tile(f32x16* o, unsigned vb0, bf16x8 pa0, bf16x8 pa1, bf16x8 pa2, bf16x8 pa3) {
#define TRRD(dst, off) asm volatile("ds_read_b64_tr_b16 %0, %1 offset:%2" : "=&v"(dst) : "v"(vb0), "i"(off) : "memory")
#define PV_D0(d0) do { s16x4 l0, l1, l2, l3, h0, h1, h2, h3; constexpr int b_ = VB * SHM_V + v_rd_off(d0, 0, 0); \
        TRRD(l0, b_); TRRD(h0, b_ + 2048); TRRD(l1, b_ + 4096); TRRD(h1, b_ + 6144); TRRD(l2, b_ + 8192); TRRD(h2, b_ + 10240); TRRD(l3, b_ + 12288); TRRD(h3, b_ + 14336); \
        asm volatile("s_waitcnt lgkmcnt(0)" ::: "memory"); SBAR(); \
        o[d0] = __builtin_amdgcn_mfma_f32_32x32x16_bf16(pa0, (bf16x8){l0[0], l0[1], l0[2], l0[3], h0[0], h0[1], h0[2], h0[3]}, o[d0], 0, 0, 0); \
        o[d0] = __builtin_amdgcn_mfma_f32_32x32x16_bf16(pa1, (bf16x8){l1[0], l1[1], l1[2], l1[3], h1[0], h1[1], h1[2], h1[3]}, o[d0], 0, 0, 0); \
        o[d0] = __builtin_amdgcn_mfma_f32_32x32x16_bf16(pa2, (bf16x8){l2[0], l2[1], l2[2], l2[3], h2[0], h2[1], h2[2], h2[3]}, o[d0], 0, 0, 0); \
        o[d0] = __builtin_amdgcn_mfma_f32_32x32x16_bf16(pa3, (bf16x8){l3[0], l3[1], l3[2], l3[3], h3[0], h3[1], h3[2], h3[3]}, o[d0], 0, 0, 0); } while (0)
    PV_D0(0); PV_D0(1); PV_D0(2); PV_D0(3);
#undef PV_D0
#undef TRRD
}
struct Stage { u32x4 a, b, c; };
__device__ __forceinline__ void attn_block(const bf16_t* __restrict__ Q, const bf16_t* __restrict__ K, const bf16_t* __restrict__ V, bf16_t* __restrict__ O, int b, int h, int qb, LAS char* lds, int tid) {
    asm volatile("" : "+v"(tid));
    const int wid = __builtin_amdgcn_readfirstlane(tid >> 6), lane = tid & 63, r32 = lane & 31, hi = lane >> 5;
    const int P0 = qb * 256, NT = 4 * qb + 4, qlo = P0 + wid * 32, qm = qlo + r32 - 4 * hi;
    const size_t tb = (size_t)b * 8192;
    LAS char* V_lds = lds + OFF_V; LAS char* K_lds = lds + OFF_K;
    LAS float* wsf = (LAS float*)(lds + OFF_WS) + wid * 64; LAS float* li_l = wsf; LAS float* al_l = wsf + 32;
    const int sr = tid >> 4, sc = (tid & 15) * 8, vst0 = v_st(sr, sc), vst1 = v_st(32 + sr, sc);
#define KMAP(i, kr, kc) const int c_##i = tz_ + 512 * (i); const int kr = c_##i / 24, kc = c_##i - kr * 24
    const unsigned vgo = (unsigned)(sr * 1024 + sc);
    const unsigned vb0 = (unsigned)(uintptr_t)V_lds + (unsigned)v_rd_base(lane);
    const bf16_t* Kh = K + tb * 1536 + h * 192; const bf16_t* Vh = V + tb * 1024 + h * 128;
    bf16x8 qr[12];
    { const bf16_t* qp = Q + (tb + qlo + r32) * 1536 + h * 192 + hi * 8;
#pragma unroll
      for (int d0 = 0; d0 < 12; ++d0) qr[d0] = *(const bf16x8*)(qp + d0 * 16); }
    Stage S;
#define SLOAD_K(k0_) do { int tz_ = tid; asm volatile("" : "+v"(tz_)); KMAP(0, r0_, c0_); KMAP(1, r1_, c1_); KMAP(2, r2_, c2_); const bf16_t* kp_ = Kh + (size_t)(k0_) * 1536; \
        S.a = *(const u32x4*)(kp_ + (r0_ * 1536 + c0_ * 8)); S.b = *(const u32x4*)(kp_ + (r1_ * 1536 + c1_ * 8)); S.c = *(const u32x4*)(kp_ + (r2_ * 1536 + c2_ * 8)); } while (0)
#define SWRITE_K(bf) do { int tz_ = tid; asm volatile("" : "+v"(tz_)); KMAP(0, r0_, c0_); KMAP(1, r1_, c1_); KMAP(2, r2_, c2_); \
        *(LAS u32x4*)(K_lds + (bf) * SHM_K + KSWZ192(r0_, c0_ * 16)) = S.a; *(LAS u32x4*)(K_lds + (bf) * SHM_K + KSWZ192(r1_, c1_ * 16)) = S.b; *(LAS u32x4*)(K_lds + (bf) * SHM_K + KSWZ192(r2_, c2_ * 16)) = S.c; } while (0)
#define SLOAD_V(k0_) do { const bf16_t* vp_ = Vh + (size_t)(k0_) * 1024 + vgo; S.a = *(const u32x4*)(vp_); S.b = *(const u32x4*)(vp_ + 32 * 1024); } while (0)
#define SWRITE_V(bf) do { *(LAS u32x4*)(V_lds + (bf) * SHM_V + vst0) = S.a; *(LAS u32x4*)(V_lds + (bf) * SHM_V + vst1) = S.b; } while (0)
    float m_reg = -1e30f, l_reg = 0.f; f32x16 o[4] = {};
    SLOAD_K(0); SWRITE_K(0); SBAR(); SLOAD_V(0); SWRITE_V(0);
    __syncthreads();
    f32x16 p0, p1; float alpha; bf16x8 pa0, pa1, pa2, pa3;
#define TILE_STEP(t, BUF) do { \
        const int kb_ = (t) * 64; const bool act_ = kb_ <= qlo + 31;     \
        if ((t) + 1 < NT) SLOAD_K(kb_ + 64); \
        SBAR(); if (act_) { __builtin_amdgcn_s_setprio(1); qkt<BUF>(p0, p1, K_lds, r32, hi, qr); __builtin_amdgcn_s_setprio(0); } SBAR(); \
        if ((t) + 1 < NT) { SWRITE_K(1 - BUF); SBAR(); SLOAD_V(kb_ + 64); SBAR(); } \
        if (act_) { \
        if (kb_ + 63 > qlo) mask_tile(p0, p1, qm - kb_); \
        partialSM(p0, p1, m_reg, alpha); \
        if (__any(alpha < 1.f)) { if (hi == 0) al_l[r32] = alpha; asm volatile("s_waitcnt lgkmcnt(0)" ::: "memory"); \
            _Pragma("unroll") for (int d_ = 0; d_ < 4; ++d_) _Pragma("unroll") for (int r = 0; r < 16; ++r) o[d_][r] *= al_l[crow(r, hi)]; } \
        finishSM(p0, p1, alpha, l_reg, pa0, pa1, pa2, pa3); SBAR(); \
        __builtin_amdgcn_s_setprio(1); pv_tile<BUF>(o, vb0, pa0, pa1, pa2, pa3); __builtin_amdgcn_s_setprio(0); } \
        if ((t) + 1 < NT) { SWRITE_V(1 - BUF); } \
        __syncthreads(); } while (0)
    for (int t = 0; t < NT; t += 2) { TILE_STEP(t, 0); TILE_STEP(t + 1, 1); }
#undef TILE_STEP
#undef SLOAD_K
#undef KMAP
#undef SWRITE_K
#undef SLOAD_V
#undef SWRITE_V
    int lz = lane; asm volatile("" : "+v"(lz)); const int r32e = lz & 31, hie = lz >> 5;
    if (hie == 0) li_l[r32e] = l_reg; asm volatile("s_waitcnt lgkmcnt(0)" ::: "memory");
    bf16_t* Ow = O + (tb + qlo) * 1024 + h * 128 + r32e;
#pragma unroll
    for (int r = 0; r < 16; ++r) { const int orow = crow(r, hie); const float rl = __builtin_amdgcn_rcpf(li_l[orow]);
#pragma unroll
        for (int d0 = 0; d0 < 4; ++d0) { const float v = o[d0][r] * rl; const float vn = __shfl_xor(v, 1);
            if ((r32e & 1) == 0) *(unsigned*)(Ow + (size_t)orow * 1024 + d0 * 32) = cvt_pk_bf16(v, vn); } }
    __syncthreads();
}
__device__ __forceinline__ void attn_phase(const bf16_t* Q, const bf16_t* K, const bf16_t* V, bf16_t* O, LAS char* lds, int G, int vcu, int tid) {
    for (int L = vcu; L < 512; L += G) {
        const int bh = L >> 4, x = L & 15, b = bh >> 3, h = bh & 7;
#pragma unroll 1
        for (int pass = 0; pass < 2; ++pass) attn_block(Q, K, V, O, b, h, pass ? 31 - x : x, lds, tid);
    }
}
#undef KSWZ192
#undef SBAR
}


namespace att8 {
constexpr int SHM_K = 64 * 192, SHM_V = 128 * 64;
constexpr int OFF_V = 0, OFF_K = 2 * SHM_V, OFF_WS = 2 * SHM_V + 2 * SHM_K;
constexpr float THR = 4.f * ATT_QS;
#define SBAR() __builtin_amdgcn_sched_barrier(0)
__device__ __forceinline__ int crow(int r, int hi) { return (r & 3) + 8 * (r >> 2) + 4 * hi; }
__device__ __forceinline__ void mfma8(f32x16& acc, pg8::v8i32 a, pg8::v8i32 b, int sc) {
    asm volatile("s_nop 1\n\tv_mfma_scale_f32_32x32x64_f8f6f4 %0, %1, %2, %0, %3, %3 op_sel_hi:[0,0,0]" : "+v"(acc) : "v"(a), "v"(b), "v"(sc)); }
__device__ __forceinline__ pg8::v8i32 cat8u(u32x4 x, u32x4 y) { return (pg8::v8i32){(int)x.x, (int)x.y, (int)x.z, (int)x.w, (int)y.x, (int)y.y, (int)y.z, (int)y.w}; }
__device__ __forceinline__ float max3f(float a, float b, float c) { float r; asm("v_max3_f32 %0, %1, %2, %3" : "=v"(r) : "v"(a), "v"(b), "v"(c)); return r; }
__device__ __forceinline__ unsigned exp2_fp8x4(float a, float b, float c, float d, f32x2 c2, f32x2 o2) {
    const f32x2 t0 = __builtin_elementwise_fma((f32x2){a, b}, c2, o2), t1 = __builtin_elementwise_fma((f32x2){c, d}, c2, o2);
    unsigned w = __builtin_amdgcn_cvt_pk_u8_f32(t0[0], 0u, 0u); w = __builtin_amdgcn_cvt_pk_u8_f32(t0[1], 1u, w);
    w = __builtin_amdgcn_cvt_pk_u8_f32(t1[0], 2u, w); w = __builtin_amdgcn_cvt_pk_u8_f32(t1[1], 3u, w); return w; }
__device__ __forceinline__ void mask_tile(f32x16& p0, f32x16& p1, int dq) {
    const float NEG = -__builtin_inff();
#pragma unroll
    for (int r = 0; r < 16; ++r) { const int c = (r & 3) + 8 * (r >> 2);
        if (dq - c < 0) p0[r] = NEG;
        if (dq - c - 32 < 0) p1[r] = NEG; }
}
#define K8SWZ(row, ch) ((row) * 192 + ((((ch)) ^ (((row) >> 2) & 3)) << 4))
#define V8SWZ(row, ch) ((row) * 64 + ((((ch)) ^ (((row) >> 2) & 3)) << 4))
template <int KB>
__device__ __forceinline__ void qkt(f32x16& p0, f32x16& p1, const LAS char* K_lds, int r32, int hi, const pg8::v8i32* qf, int sc) {
    p0 = f32x16{}; p1 = f32x16{};
#pragma unroll
    for (int st = 0; st < 3; ++st) { const int ch = 4 * st + 2 * hi;
        const LAS char* ka = K_lds + KB * SHM_K;
        const u32x4 a0 = *(const LAS u32x4*)(ka + K8SWZ(r32, ch)), a1 = *(const LAS u32x4*)(ka + K8SWZ(r32, ch + 1));
        const u32x4 b0 = *(const LAS u32x4*)(ka + K8SWZ(32 + r32, ch)), b1 = *(const LAS u32x4*)(ka + K8SWZ(32 + r32, ch + 1));
        mfma8(p0, cat8u(a0, a1), qf[st], sc);
        mfma8(p1, cat8u(b0, b1), qf[st], sc); }
    asm volatile("s_nop 15\n\ts_nop 7" ::: "memory");
}
template <int VB>
__device__ __forceinline__ void pv_tile(f32x16* o, const LAS char* V_lds, int r32, int hi, pg8::v8i32 pa, int sc) {
#pragma unroll
    for (int d0 = 0; d0 < 4; ++d0) { const int row = d0 * 32 + r32; const LAS char* va = V_lds + VB * SHM_V;
        const u32x4 v0 = *(const LAS u32x4*)(va + V8SWZ(row, 2 * hi)), v1 = *(const LAS u32x4*)(va + V8SWZ(row, 2 * hi + 1));
        mfma8(o[d0], pa, cat8u(v0, v1), sc); }
}
struct Stage { u32x4 k0, k1, k2, v0, v1; };
constexpr int SHM_K2 = 128 * 192, SHM_V2 = 2 * SHM_V;
constexpr int NBUF = 3;
constexpr int OFF_K2 = NBUF * SHM_V2, OFF_WS2 = NBUF * SHM_V2 + NBUF * SHM_K2;
__device__ __forceinline__ void mfma8z(f32x16& acc, pg8::v8i32 a, pg8::v8i32 b, int sc) {
    asm volatile("s_nop 1\n\tv_mfma_scale_f32_32x32x64_f8f6f4 %0, %1, %2, 0, %3, %3 op_sel_hi:[0,0,0]" : "=&v"(acc) : "v"(a), "v"(b), "v"(sc)); }
#define KFRAG(ka_, st_, j_, rw_) (*(const LAS u32x4*)((ka_) + kof[j_] + 64 * (st_) + 192 * (rw_)))
#define VFRAG(va_, d0_, j_) (*(const LAS u32x4*)((va_) + vof[j_] + 2048 * (d0_)))
__device__ __forceinline__ void qkt2z(f32x16& p0, f32x16& p1, const LAS char* ka, const int* kof, const pg8::v8i32* qf, int sc) {
#pragma unroll
    for (int st = 0; st < 3; ++st) {
        const u32x4 a0 = KFRAG(ka, st, 0, 0), a1 = KFRAG(ka, st, 1, 0), b0 = KFRAG(ka, st, 0, 32), b1 = KFRAG(ka, st, 1, 32);
        if (st == 0) { mfma8z(p0, cat8u(a0, a1), qf[st], sc); mfma8z(p1, cat8u(b0, b1), qf[st], sc); }
        else { mfma8(p0, cat8u(a0, a1), qf[st], sc); mfma8(p1, cat8u(b0, b1), qf[st], sc); } }
}
__device__ __forceinline__ void pv2(f32x16* o, const LAS char* va, const int* vof, pg8::v8i32 pa, int sc) {
#pragma unroll
    for (int d0 = 0; d0 < 4; ++d0) mfma8(o[d0], pa, cat8u(VFRAG(va, d0, 0), VFRAG(va, d0, 1)), sc);
}
template <int I> __device__ __forceinline__ void cvt_ch(pg8::v8i32& pa, const f32x16& p0, const f32x16& p1, f32x2 c2, f32x2 o2) {
    constexpr int j = 4 * (I & 3);
    int w; if (I < 4) w = (int)exp2_fp8x4(p0[j], p0[j + 1], p0[j + 2], p0[j + 3], c2, o2); else w = (int)exp2_fp8x4(p1[j], p1[j + 1], p1[j + 2], p1[j + 3], c2, o2);
    asm volatile("" : "+v"(w)); pa[I] = w; }
template <int G> __device__ __forceinline__ float max_grp(float m, const f32x16& p0, const f32x16& p1) {
    const f32x16& p = G < 2 ? p0 : p1; constexpr int j = 8 * (G & 1);
    if (G == 0) { m = max3f(p[0], p[1], p[2]); m = max3f(m, p[3], p[4]); m = max3f(m, p[5], p[6]); m = max3f(m, p[7], p[7]); }
    else { m = max3f(m, p[j], p[j + 1]); m = max3f(m, p[j + 2], p[j + 3]); m = max3f(m, p[j + 4], p[j + 5]); m = max3f(m, p[j + 6], p[j + 7]); }
    return m; }
__device__ __forceinline__ void attn_block(const unsigned char* __restrict__ Q, const unsigned char* __restrict__ K, const unsigned char* __restrict__ VT, bf16_t* __restrict__ O, int b, int h, int qb, LAS char* lds, int tid) {
    asm volatile("" : "+v"(tid));
    const int wid = __builtin_amdgcn_readfirstlane(tid >> 6), lane = tid & 63, r32 = lane & 31, hi = lane >> 5;
    const int P0 = qb * 256, NS = 2 * qb + 2, qlo = P0 + wid * 32, qm = qlo + r32 - 4 * hi;
    const size_t tb = (size_t)b * 8192;
    LAS char* V_lds = lds; LAS char* K_lds = lds + OFF_K2;
    LAS float* wsf = (LAS float*)(lds + OFF_WS2) + wid * 64; LAS float* al_l = wsf + 32;
    const unsigned char* Kh = K + tb * 1536 + h * 192; const unsigned char* Vh = VT + (size_t)((b * 8 + h) * 128) * 8192;
    int sc = 0x7F7F7F7F; asm volatile("" : "+v"(sc));
    pg8::v8i32 qf[3];
    { const unsigned char* qp = Q + (tb + qlo + r32) * 1536 + h * 192 + hi * 32;
#pragma unroll
      for (int st = 0; st < 3; ++st) qf[st] = cat8u(*(const u32x4*)(qp + st * 64), *(const u32x4*)(qp + st * 64 + 16)); }
    const int swz_ = (r32 >> 2) & 3;
    const int kof[2] = {r32 * 192 + (((2 * hi) ^ swz_) << 4), r32 * 192 + (((2 * hi + 1) ^ swz_) << 4)}, vof[2] = {r32 * 64 + (((2 * hi) ^ swz_) << 4), r32 * 64 + (((2 * hi + 1) ^ swz_) << 4)};
    unsigned kgo[3], vgo;
#pragma unroll
    for (int i = 0; i < 3; ++i) { const int c = (wid * 3 + i) * 64 + lane, rw = c / 12, x = c - rw * 12; kgo[i] = (unsigned)(rw * 1536 + (((x & ~3) | ((x & 3) ^ ((rw >> 2) & 3))) << 4)); }
    { const int c = wid * 64 + lane, rw = c >> 2; vgo = (unsigned)((rw * 4 + ((c & 3) ^ ((rw >> 2) & 3))) << 4); }
#define SDMA_K(s_, bf) do { const unsigned char* kp_ = Kh + (size_t)(s_) * (128 * 1536); LAS char* kd_ = K_lds + (bf) * SHM_K2 + wid * 3072; \
        _Pragma("unroll") for (int i_ = 0; i_ < 3; ++i_) __builtin_amdgcn_global_load_lds((const unsigned*)(kp_ + kgo[i_]), (LAS unsigned*)(kd_ + i_ * 1024), 16, 0, 0); } while (0)
#define SDMA_V(s_, bf) do { const unsigned char* vp_ = Vh + (size_t)(s_) * 16384 + vgo; LAS char* vd_ = V_lds + (bf) * SHM_V2 + wid * 1024; \
        __builtin_amdgcn_global_load_lds((const unsigned*)vp_, (LAS unsigned*)vd_, 16, 0, 0); __builtin_amdgcn_global_load_lds((const unsigned*)(vp_ + 8192), (LAS unsigned*)(vd_ + SHM_V), 16, 0, 0); } while (0)
#define SDMA_WAIT() asm volatile("s_waitcnt vmcnt(0)" ::: "memory")
    LAS char* ones_l = lds + OFF_WS2 + 2048;
    if (tid < 8) ((LAS unsigned*)ones_l)[tid] = 0x38383838u;
    float m_reg = -1e30f; f32x16 o[4] = {}; f32x16 lacc = {};
#define ONES8() cat8u(*(const LAS u32x4*)ones_l, *(const LAS u32x4*)(ones_l + 16))
    SDMA_K(0, 0); SDMA_V(0, 0); SDMA_K(1, 1); SDMA_V(1, 1);
    asm volatile("s_waitcnt vmcnt(5) lgkmcnt(0)" ::: "memory");
    __builtin_amdgcn_s_barrier();
    f32x16 pA0, pA1, pB0, pB1;
    constexpr float ISQ = 1.0f / ATT_QS;
#define SM_DECIDE(PM_, O2_, RESC_) do { float pmax = (PM_); \
        { auto rr = __builtin_amdgcn_permlane32_swap(__float_as_uint(pmax), __float_as_uint(pmax), false, false); pmax = fmaxf(__uint_as_float(rr[0]), __uint_as_float(rr[1])); } \
        float mn, alpha; \
        if (__builtin_expect(__all((pmax - m_reg) <= THR), 1)) { mn = m_reg; alpha = 1.f; RESC_ = false; } \
        else { mn = fmaxf(m_reg, pmax); alpha = __builtin_amdgcn_exp2f((m_reg - mn) * ISQ); m_reg = mn; RESC_ = true; } \
        const float off8_ = 88.0f - mn * (8.0f * ISQ); O2_ = (f32x2){off8_, off8_}; \
        if (__any(alpha < 1.f)) { if (hi == 0) al_l[r32] = alpha; asm volatile("s_nop 15\n\ts_nop 7\n\ts_waitcnt lgkmcnt(0)" ::: "memory");     \
            _Pragma("unroll") for (int r = 0; r < 16; ++r) { const float a_ = al_l[crow(r, hi)]; o[0][r] *= a_; o[1][r] *= a_; o[2][r] *= a_; o[3][r] *= a_; lacc[r] *= a_; } } } while (0)
#define CVT_ALL(PA_, P0_, P1_, O2_) do { cvt_ch<0>(PA_, P0_, P1_, c2_, O2_); cvt_ch<1>(PA_, P0_, P1_, c2_, O2_); cvt_ch<2>(PA_, P0_, P1_, c2_, O2_); cvt_ch<3>(PA_, P0_, P1_, c2_, O2_); \
        cvt_ch<4>(PA_, P0_, P1_, c2_, O2_); cvt_ch<5>(PA_, P0_, P1_, c2_, O2_); cvt_ch<6>(PA_, P0_, P1_, c2_, O2_); cvt_ch<7>(PA_, P0_, P1_, c2_, O2_); } while (0)
    const f32x2 c2_ = {8.0f * ISQ, 8.0f * ISQ};
    struct KF { u32x4 a0, a1, b0, b1; }; struct VF { u32x4 v0, v1; };
#define LDK(ka_, st_) KF{KFRAG(ka_, st_, 0, 0), KFRAG(ka_, st_, 1, 0), KFRAG(ka_, st_, 0, 32), KFRAG(ka_, st_, 1, 32)}
#define LDV(va_, d0_) VF{VFRAG(va_, d0_, 0), VFRAG(va_, d0_, 1)}
#define STEP(s_, BUF) do { \
        const int kb0_ = (s_) * 128, kb1_ = kb0_ + 64;     \
        const int sn_ = (s_) + 2 < NS ? (s_) + 2 : NS - 1;     \
        const LAS char* kbuf_ = K_lds + BUF * SHM_K2; const LAS char* vbuf_ = V_lds + BUF * SHM_V2; const LAS char* kb_ = kbuf_ + 64 * 192; const LAS char* vb_ = vbuf_ + SHM_V; \
        KF f0 = LDK(kbuf_, 0), f1 = LDK(kbuf_, 1);             \
        { \
            pg8::v8i32 pa, pb; float pmb_ = 0.f; f32x2 o2a_, o2b_; VF v0, v1, w0, w1; bool ra_, rb_; \
            { SBAR(); mfma8z(pA0, cat8u(f0.a0, f0.a1), qf[0], sc); mfma8z(pA1, cat8u(f0.b0, f0.b1), qf[0], sc); SBAR(); \
              KF f2 = LDK(kbuf_, 2); SBAR(); SDMA_K(sn_, (BUF + 2) % NBUF);     \
              SBAR(); mfma8(pA0, cat8u(f1.a0, f1.a1), qf[1], sc); mfma8(pA1, cat8u(f1.b0, f1.b1), qf[1], sc); SBAR(); \
              KF g0 = LDK(kb_, 0); SBAR(); SDMA_V(sn_, (BUF + 2) % NBUF); \
              SBAR(); mfma8(pA0, cat8u(f2.a0, f2.a1), qf[2], sc); mfma8(pA1, cat8u(f2.b0, f2.b1), qf[2], sc); SBAR(); \
              KF g1 = LDK(kb_, 1); \
                \
                \
              SBAR(); mfma8z(pB0, cat8u(g0.a0, g0.a1), qf[0], sc); mfma8z(pB1, cat8u(g0.b0, g0.b1), qf[0], sc); SBAR(); \
              asm volatile("s_nop 7" ::: "memory"); \
              if (kb0_ + 63 > qlo) mask_tile(pA0, pA1, qm - kb0_); \
              float pm_ = 0.f; pm_ = max_grp<0>(pm_, pA0, pA1); pm_ = max_grp<1>(pm_, pA0, pA1); pm_ = max_grp<2>(pm_, pA0, pA1); pm_ = max_grp<3>(pm_, pA0, pA1); \
              SM_DECIDE(pm_, o2a_, ra_); \
                \
              KF g2 = LDK(kb_, 2); \
              SBAR(); mfma8(pB0, cat8u(g1.a0, g1.a1), qf[1], sc); SBAR(); cvt_ch<0>(pa, pA0, pA1, c2_, o2a_); cvt_ch<1>(pa, pA0, pA1, c2_, o2a_); cvt_ch<2>(pa, pA0, pA1, c2_, o2a_); \
              SBAR(); mfma8(pB1, cat8u(g1.b0, g1.b1), qf[1], sc); SBAR(); cvt_ch<3>(pa, pA0, pA1, c2_, o2a_); cvt_ch<4>(pa, pA0, pA1, c2_, o2a_); \
              v0 = LDV(vbuf_, 0); v1 = LDV(vbuf_, 1); \
              SBAR(); mfma8(pB0, cat8u(g2.a0, g2.a1), qf[2], sc); SBAR(); cvt_ch<5>(pa, pA0, pA1, c2_, o2a_); cvt_ch<6>(pa, pA0, pA1, c2_, o2a_); \
              SBAR(); mfma8(pB1, cat8u(g2.b0, g2.b1), qf[2], sc); SBAR(); cvt_ch<7>(pa, pA0, pA1, c2_, o2a_); } \
              \
            if (kb1_ + 63 > qlo) { asm volatile("s_nop 15\n\ts_nop 7" ::: "memory"); mask_tile(pB0, pB1, qm - kb1_); } \
              \
            { SBAR(); mfma8(o[0], pa, cat8u(v0.v0, v0.v1), sc); asm volatile("s_nop 7" ::: "memory"); SBAR(); \
              VF v2 = LDV(vbuf_, 2); pmb_ = max_grp<0>(pmb_, pB0, pB1); cvt_ch<0>(pb, pB0, pB1, c2_, o2a_); cvt_ch<1>(pb, pB0, pB1, c2_, o2a_); \
              SBAR(); mfma8(o[1], pa, cat8u(v1.v0, v1.v1), sc); SBAR(); \
              VF v3 = LDV(vbuf_, 3); pmb_ = max_grp<1>(pmb_, pB0, pB1); cvt_ch<2>(pb, pB0, pB1, c2_, o2a_); cvt_ch<3>(pb, pB0, pB1, c2_, o2a_); \
              SBAR(); mfma8(o[2], pa, cat8u(v2.v0, v2.v1), sc); SBAR(); \
              const pg8::v8i32 on_ = ONES8(); pmb_ = max_grp<2>(pmb_, pB0, pB1); cvt_ch<4>(pb, pB0, pB1, c2_, o2a_); cvt_ch<5>(pb, pB0, pB1, c2_, o2a_); \
              SBAR(); mfma8(o[3], pa, cat8u(v3.v0, v3.v1), sc); SBAR(); \
              w0 = LDV(vb_, 0); w1 = LDV(vb_, 1); pmb_ = max_grp<3>(pmb_, pB0, pB1); cvt_ch<6>(pb, pB0, pB1, c2_, o2a_); cvt_ch<7>(pb, pB0, pB1, c2_, o2a_); \
              SBAR(); mfma8(lacc, pa, on_, sc); SBAR(); } \
            SM_DECIDE(pmb_, o2b_, rb_); \
            if (rb_) CVT_ALL(pb, pB0, pB1, o2b_); \
            { SBAR(); mfma8(o[0], pb, cat8u(w0.v0, w0.v1), sc); SBAR(); \
              VF w2 = LDV(vb_, 2); \
              SBAR(); mfma8(o[1], pb, cat8u(w1.v0, w1.v1), sc); SBAR(); \
              VF w3 = LDV(vb_, 3); \
              SBAR(); mfma8(o[2], pb, cat8u(w2.v0, w2.v1), sc); SBAR(); \
              const pg8::v8i32 on_ = ONES8(); \
              SBAR(); mfma8(o[3], pb, cat8u(w3.v0, w3.v1), sc); mfma8(lacc, pb, on_, sc); SBAR(); } \
        } \
        asm volatile("s_waitcnt vmcnt(5) lgkmcnt(0)" ::: "memory");     \
        __builtin_amdgcn_s_barrier(); } while (0)
    for (int s_i = 0; s_i < NS; s_i += 3) { STEP(s_i, 0); if (s_i + 1 < NS) STEP(s_i + 1, 1); if (s_i + 2 < NS) STEP(s_i + 2, 2); }
    SDMA_WAIT();
#undef STEP
#undef SM_DECIDE
#undef CVT_ALL
#undef SDMA_K
#undef SDMA_V
#undef SDMA_WAIT
#undef ONES8
#undef LDK
#undef LDV
    int lz = lane; asm volatile("" : "+v"(lz)); const int r32e = lz & 31, hie = lz >> 5;
    asm volatile("s_nop 15\n\ts_nop 7" ::: "memory");
    LAS unsigned char* stg = (LAS unsigned char*)lds + OFF_WS2 + 2112 + wid * 1152;
    unsigned char* Ob = (unsigned char*)O + (tb + qlo) * 1024 + h * 128;
#pragma unroll
    for (int q = 0; q < 4; ++q) {
#pragma unroll
        for (int rr = 0; rr < 4; ++rr) { const int r = 4 * q + rr, lrow = rr + 4 * hie;
            const float rl = __builtin_amdgcn_rcpf(lacc[r] * (ATT_VS / OB_SCALE));
#pragma unroll
            for (int d0 = 0; d0 < 4; ++d0) { const float v = o[d0][r] * rl; const float vn = DPP_F(v, 0xB1);
                if ((r32e & 1) == 0) *(LAS unsigned short*)(stg + lrow * 144 + d0 * 32 + r32e) = (unsigned short)__builtin_amdgcn_cvt_pk_fp8_f32(v, vn, 0, false); } }
        asm volatile("s_waitcnt lgkmcnt(0)" ::: "memory");
        { const int row = lz >> 3, ch = lz & 7; const u32x4 w = *(const LAS u32x4*)(stg + row * 144 + ch * 16);
          *(u32x4*)(Ob + (size_t)(8 * q + row) * 1024 + ch * 16) = w; }
        __builtin_amdgcn_sched_barrier(0); }
    __syncthreads();
}
#undef KFRAG
#undef VFRAG
__device__ __forceinline__ void attn_phase(const unsigned char* Q, const unsigned char* K, const unsigned char* VT, bf16_t* O, LAS char* lds, int G, int vcu, int tid) {
    for (int L = vcu; L < 512; L += G) {
        const int bh = L >> 4, x = L & 15, b = bh >> 3, h = bh & 7;
#pragma unroll 1
        for (int pass = 0; pass < 2; ++pass) attn_block(Q, K, VT, O, b, h, pass ? 31 - x : x, lds, tid);
    }
}
#undef K8SWZ
#undef V8SWZ
#undef SBAR
}

#ifndef PH_MASK
#define PH_MASK 0xffffffffu
#endif
#define PH_ON(n) (((PH_MASK) >> (n)) & 1u)
#ifndef REP_MASK
#define REP_MASK 0u
#endif
#define REP(n) (1 + (int)(((REP_MASK) >> (n)) & 1u))
__global__ void __launch_bounds__(512, 2) yoco_fwd(const Params p) {
    extern __shared__ __attribute__((aligned(16))) unsigned char lds_raw[];
    LAS unsigned char* lds = (LAS unsigned char*)lds_raw;
    const int G0 = gridDim.x, bx0 = blockIdx.x, vcu0 = (G0 % 8 == 0) ? (bx0 % 8) * (G0 / 8) + bx0 / 8 : bx0;
    volatile LAS unsigned* misc = (volatile LAS unsigned*)(lds + MISC_OFF);
    for (int i = threadIdx.x; i < (LDS_BYTES - MISC_OFF) / 4; i += 512) misc[i] = 0u;
    __syncthreads();
    XcdBarrier bar = xcd_barrier_post((unsigned*)(p.ws + WS_CTL) + CW_BAR, misc + MW_BAR);
#define GRID_BAR() xcd_barrier(bar)
#define PHASE_VARS() KPtr pp = (KPtr)__builtin_amdgcn_kernarg_segment_ptr(); asm volatile("" : "+s"(pp)); unsigned char* ws = pp->ws; (void)pp; \
    int G = G0, bx = bx0, vcu = vcu0; asm volatile("" : "+s"(G), "+s"(bx), "+s"(vcu)); const int NGW = G * 8; (void)NGW; (void)bx; int tid = bar.wave * 64 + lane_id(); asm volatile("" : "+v"(tid)); \
    const int lane = tid & 63, wave = bar.wave, gw = vcu * 8 + wave; (void)lane; (void)gw; (void)ws

    { PHASE_VARS(); if (PH_ON(0)) prologue_phase(pp, ws, lds, tid, vcu, G, gw, NGW, lane, 2, NTJOBS, true); }
    GRID_BAR();
    { PHASE_VARS(); if (PH_ON(0) && (vcu & 1)) prologue_phase(pp, ws, lds, tid, vcu, G, gw, NGW, lane, 0, 2, false); }
    for (int l = 0; l < 4; ++l) { PHASE_VARS();
        DenseSched S; S.init((const bf16_t*)(ws + WS_PB) + (size_t)l * T * 256, (const bf16_t*)(ws + WS_WPP) + (size_t)l * 1024 * 256, T, 1024, 256, 256, G, bx);
        EpiBf16 E{(bf16_t*)(ws + WS_PP) + (size_t)l * T * 1024, 1024};
        if (PH_ON(1)) for (int r_ = 0; r_ < REP(1); ++r_) pg8::gemm_phase(lds, tid, 256, 256, 256, S, E);
    }

    for (int l = 0; l < 4; ++l) {
        if (l < 2) {
            { PHASE_VARS(); DenseSched S; S.init((const bf16_t*)(ws + WS_XBA), (const bf16_t*)(ws + WS_WRIN) + (size_t)l * 6144 * 1024, T, 4096, 1024, 1024, G, bx);
              EpiRetA E{(bf16_t*)(ws + WS_QB), (bf16_t*)(ws + WS_ACAT), (bf16_t*)(ws + WS_GB), (bf16_t*)(ws + WS_KB), (const float*)(ws + WS_COSR), (const float*)(ws + WS_SINR), (bf16_t*)(ws + WS_KDT)};
              if (PH_ON(2)) for (int r_ = 0; r_ < REP(2); ++r_) pg8::gemm_phase(lds, tid, 1024, 1024, 1024, S, E); }
#if G1B_FP8
            { PHASE_VARS(); DenseSched S; S.init((const bf16_t*)(ws + WS_WV8 + (size_t)l * 2048 * 1024), (const bf16_t*)(ws + WS_XF8), 2048, T, 512, 512, G, bx);
              EpiRetB E{(bf16_t*)(ws + WS_VS), 1.0f / WV_SCALE};
              if (PH_ON(3)) for (int r_ = 0; r_ < REP(3); ++r_) pg8::gemm_phase<true>(lds, tid, 512, 512, 512, S, E); }
#else
            { PHASE_VARS(); DenseSched S; S.init((const bf16_t*)(ws + WS_WRIN) + (size_t)l * 6144 * 1024 + (size_t)4096 * 1024, (const bf16_t*)(ws + WS_XBA), 2048, T, 1024, 1024, G, bx);
              EpiRetB E{(bf16_t*)(ws + WS_VS)};
              if (PH_ON(3)) for (int r_ = 0; r_ < REP(3); ++r_) pg8::gemm_phase(lds, tid, 1024, 1024, 1024, S, E); }
#endif
            if (l == 0) { PHASE_VARS(); if (PH_ON(0) && !(vcu & 1)) prologue_phase(pp, ws, lds, tid, vcu, G, gw, NGW, lane, 0, 2, false); }
            GRID_BAR();
            { PHASE_VARS(); SchedG2 S{(const char*)(ws + WS_ACAT), (const char*)(ws + WS_KB), G, bx}; EpiRetP E{(bf16_t*)(ws + WS_ACAT)};
              if (PH_ON(4)) for (int r_ = 0; r_ < REP(4); ++r_) pg8::gemm_phase(lds, tid, 2048, 1024, 256, S, E); }
            { PHASE_VARS(); SchedG3 S{(const char*)(ws + WS_VS), (const char*)(ws + WS_KDT), G, bx}; EpiRetU E{(bf16_t*)(ws + WS_VS)};
              if (PH_ON(5)) for (int r_ = 0; r_ < REP(5); ++r_) pg8::gemm_phase(lds, tid, 512, 256, 256, S, E); }
            GRID_BAR();
            { PHASE_VARS(); if (PH_ON(6)) for (int r_ = REP(6) - 1; r_ >= 0; --r_) ret_scan_phase(ws, gw * 64 + lane, NGW * 64, r_ != 0); }
            GRID_BAR();
            { PHASE_VARS(); SchedG4 S{(const char*)(ws + WS_ACAT), (const char*)(ws + WS_VS), G, bx}; EpiBf16 E{(bf16_t*)(ws + WS_Y), 2048};
              if (PH_ON(7)) for (int r_ = 0; r_ < REP(7); ++r_) pg8::gemm_phase(lds, tid, 2048, 512, 512, S, E); }
            GRID_BAR();
            { PHASE_VARS(); if (PH_ON(8)) for (int r_ = 0; r_ < REP(8); ++r_) ret_gn_phase(pp, ws, l, lane, gw, NGW); }
            GRID_BAR();
#if G5_FP8
            { PHASE_VARS(); DenseSched S; S.init((const bf16_t*)(ws + WS_Z), (const bf16_t*)((unsigned char*)(ws + WS_WROUT) + (size_t)l * 1024 * 2048), T, 1024, 1024, 1024, G, bx);
              EpiBf16 E{(bf16_t*)(ws + WS_MIX), 1024, 1.0f / (WROUT_SCALE * Z_SCALE)};
              if (PH_ON(9)) for (int r_ = 0; r_ < REP(9); ++r_) pg8::gemm_phase<true>(lds, tid, 1024, 1024, 1024, S, E); }
#else
            { PHASE_VARS(); DenseSched S; S.init((const bf16_t*)(ws + WS_Z), (const bf16_t*)(ws + WS_WROUT) + (size_t)l * 1024 * 2048, T, 1024, 2048, 2048, G, bx);
              EpiBf16 E{(bf16_t*)(ws + WS_MIX), 1024};
              if (PH_ON(9)) for (int r_ = 0; r_ < REP(9); ++r_) pg8::gemm_phase(lds, tid, 2048, 2048, 2048, S, E); }
#endif
            GRID_BAR();
        } else {
            const int j = l - 2;
#if ATT_FP8
            if (l == 2) { PHASE_VARS(); DenseSched S; S.init((const bf16_t*)(ws + WS_XF8), (const bf16_t*)(ws + WS_WKVA), T, 512, 512, 512, G, bx);
              EpiKVA E{(bf16_t*)(ws + WS_CKV), (float*)(ws + WS_SSQ), (bf16_t*)(ws + WS_KBUF), (const float*)(ws + WS_COSM), (const float*)(ws + WS_SINM), 1.0f / WKVA_SCALE};
              if (PH_ON(10)) for (int r_ = 0; r_ < REP(10); ++r_) pg8::gemm_phase<true>(lds, tid, 512, 512, 512, S, E); }
            { PHASE_VARS(); DenseSched S; S.init((const bf16_t*)(ws + WS_XF8), (const bf16_t*)((unsigned char*)(ws + WS_WQA) + (size_t)j * 256 * 1024), T, 256, 512, 512, G, bx);
              EpiQA E{(bf16_t*)(ws + WS_QLAT), (float*)(ws + WS_SSQ2), 1.0f / WQA_SCALE};
              if (PH_ON(11)) for (int r_ = 0; r_ < REP(11); ++r_) pg8::gemm_phase<true>(lds, tid, 512, 512, 512, S, E); }
#else
            if (l == 2) { PHASE_VARS(); DenseSched S; S.init((const bf16_t*)(ws + WS_XBA), (const bf16_t*)(ws + WS_WKVA), T, 512, 1024, 1024, G, bx);
              EpiKVA E{(bf16_t*)(ws + WS_CKV), (float*)(ws + WS_SSQ), (bf16_t*)(ws + WS_KBUF), (const float*)(ws + WS_COSM), (const float*)(ws + WS_SINM), 1.0f};
              if (PH_ON(10)) for (int r_ = 0; r_ < REP(10); ++r_) pg8::gemm_phase(lds, tid, 1024, 1024, 1024, S, E); }
            { PHASE_VARS(); DenseSched S; S.init((const bf16_t*)(ws + WS_XBA), (const bf16_t*)(ws + WS_WQA) + (size_t)j * 256 * 1024, T, 256, 1024, 1024, G, bx);
              EpiQA E{(bf16_t*)(ws + WS_QLAT), (float*)(ws + WS_SSQ2), 1.0f};
              if (PH_ON(11)) for (int r_ = 0; r_ < REP(11); ++r_) pg8::gemm_phase(lds, tid, 1024, 1024, 1024, S, E); }
#endif
            GRID_BAR();
            if (l == 2) { PHASE_VARS(); DenseSched S; S.init((const bf16_t*)(ws + WS_CKV), (const bf16_t*)(ws + WS_WKVB), T, 2048, 256, 256, G, bx);
              EpiKVB E{(bf16_t*)(ws + WS_KBUF), (bf16_t*)(ws + WS_VBUF), (const float*)(ws + WS_SSQ)};
              if (PH_ON(12)) for (int r_ = 0; r_ < REP(12); ++r_) pg8::gemm_phase(lds, tid, 256, 256, 256, S, E); }
            { PHASE_VARS(); DenseSched S; S.init((const bf16_t*)(ws + WS_QLAT), (const bf16_t*)(ws + WS_WQB) + (size_t)j * 1536 * 256, T, 1536, 256, 256, G, bx);
              EpiQB E{(bf16_t*)(ws + WS_QBUF), (const float*)(ws + WS_SSQ2), (const float*)(ws + WS_COSM), (const float*)(ws + WS_SINM)};
              if (PH_ON(13)) for (int r_ = 0; r_ < REP(13); ++r_) pg8::gemm_phase(lds, tid, 256, 256, 256, S, E); }
            GRID_BAR();
            { PHASE_VARS(); if (PH_ON(14)) for (int r_ = 0; r_ < REP(14); ++r_)
#if ATT_FP8
              att8::attn_phase((const unsigned char*)(ws + WS_QBUF), (const unsigned char*)(ws + WS_KBUF), (const unsigned char*)(ws + WS_VBUF), (bf16_t*)(ws + WS_OB), (LAS char*)lds, G, vcu, tid); }
#else
              att::attn_phase((const bf16_t*)(ws + WS_QBUF), (const bf16_t*)(ws + WS_KBUF), (const bf16_t*)(ws + WS_VBUF), (bf16_t*)(ws + WS_OB), (LAS char*)lds, G, vcu, tid); }
#endif
            GRID_BAR();
#if ATT_FP8
            { PHASE_VARS(); DenseSched S; S.init((const bf16_t*)(ws + WS_OB), (const bf16_t*)((unsigned char*)(ws + WS_WO) + (size_t)j * 1024 * 1024), T, 1024, 512, 512, G, bx);
              EpiBf16 E{(bf16_t*)(ws + WS_MIX), 1024, 1.0f / (WO_SCALE * OB_SCALE)};
              if (PH_ON(15)) for (int r_ = 0; r_ < REP(15); ++r_) pg8::gemm_phase<true>(lds, tid, 512, 512, 512, S, E); }
#else
            { PHASE_VARS(); DenseSched S; S.init((const bf16_t*)(ws + WS_OB), (const bf16_t*)(ws + WS_WO) + (size_t)j * 1024 * 1024, T, 1024, 1024, 1024, G, bx);
              EpiBf16 E{(bf16_t*)(ws + WS_MIX), 1024};
              if (PH_ON(15)) for (int r_ = 0; r_ < REP(15); ++r_) pg8::gemm_phase(lds, tid, 1024, 1024, 1024, S, E); }
#endif
            GRID_BAR();
        }
        { PHASE_VARS(); const bf16_t* hin = (const bf16_t*)(ws + WS_XBA);
          if (PH_ON(16)) for (int r_ = REP(16) - 1; r_ >= 0; --r_) ln1_router_phase(pp, ws, lds, l, hin, tid, wave, lane, G, r_ != 0); }
        GRID_BAR();
        { PHASE_VARS(); if (PH_ON(17)) plan_phase(ws, lds, l, tid);
          MoeSched S{nullptr, (const char*)(ws + WS_WGU) + (size_t)l * 32 * 2048 * 1024, (size_t)2048 * 1024, 8, G, vcu, misc, (const char*)(ws + WS_XBB), (const int*)(ws + WS_XG)};
          EpiGU E{(unsigned char*)(ws + WS_ACT), pp->in[21] + (size_t)l * 32 * 2048};
          if (PH_ON(18)) for (int r_ = 0; r_ < REP(18); ++r_) pg8::gemm_phase<true, true, true>(lds, tid, 512, 512, 512, S, E); }
        GRID_BAR();
        { PHASE_VARS(); MoeSched S{(const char*)(ws + WS_ACT), (const char*)(ws + WS_WDN) + (size_t)l * 32 * 1024 * 1024, (size_t)1024 * 1024, 4, G, vcu, misc, nullptr, nullptr};
          EpiDN E{(unsigned char*)(ws + WS_YS), pp->in[23] + (size_t)l * 32 * 1024};
          if (PH_ON(19)) for (int r_ = 0; r_ < REP(19); ++r_) pg8::gemm_phase<true>(lds, tid, 512, 512, 512, S, E); }
        GRID_BAR();
        { PHASE_VARS(); if (PH_ON(20)) for (int r_ = REP(20) - 1; r_ >= 0; --r_) ln2_phase(pp, ws, lds, l, lane, gw, NGW, r_ != 0); }
        GRID_BAR();
        { PHASE_VARS(); DenseSched S; S.init((const bf16_t*)(ws + WS_XBB), (const bf16_t*)(ws + WS_WPG) + (size_t)l * 1024 * 1024, T, 1024, 1024, 1024, G, bx);
          if (REP(21) == 2) { EpiPLE E{(const bf16_t*)(ws + WS_XBB), nullptr, (bf16_t*)(ws + WS_END + (size_t)T * 4096), (const bf16_t*)(ws + WS_PP) + (size_t)l * T * 1024, (unsigned char*)(ws + WS_END + (size_t)T * 6144)};
            pg8::gemm_phase(lds, tid, 1024, 1024, 1024, S, E); }
          EpiPLE E{(const bf16_t*)(ws + WS_XBB), (l == 3) ? pp->out : nullptr, (bf16_t*)(ws + WS_XBA), (const bf16_t*)(ws + WS_PP) + (size_t)l * T * 1024, (unsigned char*)(ws + WS_XF8)};
          if (PH_ON(21)) pg8::gemm_phase(lds, tid, 1024, 1024, 1024, S, E); }
        GRID_BAR();
    }
}

extern "C" void kernel_launch(void* const* d_in, const int* in_sizes, int n_in, void* d_out, int out_size, void* d_ws, size_t ws_size, hipStream_t stream) {
    static int grid = 0;
    if (grid == 0) {
        if (n_in != 26 || in_sizes[0] != T * D || out_size != T * D || ws_size < WS_END + ((size_t)300 << 20)) {
            fprintf(stderr, "kernel_launch: unexpected shapes (n_in %d, in0 %d, out %d, ws %zu need %zu); nothing launched\n", n_in, n_in > 0 ? in_sizes[0] : -1, out_size, ws_size, (size_t)WS_END); grid = -1; return; }
        int dev = 0, cus = 0, per_cu = 0;
        if (hipGetDevice(&dev) != hipSuccess || hipDeviceGetAttribute(&cus, hipDeviceAttributeMultiprocessorCount, dev) != hipSuccess) { grid = -1; return; }
        if (hipFuncSetAttribute((const void*)yoco_fwd, hipFuncAttributeMaxDynamicSharedMemorySize, LDS_BYTES) != hipSuccess) { fprintf(stderr, "kernel_launch: hipFuncSetAttribute failed\n"); grid = -1; return; }
        if (hipOccupancyMaxActiveBlocksPerMultiprocessor(&per_cu, (const void*)yoco_fwd, 512, LDS_BYTES) != hipSuccess || per_cu < 1)
            fprintf(stderr, "kernel_launch: note: occupancy query reports %d workgroups per CU\n", per_cu);
        (void)hipGetLastError();
        grid = cus;
    }
    if (grid < 0) return;
    if (hipMemsetAsync((char*)d_ws + WS_CTL, 0, CTL_BYTES, stream) != hipSuccess) { fprintf(stderr, "kernel_launch: memset failed\n"); return; }
    Params a{};
    for (int i = 0; i < 26; ++i) a.in[i] = (const float*)d_in[i];
    a.out = (float*)d_out; a.ws = (unsigned char*)d_ws;
    hipLaunchKernelGGL(yoco_fwd, dim3(grid), dim3(512), LDS_BYTES, stream, a);
    const hipError_t le = hipPeekAtLastError();
    if (le != hipSuccess) fprintf(stderr, "kernel_launch: launch failed: %s\n", hipGetErrorName(le));
}
```

```cpp
#include <hip/hip_runtime.h>
#include <cstdio>
#include <cstdint>

#define LAS __attribute__((address_space(3)))
#define GAS __attribute__((address_space(1)))
typedef unsigned short bf16_t;
typedef short bf16x8 __attribute__((ext_vector_type(8)));
typedef short s16x4 __attribute__((ext_vector_type(4)));
typedef float f32x4 __attribute__((ext_vector_type(4)));
typedef float f32x2 __attribute__((ext_vector_type(2)));
typedef float f32x16 __attribute__((ext_vector_type(16)));
typedef unsigned u32x4 __attribute__((ext_vector_type(4)));
typedef unsigned u32x2 __attribute__((ext_vector_type(2)));

constexpr int T = 32768, SEQ = 8192, NB = 4, D = 1024, DEPTH = 4, NE = 32;
constexpr int NSLOT = T * 4 + NE * 256;
constexpr float DN_ALPHA = 1.6817928305074290f;
constexpr float LN_EPS = 1e-5f, GN_EPS = 1e-6f, RMS_EPS = 1e-6f;
constexpr float SWIGLU_LIMIT = 7.0f, SWIGLU_ALPHA = 1.702f;
#ifndef ATT_FP8
#define ATT_FP8 1
#endif
constexpr float ATT_QS = 8.0f, ATT_VS = 2.0f, ATT_PS = 16.0f;
#ifndef G5_FP8
#define G5_FP8 1
#endif
constexpr float WROUT_SCALE = 128.0f, Z_SCALE = 4.0f;
#ifndef G1B_FP8
#define G1B_FP8 1
#endif
constexpr float WV_SCALE = 32.0f;
constexpr float WQA_SCALE = 32.0f, WKVA_SCALE = 32.0f, WO_SCALE = 64.0f, OB_SCALE = 16.0f;
constexpr float WGU_SCALE = 32.0f, WDN_SCALE = 64.0f, ACT_SCALE = 4.0f, YS_SCALE = 16.0f;

constexpr size_t al256(size_t x) { return (x + 255) & ~(size_t)255; }
constexpr size_t WS_CTL = 0, CTL_BYTES = 1u << 20;
constexpr size_t WS_WRT = WS_CTL + (512u << 10);
constexpr size_t WS_WRIN  = WS_CTL + CTL_BYTES;
constexpr size_t WS_WROUT = WS_WRIN  + (size_t)2 * 6144 * 1024 * 2;
constexpr size_t WS_WKVA  = WS_WROUT + (size_t)2 * 1024 * 2048 * 2;
constexpr size_t WS_WKVB  = WS_WKVA  + (size_t)512 * 1024 * 2;
constexpr size_t WS_WQA   = WS_WKVB  + (size_t)2048 * 256 * 2;
constexpr size_t WS_WQB   = WS_WQA   + (size_t)2 * 256 * 1024 * 2;
constexpr size_t WS_WO    = WS_WQB   + (size_t)2 * 1536 * 256 * 2;
constexpr size_t WS_WGU   = WS_WO    + (size_t)2 * 1024 * 1024 * 2;
constexpr size_t WS_WDN   = WS_WGU   + (size_t)4 * 32 * 2048 * 1024 * 2;
constexpr size_t WS_WPG   = WS_WDN   + (size_t)4 * 32 * 1024 * 1024 * 2;
constexpr size_t WS_WPP   = WS_WPG   + (size_t)4 * 1024 * 1024 * 2;
constexpr size_t WS_COSR  = WS_WPP   + (size_t)4 * 1024 * 256 * 2;
constexpr size_t WS_SINR  = WS_COSR  + (size_t)T * 128 * 4;
constexpr size_t WS_COSRT = WS_SINR  + (size_t)T * 128 * 4;
constexpr size_t WS_SINRT = WS_COSRT + (size_t)T * 128 * 4;
constexpr size_t WS_COSM  = WS_SINRT + (size_t)T * 128 * 4;
constexpr size_t WS_SINM  = WS_COSM  + (size_t)T * 32 * 4;
constexpr size_t WS_XBA   = WS_SINM  + (size_t)T * 32 * 4;
constexpr size_t WS_XBB   = WS_XBA   + (size_t)T * 1024 * 2;
constexpr size_t WS_H     = WS_XBB   + (size_t)T * 1024 * 2;
constexpr size_t WS_XF8   = WS_H     + (size_t)T * 1024 * 2;
constexpr size_t WS_MIX   = WS_H     + (size_t)T * 1024 * 4;
constexpr size_t WS_PB    = WS_MIX   + (size_t)T * 1024 * 4;
constexpr size_t WS_PP    = WS_PB    + (size_t)4 * T * 256 * 2;
constexpr size_t WS_MIXER = WS_PP    + (size_t)4 * T * 1024 * 2;
constexpr size_t WS_QB    = WS_MIXER;
constexpr size_t WS_KB    = WS_QB    + (size_t)T * 1024 * 2;
constexpr size_t WS_ACAT  = WS_KB    + (size_t)T * 1024 * 2;
constexpr size_t WS_KDT   = WS_ACAT  + (size_t)T * 2048 * 2;
constexpr size_t WS_VS    = WS_KDT   + (size_t)T * 1024 * 2;
constexpr size_t WS_GB    = WS_VS    + (size_t)16 * 32 * 512 * 512 * 2;
constexpr size_t WS_Y     = WS_GB    + (size_t)T * 2048 * 2;
constexpr size_t WS_Z     = WS_Y     + (size_t)T * 2048 * 2;
constexpr size_t WS_MIXER_END = WS_Z + (size_t)T * 2048 * 2;
constexpr size_t WS_CKV   = WS_MIXER;
constexpr size_t WS_SSQ   = WS_CKV   + (size_t)T * 256 * 2;
constexpr size_t WS_SSQ2  = WS_SSQ   + (size_t)T * 4 * 4;
constexpr size_t WS_KBUF  = WS_SSQ2  + (size_t)T * 4 * 4;
constexpr size_t WS_VBUF  = WS_KBUF  + (size_t)T * 1536 * 2;
constexpr size_t WS_QLAT  = WS_VBUF  + (size_t)T * 1024 * 2;
constexpr size_t WS_QBUF  = WS_QLAT  + (size_t)T * 256 * 2;
constexpr size_t WS_OB    = WS_QBUF  + (size_t)T * 1536 * 2;
static_assert(WS_OB + (size_t)T * 1024 * 2 <= WS_MIXER_END, "MLA overlay fits");
constexpr size_t WS_XG    = WS_MIXER_END;
constexpr size_t WS_ACT   = WS_XG    + (size_t)NSLOT * 1024 * 2;
constexpr size_t WS_YS    = WS_ACT   + (size_t)NSLOT * 1024 * 2;
constexpr size_t WS_EIDX  = WS_YS    + (size_t)NSLOT * 1024 * 2;
constexpr size_t WS_GATE  = WS_EIDX  + (size_t)T * 16;
constexpr size_t WS_POS   = WS_GATE  + (size_t)T * 16;
constexpr size_t WS_SLOT  = WS_POS   + (size_t)T * 16;
constexpr size_t WS_END   = WS_SLOT  + (size_t)T * 16;
constexpr size_t WS_WV8   = WS_END + ((size_t)200 << 20);
constexpr int CW_BAR = 4096;
constexpr int CW_CNT = 8192;

constexpr int RING_BYTES = 131072;
constexpr int MISC_OFF = 139264;
constexpr int GB_OFF = 147456;
constexpr int LDS_BYTES = 155648;
constexpr int MW_BAR = 0, MW_PSTART = 16, MW_CNT = 48, MW_GIDX = 1024, MW_NRB = 80, MW_RBEXP = 128, MW_LCNT = 320, MW_LBASE = 352, MW_TOK = 384;

__device__ __forceinline__ unsigned cvt_pk_bf16(float lo, float hi) { unsigned r; asm volatile("v_cvt_pk_bf16_f32 %0, %1, %2" : "=v"(r) : "v"(lo), "v"(hi)); return r; }
__device__ __forceinline__ u32x4 pack8(f32x4 a, f32x4 b) { u32x4 w; w.x = cvt_pk_bf16(a[0], a[1]); w.y = cvt_pk_bf16(a[2], a[3]); w.z = cvt_pk_bf16(b[0], b[1]); w.w = cvt_pk_bf16(b[2], b[3]); return w; }
__device__ __forceinline__ unsigned cvt4_fp8(float a, float b, float c, float d) { int w = 0; w = __builtin_amdgcn_cvt_pk_fp8_f32(a, b, w, false); w = __builtin_amdgcn_cvt_pk_fp8_f32(c, d, w, true); return (unsigned)w; }
__device__ __forceinline__ float bf2f(unsigned short b) { return __uint_as_float(((unsigned)b) << 16); }
__device__ __forceinline__ float bflo(unsigned w) { return __uint_as_float(w << 16); }
__device__ __forceinline__ float bfhi(unsigned w) { return __uint_as_float(w & 0xffff0000u); }
#define DPP_F(v, ctrl) __uint_as_float((unsigned)__builtin_amdgcn_update_dpp(0, (int)__float_as_uint(v), ctrl, 0xF, 0xF, false))
#define DPP_U(v, ctrl) ((unsigned)__builtin_amdgcn_update_dpp(0, (int)(v), ctrl, 0xF, 0xF, false))
__device__ __forceinline__ float wave_sum(float v) {
    v += DPP_F(v, 0xB1); v += DPP_F(v, 0x4E); v += DPP_F(v, 0x141); v += DPP_F(v, 0x140);
    const float r0 = __uint_as_float(__builtin_amdgcn_readlane(__float_as_uint(v), 0)), r1 = __uint_as_float(__builtin_amdgcn_readlane(__float_as_uint(v), 16));
    const float r2 = __uint_as_float(__builtin_amdgcn_readlane(__float_as_uint(v), 32)), r3 = __uint_as_float(__builtin_amdgcn_readlane(__float_as_uint(v), 48));
    return (r0 + r1) + (r2 + r3);
}
__device__ __forceinline__ unsigned wave_umax(unsigned v) {
    v = max(v, DPP_U(v, 0xB1)); v = max(v, DPP_U(v, 0x4E)); v = max(v, DPP_U(v, 0x141)); v = max(v, DPP_U(v, 0x140));
    const unsigned r0 = __builtin_amdgcn_readlane(v, 0), r1 = __builtin_amdgcn_readlane(v, 16), r2 = __builtin_amdgcn_readlane(v, 32), r3 = __builtin_amdgcn_readlane(v, 48);
    return max(max(r0, r1), max(r2, r3));
}
__device__ __forceinline__ void xpose8(float (&x)[8], int lane) {
    const bool b4 = lane & 4, b2 = lane & 2, b1 = lane & 1;
#pragma unroll
    for (int j = 0; j < 4; ++j) { const float a = x[j], b = x[j + 4]; const float snd = b4 ? a : b; const float rcv = DPP_F(DPP_F(snd, 0x141), 0x1B); x[j] = b4 ? rcv : a; x[j + 4] = b4 ? b : rcv; }
#pragma unroll
    for (int j = 0; j < 8; ++j) if ((j & 2) == 0) { const float a = x[j], b = x[j + 2]; const float snd = b2 ? a : b; const float rcv = DPP_F(snd, 0x4E); x[j] = b2 ? rcv : a; x[j + 2] = b2 ? b : rcv; }
#pragma unroll
    for (int j = 0; j < 8; ++j) if ((j & 1) == 0) { const float a = x[j], b = x[j + 1]; const float snd = b1 ? a : b; const float rcv = DPP_F(snd, 0xB1); x[j] = b1 ? rcv : a; x[j + 1] = b1 ? b : rcv; }
}
__device__ __forceinline__ int lane_id() { int l; asm volatile("v_mbcnt_lo_u32_b32 %0, -1, 0\n\tv_mbcnt_hi_u32_b32 %0, -1, %0" : "=v"(l)); return l; }
__device__ __forceinline__ float sigmoidf_(float x) { return __builtin_amdgcn_rcpf(1.0f + __builtin_amdgcn_exp2f(x * -1.4426950408889634f)); }

#define XB_TMO      128
#define XB_XCNT(j)  (256  + 64 * (j))
#define XB_XSUB(j)  (1280 + 64 * (j))
#define XB_XGEN(j)  (2304 + 64 * (j))
#define XB_TOP      3328
#define XB_TOPGEN   3392
#define XCD_BAR_WORDS 3456
#define XB_SPIN_CAP (1u << 18)
__device__ __forceinline__ unsigned xb_ld(unsigned* p)              { return __hip_atomic_load(p, __ATOMIC_RELAXED, __HIP_MEMORY_SCOPE_AGENT); }
__device__ __forceinline__ unsigned xb_add(unsigned* p, unsigned v) { return __hip_atomic_fetch_add(p, v, __ATOMIC_RELAXED, __HIP_MEMORY_SCOPE_AGENT); }
__device__ __forceinline__ unsigned xb_xcc_id() { return (unsigned)__builtin_amdgcn_s_getreg((3 << 11) | 20) & 0xFu; }
#define XB_SPIN(cond, bar) do { unsigned _sp = 0; while (cond) { __builtin_amdgcn_s_sleep(1); \
    if ((++_sp & 255u) == 0u) { if (xb_ld(&(bar)[XB_TMO])) break; if (_sp > XB_SPIN_CAP) { atomicAdd(&(bar)[XB_TMO], 1u); break; } } } } while (0)
struct XcdBarrier { unsigned* bar; unsigned x; volatile LAS unsigned* st; int wave; };
__device__ __forceinline__ XcdBarrier xcd_barrier_post(unsigned* bar, volatile LAS unsigned* st) {
    XcdBarrier b; b.bar = bar; b.x = xb_xcc_id(); b.st = st; b.wave = __builtin_amdgcn_readfirstlane((int)(threadIdx.x >> 6));
    if (threadIdx.x == 0) (void)xb_add(&bar[XB_XCNT(b.x)], 1u);
    return b;
}
__device__ __forceinline__ void xcd_barrier_complete(unsigned* bar, unsigned x, unsigned& nloc, unsigned& nx) {
    const unsigned G = gridDim.x * gridDim.y * gridDim.z;
    unsigned sum, cnt, mine, sp = 0u;
    for (;;) {
        sum = 0u; cnt = 0u; mine = 0u;
#pragma unroll
        for (unsigned j = 0; j < 16; ++j) { const unsigned c = xb_ld(&bar[XB_XCNT(j)]); sum += c; cnt += (c > 0u) ? 1u : 0u; mine = (j == x) ? c : mine; }
        if (sum == G) break;
        __builtin_amdgcn_s_sleep(1);
        if ((++sp & 255u) == 0u) { if (xb_ld(&bar[XB_TMO])) break; if (sp > XB_SPIN_CAP) { atomicAdd(&bar[XB_TMO], 1u); break; } }
    }
    nloc = mine > 0u ? mine : 1u; nx = cnt > 0u ? cnt : 1u;
}
__device__ __forceinline__ void xcd_barrier(const XcdBarrier& b) {
    asm volatile("s_waitcnt vmcnt(0)" ::: "memory");
    __syncthreads();
    if (b.wave == 0 && lane_id() == 0) {
        unsigned* bar = b.bar; asm volatile("" : "+s"(bar));
        __builtin_amdgcn_s_waitcnt(0);
        unsigned nloc = b.st[0], nx = b.st[1];
        if (nloc == 0u) { xcd_barrier_complete(bar, b.x, nloc, nx); b.st[0] = nloc; b.st[1] = nx; }
        const unsigned old = xb_add(&bar[XB_XSUB(b.x)], 1u);
        const unsigned gen = old / nloc;
        if (old + 1u == (gen + 1u) * nloc) {
            __builtin_amdgcn_fence(__ATOMIC_RELEASE, "agent");
            asm volatile("s_waitcnt vmcnt(0)" ::: "memory");
            const unsigned og = xb_add(&bar[XB_TOP], 1u);
            const unsigned tg = og / nx;
            if (og + 1u == (tg + 1u) * nx) xb_add(&bar[XB_TOPGEN], 1u);
            else XB_SPIN(xb_ld(&bar[XB_TOPGEN]) == tg, bar);
            __builtin_amdgcn_fence(__ATOMIC_ACQUIRE, "agent");
            xb_add(&bar[XB_XGEN(b.x)], 1u);
            asm volatile("s_waitcnt vmcnt(0)" ::: "memory");
        } else {
            XB_SPIN(xb_ld(&bar[XB_XGEN(b.x)]) == gen, bar);
            __builtin_amdgcn_fence(__ATOMIC_ACQUIRE, "agent");
            asm volatile("s_waitcnt vmcnt(0)" ::: "memory");
        }
    }
    __syncthreads();
}

namespace pg8 {
constexpr int BM = 256, BK = 64, HALF = 128, HTB = HALF * BK * 2, STAGE_BYTES = 8 * HTB, NXCD = 8, WGM = 8;
__device__ __forceinline__ int lds_byte(int r, int c) { const int st = (r >> 4) * 2 + (c >> 5), rr = r & 15, cc = c & 31, ob = rr * 64 + cc * 2; return st * 1024 + (ob ^ (((ob >> 9) & 1) << 5)); }
__device__ __forceinline__ void stage_rc(int b, int& R, int& C) { const int st = b / 1024, sb = b % 1024, swz = sb ^ (((sb >> 9) & 1) << 5); R = (st >> 1) * 16 + swz / 64; C = (st & 1) * 32 + (swz % 64) / 2; }
__device__ __forceinline__ int perm32(int rho) { const int n = rho >> 4, i = rho & 15; return 8 * (i >> 2) + 4 * n + (i & 3); }

struct Unit { const char* A; const char* B; int pm, pn, e, nv; };
typedef int v8i32 __attribute__((ext_vector_type(8)));
typedef int v4i32 __attribute__((ext_vector_type(4)));
__device__ __forceinline__ void mfma_fp8(f32x4& acc, v8i32 b, v8i32 a, int sc) {
    asm volatile("s_nop 1\n\tv_mfma_scale_f32_16x16x128_f8f6f4 %0, %1, %2, %0, %3, %3 op_sel_hi:[0,0,0]" : "+v"(acc) : "v"(b), "v"(a), "v"(sc)); }
__device__ __forceinline__ void mfma_fp8z(f32x4& acc, v8i32 b, v8i32 a, int sc) {
    asm volatile("s_nop 1\n\tv_mfma_scale_f32_16x16x128_f8f6f4 %0, %1, %2, 0, %3, %3 op_sel_hi:[0,0,0]" : "=&v"(acc) : "v"(b), "v"(a), "v"(sc)); }
__device__ __forceinline__ void mfma_bf16(f32x4& acc, bf16x8 b, bf16x8 a) { asm volatile("v_mfma_f32_16x16x32_bf16 %0, %1, %2, %0" : "+v"(acc) : "v"(b), "v"(a)); }
__device__ __forceinline__ void mfma_bf16z(f32x4& acc, bf16x8 b, bf16x8 a) { asm volatile("v_mfma_f32_16x16x32_bf16 %0, %1, %2, 0" : "=&v"(acc) : "v"(b), "v"(a)); }
__device__ __forceinline__ v8i32 cat8(bf16x8 a, bf16x8 b) { return __builtin_shufflevector(__builtin_bit_cast(v4i32, a), __builtin_bit_cast(v4i32, b), 0, 1, 2, 3, 4, 5, 6, 7); }

template <class E, class = void> struct epi_nvm { static constexpr int value = 0; };
template <class E> struct epi_nvm<E, decltype((void)E::NVM)> { static constexpr int value = E::NVM; };
template <bool FP8 = false, bool SP2 = true, bool GATHER = false, class Epi, class Sched>
__device__ __forceinline__ void gemm_phase(LAS unsigned char* lds, int tid, const int lda, const int ldb, const int K, const Sched& S, const Epi& E) {
    asm volatile("" : "+v"(tid));
    const int wid = __builtin_amdgcn_readfirstlane(tid >> 6), lane = tid & 63, wr = wid >> 2, wc = wid & 3, fr = lane & 15, fq = lane >> 4;
    int Kx = K; asm volatile("" : "+s"(Kx));
    const int nt = Kx / BK;
    unsigned voffA[2], voffB[2];
#pragma unroll
    for (int i = 0; i < 2; ++i) { int R, C; stage_rc(tid * 16 + i * 8192, R, C); const int Rb = (R & ~31) + perm32(R & 31);
        voffA[i] = (unsigned)(R * lda + C) * 2u; voffB[i] = (unsigned)(Rb * ldb + C) * 2u; }
    unsigned vc[2][2], vn[2][2];
    LAS unsigned* gslot = (LAS unsigned*)(lds + MISC_OFF) + MW_GIDX + wid * 64;
#define PG8_GIDX_ISSUE(U, buf) do { int lq_ = lane; asm volatile("" : "+v"(lq_)); const int h_ = lq_ >> 5, i_ = (lq_ >> 4) & 1, r_ = lq_ & 15; int row_ = h_ * 128 + (wid >> 1) * 16 + 64 * i_ + r_; row_ = row_ < (U).nv ? row_ : (U).nv - 1; \
        __builtin_amdgcn_global_load_lds((const unsigned*)(U).A + row_, gslot + (buf) * 512, 4, 0, 0); } while (0)
#define PG8_GIDX_READ(buf, V) do { int tq_ = tid; asm volatile("" : "+v"(tq_));     \
        _Pragma("unroll") for (int i_ = 0; i_ < 2; ++i_) { int R_, C_; stage_rc(tq_ * 16 + i_ * 8192, R_, C_); \
        _Pragma("unroll") for (int h_ = 0; h_ < 2; ++h_) (V)[h_][i_] = gslot[(buf) * 512 + h_ * 32 + i_ * 16 + (R_ & 15)] * 1024u + (unsigned)(C_ * 2); } } while (0)
    const size_t kstep = (size_t)(BK * 2);
    const size_t hstepA = (size_t)HALF * lda * 2, hstepB = (size_t)HALF * ldb * 2;
    const unsigned ldsw = (unsigned)wid * 1024u;
    int aoffk[2], boffk[2];
#pragma unroll
    for (int k = 0; k < 2; ++k) { aoffk[k] = lds_byte(wr * 64 + fr, fq * 8) + k * 1024;
                                  boffk[k] = lds_byte(wc * 32 + fr, fq * 8) + k * 1024; }
#define PG8_SA(b, h) (((b) * 2 + (h)) * HTB)
#define PG8_SB(b, h) ((4 + (b) * 2 + (h)) * HTB)
#define PG8_STAGE(bufoff, gbase, voff) do { _Pragma("unroll") for (int _i = 0; _i < 2; ++_i) \
        __builtin_amdgcn_global_load_lds((const unsigned*)((const char*)(gbase) + (voff)[_i]), (LAS unsigned*)(lds + (bufoff) + ldsw + _i * 8192), 16, 0, 0); } while (0)
#define PG8_STAGE_A(bufoff, abase, half, NX) do { if constexpr (GATHER) { if (NX) PG8_STAGE(bufoff, abase, vn[half]); else PG8_STAGE(bufoff, abase, vc[half]); } \
        else PG8_STAGE(bufoff, (abase) + (half) * hstepA, voffA); } while (0)
#define PG8_LDA(dst, b, h) do { _Pragma("unroll") for (int m = 0; m < 4; ++m) _Pragma("unroll") for (int k = 0; k < 2; ++k) dst[m][k] = *(const LAS bf16x8*)(lds + PG8_SA(b, h) + aoffk[k] + m * 2048); } while (0)
#define PG8_LDB(dst, b, h) do { _Pragma("unroll") for (int n = 0; n < 2; ++n) _Pragma("unroll") for (int k = 0; k < 2; ++k) dst[n][k] = *(const LAS bf16x8*)(lds + PG8_SB(b, h) + boffk[k] + n * 2048); } while (0)
#define PG8_MMA(ai, bj, At, Bt) do { __builtin_amdgcn_s_setprio(1); \
        if constexpr (FP8) { _Pragma("unroll") for (int m = 0; m < 4; ++m) _Pragma("unroll") for (int n = 0; n < 2; ++n) mfma_fp8(acc[ai][bj][m][n], cat8(Bt[n][0], Bt[n][1]), cat8(At[m][0], At[m][1]), sc8); } \
        else { _Pragma("unroll") for (int k = 0; k < 2; ++k) _Pragma("unroll") for (int m = 0; m < 4; ++m) _Pragma("unroll") for (int n = 0; n < 2; ++n) mfma_bf16(acc[ai][bj][m][n], Bt[n][k], At[m][k]); } \
        __builtin_amdgcn_s_setprio(0); } while (0)
#define PG8_MMA0(ai, bj, At, Bt) do { if (first_) { __builtin_amdgcn_s_setprio(1); \
        if constexpr (FP8) { _Pragma("unroll") for (int m = 0; m < 4; ++m) _Pragma("unroll") for (int n = 0; n < 2; ++n) mfma_fp8z(acc[ai][bj][m][n], cat8(Bt[n][0], Bt[n][1]), cat8(At[m][0], At[m][1]), sc8); } \
        else { _Pragma("unroll") for (int m = 0; m < 4; ++m) _Pragma("unroll") for (int n = 0; n < 2; ++n) mfma_bf16z(acc[ai][bj][m][n], Bt[n][0], At[m][0]); \
               _Pragma("unroll") for (int m = 0; m < 4; ++m) _Pragma("unroll") for (int n = 0; n < 2; ++n) mfma_bf16(acc[ai][bj][m][n], Bt[n][1], At[m][1]); } \
        __builtin_amdgcn_s_setprio(0); } else PG8_MMA(ai, bj, At, Bt); } while (0)
#define PG8_ZERO_ACC() do { _Pragma("unroll") for (int a = 0; a < 2; ++a) _Pragma("unroll") for (int b = 0; b < 2; ++b) _Pragma("unroll") for (int m = 0; m < 4; ++m) \
        _Pragma("unroll") for (int n = 0; n < 2; ++n) acc[a][b][m][n] = (f32x4){0.f, 0.f, 0.f, 0.f}; } while (0)
#define PG8_WAIT_V(n) asm volatile("s_waitcnt vmcnt(" #n ")" ::: "memory")
#define PG8_WAIT_L(n) asm volatile("s_waitcnt lgkmcnt(" #n ")" ::: "memory")
#define PG8_BAR __builtin_amdgcn_s_barrier()
#define PG8_SCHED __builtin_amdgcn_sched_barrier(0)
    Unit cur, nxt; int ui = 0;
    if (!S.next(0, cur)) return;
    f32x4 acc[2][2][4][2];
    bf16x8 At[4][2], B0[2][2], B1[2][2];
    int sc8 = 0x7F7F7F7F; if constexpr (FP8) asm volatile("" : "+v"(sc8));
    const char* cA = cur.A; const char* cB = cur.B;
    if constexpr (GATHER) { cA = S.X; PG8_GIDX_ISSUE(cur, 0); asm volatile("s_waitcnt vmcnt(0)" ::: "memory"); PG8_GIDX_READ(0, vc);
#pragma unroll
        for (int h_ = 0; h_ < 2; ++h_) { vn[h_][0] = vc[h_][0]; vn[h_][1] = vc[h_][1]; } }
    if constexpr (SP2) {
        PG8_STAGE(PG8_SB(0, 0), cB, voffB); PG8_STAGE(PG8_SB(0, 1), cB + hstepB, voffB); PG8_STAGE_A(PG8_SA(0, 0), cA, 0, false); PG8_STAGE_A(PG8_SA(0, 1), cA, 1, false);
        if (wr == 1) PG8_BAR;
        PG8_WAIT_V(2); PG8_BAR;
        PG8_STAGE(PG8_SB(1, 0), cB + kstep, voffB); PG8_STAGE_A(PG8_SA(1, 0), cA + kstep, 0, false); PG8_STAGE(PG8_SB(1, 1), cB + hstepB + kstep, voffB);
        PG8_WAIT_V(6); PG8_BAR;
    } else {
    PG8_STAGE(PG8_SB(0, 0), cB, voffB); PG8_STAGE(PG8_SA(0, 0), cA, voffA); PG8_STAGE(PG8_SB(0, 1), cB + hstepB, voffB); PG8_STAGE(PG8_SA(0, 1), cA + hstepA, voffA);
    if (wr == 1) PG8_BAR;
    PG8_WAIT_V(4); PG8_BAR;
    PG8_STAGE(PG8_SB(1, 0), cB + kstep, voffB); PG8_STAGE(PG8_SA(1, 0), cA + kstep, voffA); PG8_STAGE(PG8_SB(1, 1), cB + hstepB + kstep, voffB);
    PG8_WAIT_V(6); PG8_BAR;
    }
    for (;;) {
        const bool has_next = S.next(ui + 1, nxt);
        const char* nA = GATHER ? cA : (has_next ? nxt.A : cA); const char* nB = has_next ? nxt.B : cB;
        if constexpr (GATHER) { if (has_next) PG8_GIDX_ISSUE(nxt, (ui + 1) & 1); }
        for (int t = 0; t < nt; t += 2) {
            const bool last = (t == nt - 2), first_ = (t == 0), relax_ = first_ && ui > 0;
#define PG8_WAIT_V8R() do { if constexpr (epi_nvm<Epi>::value > 0) { if (relax_) asm volatile("s_waitcnt vmcnt(%0)" :: "n"(8 + epi_nvm<Epi>::value) : "memory"); else PG8_WAIT_V(8); } else PG8_WAIT_V(8); } while (0)
            if constexpr (GATHER) { if (last && has_next) PG8_GIDX_READ((ui + 1) & 1, vn); }
            const char* a1 = cA + (size_t)(t + 1) * kstep;
            const char* a2 = last ? nA : cA + (size_t)(t + 2) * kstep; const char* b2 = last ? nB : cB + (size_t)(t + 2) * kstep;
            const char* a3 = a2 + kstep; const char* b3 = b2 + kstep;
            if constexpr (SP2) {
            PG8_LDB(B0, 0, 0); PG8_LDB(B1, 0, 1); PG8_SCHED; PG8_LDA(At, 0, 0); PG8_STAGE_A(PG8_SA(1, 1), a1, 1, false);
            PG8_WAIT_V8R(); PG8_WAIT_L(0); PG8_BAR; PG8_MMA0(0, 0, At, B0); PG8_MMA0(0, 1, At, B1); PG8_BAR; PG8_SCHED;
            PG8_LDA(At, 0, 1); PG8_STAGE(PG8_SB(0, 0), b2, voffB); PG8_STAGE(PG8_SB(0, 1), b2 + hstepB, voffB); PG8_STAGE_A(PG8_SA(0, 0), a2, 0, last);
            PG8_WAIT_V8R(); PG8_WAIT_L(0); PG8_BAR; PG8_MMA0(1, 0, At, B0); PG8_MMA0(1, 1, At, B1); PG8_BAR; PG8_SCHED;
            PG8_LDB(B0, 1, 0); PG8_LDB(B1, 1, 1); PG8_SCHED; PG8_LDA(At, 1, 0); PG8_STAGE_A(PG8_SA(0, 1), a2, 1, last);
            PG8_WAIT_V8R(); PG8_WAIT_L(0); PG8_BAR; PG8_MMA(0, 0, At, B0); PG8_MMA(0, 1, At, B1); PG8_BAR; PG8_SCHED;
            PG8_LDA(At, 1, 1); PG8_STAGE(PG8_SB(1, 0), b3, voffB); PG8_STAGE(PG8_SB(1, 1), b3 + hstepB, voffB); PG8_STAGE_A(PG8_SA(1, 0), a3, 0, last);
            PG8_WAIT_V(8); PG8_WAIT_L(0); PG8_BAR; PG8_MMA(1, 0, At, B0); PG8_MMA(1, 1, At, B1); PG8_BAR; PG8_SCHED;
            } else {
            PG8_LDB(B0, 0, 0); PG8_SCHED; PG8_LDA(At, 0, 0); PG8_STAGE(PG8_SA(1, 1), a1 + hstepA, voffA);
            PG8_WAIT_L(8); PG8_BAR; PG8_WAIT_L(0); PG8_MMA(0, 0, At, B0); PG8_BAR; PG8_SCHED;
            PG8_LDB(B1, 0, 1); PG8_STAGE(PG8_SB(0, 0), b2, voffB);
            PG8_BAR; PG8_WAIT_L(0); PG8_MMA(0, 1, At, B1); PG8_BAR;
            PG8_LDA(At, 0, 1); PG8_STAGE(PG8_SA(0, 0), a2, voffA);
            PG8_BAR; PG8_WAIT_L(0); PG8_MMA(1, 0, At, B0); PG8_BAR; PG8_SCHED;
            PG8_STAGE(PG8_SB(0, 1), b2 + hstepB, voffB);
            PG8_WAIT_V(6); PG8_BAR; PG8_MMA(1, 1, At, B1); PG8_BAR;
            PG8_LDB(B0, 1, 0); PG8_SCHED; PG8_LDA(At, 1, 0); PG8_STAGE(PG8_SA(0, 1), a2 + hstepA, voffA);
            PG8_WAIT_L(8); PG8_BAR; PG8_WAIT_L(0); PG8_MMA(0, 0, At, B0); PG8_BAR; PG8_SCHED;
            PG8_LDB(B1, 1, 1); PG8_STAGE(PG8_SB(1, 0), b3, voffB);
            PG8_BAR; PG8_WAIT_L(0); PG8_MMA(0, 1, At, B1); PG8_BAR;
            PG8_LDA(At, 1, 1); PG8_STAGE(PG8_SA(1, 0), a3, voffA);
            PG8_BAR; PG8_WAIT_L(0); PG8_MMA(1, 0, At, B0); PG8_BAR; PG8_SCHED;
            PG8_STAGE(PG8_SB(1, 1), b3 + hstepB, voffB);
            PG8_WAIT_V(6); PG8_BAR; PG8_MMA(1, 1, At, B1); PG8_BAR;
            }
        }
        asm volatile("s_nop 15\n\ts_nop 15" ::: "memory");
        E(acc, cur, wr, wc, fr, fq);
        if (!has_next) break;
        cur = nxt; cA = nA; cB = nB; ++ui;
        if constexpr (GATHER) {
#pragma unroll
            for (int h_ = 0; h_ < 2; ++h_) { vc[h_][0] = vn[h_][0]; vc[h_][1] = vn[h_][1]; } }
    }
    PG8_WAIT_V(0);
    if (wr == 0) PG8_BAR;
    PG8_BAR;
#undef PG8_SA
#undef PG8_SB
#undef PG8_STAGE
#undef PG8_LDA
#undef PG8_STAGE_A
#undef PG8_GIDX_ISSUE
#undef PG8_GIDX_READ
#undef PG8_LDB
#undef PG8_MMA
#undef PG8_WAIT_V
#undef PG8_WAIT_L
#undef PG8_BAR
#undef PG8_SCHED
}
}
using pg8::Unit;
typedef f32x4 Acc[2][2][4][2];

#define EPI_OPAQUE() int fr_ = fr, fq_ = fq; asm volatile("" : "+v"(fr_), "+v"(fq_))
#define EPI_BEGIN _Pragma("unroll") for (int ai = 0; ai < 2; ++ai) _Pragma("unroll") for (int m = 0; m < 4; ++m) { EPI_OPAQUE(); const int row = ai * 128 + wr * 64 + m * 16 + fr_; \
    _Pragma("unroll") for (int bj = 0; bj < 2; ++bj) { const int col = bj * 128 + wc * 32 + fq_ * 8; f32x4 v0 = acc[ai][bj][m][0], v1 = acc[ai][bj][m][1];
#define EPI_END } }

struct Params {
    const float* in[26];
    float* out;
    unsigned char* ws;
};
typedef const __attribute__((address_space(4))) Params* KPtr;

struct DenseSched {
    const char* A; const char* B; size_t tA, tB; int nM, nN, nwg, G, c;
    __device__ __forceinline__ void init(const void* A_, const void* B_, int M, int N, int lda, int ldb, int G_, int c_) {
        A = (const char*)A_; B = (const char*)B_; tA = (size_t)256 * lda * 2; tB = (size_t)256 * ldb * 2; nM = M / 256; nN = N / 256; nwg = nM * nN; G = G_; c = c_; }
    __device__ __forceinline__ bool next(int i, Unit& u) const {
        const long L = (long)i * G + c; if (L >= nwg) return false;
        int wgid = (int)L; { const int q = nwg / 8, r = nwg % 8, xcd = wgid % 8, off = wgid / 8; wgid = (xcd < r ? xcd * (q + 1) : r * (q + 1) + (xcd - r) * q) + off; }
        const int nig = 8 * nN, gid = wgid / nig, fm = gid * 8, gsz = (nM - fm) < 8 ? (nM - fm) : 8;
        u.pm = fm + ((wgid % nig) % gsz); u.pn = (wgid % nig) / gsz; u.e = 0;
        u.A = A + (size_t)u.pm * tA; u.B = B + (size_t)u.pn * tB; return true;
    }
};
struct SchedG2 {
    const char* Q; const char* K; int G, c;
    __device__ __forceinline__ bool next(int i, Unit& u) const {
        const int L = i * G + c; if (L >= 512) return false;
        const int bh = L >> 5, n = L & 31, b = bh >> 2, h = bh & 3, t0 = b * 8192 + n * 256;
        const size_t off = ((size_t)t0 * 1024 + h * 256) * 2;
        u.A = Q + ((size_t)t0 * 2048 + h * 512 + 256) * 2; u.B = K + off; u.pm = t0 >> 8; u.pn = h; u.e = L; return true;
    }
};
struct SchedG3 {
    const char* VS; const char* KDT; int G, c;
    __device__ __forceinline__ bool next(int i, Unit& u) const {
        const int L = i * G + c; if (L >= 1024) return false;
        const int cidx = L >> 1, half = L & 1;
        u.A = VS + (size_t)cidx * 524288 + (size_t)half * 262144; u.B = KDT + (size_t)cidx * 131072; u.pm = half; u.pn = 0; u.e = cidx; return true;
    }
};
struct SchedG4 {
    const char* ACAT; const char* VS; int G, c;
    __device__ __forceinline__ bool next(int i, Unit& u) const {
        const int L = i * G + c; if (L >= 1024) return false;
        const int cidx = L >> 1, half = L & 1, bh = cidx >> 5, n = cidx & 31, b = bh >> 2, h = bh & 3, t0 = b * 8192 + n * 256;
        u.A = ACAT + ((size_t)t0 * 2048 + h * 512) * 2; u.B = VS + (size_t)cidx * 524288 + (size_t)half * 262144; u.pm = t0 >> 8; u.pn = h * 2 + half; u.e = cidx; return true;
    }
};
struct MoeSched {
    const char* A; const char* W; size_t wstride; int NT, G, c; volatile LAS unsigned* misc; const char* X; const int* TOKL;
    __device__ __forceinline__ bool next(int i, Unit& u) const {
        const int L = i * G + c; const int nrb = __builtin_amdgcn_readfirstlane((int)misc[MW_NRB]); if (L >= nrb * NT) return false;
        const int rb = L / NT, pn = L - rb * NT; const int e = __builtin_amdgcn_readfirstlane((int)((volatile LAS unsigned char*)(misc + MW_RBEXP))[rb]);
        u.B = W + (size_t)e * wstride + (size_t)pn * (256 * 1024); u.pm = rb; u.pn = pn; u.e = e;
        if (TOKL) { const int j0 = rb * 256 - __builtin_amdgcn_readfirstlane((int)misc[MW_PSTART + e]); u.A = (const char*)(TOKL + (size_t)e * T + j0); u.nv = __builtin_amdgcn_readfirstlane((int)misc[MW_CNT + e]) - j0; }
        else { u.A = A + (size_t)rb * (256 * 1024); u.nv = 256; }
        return true;
    }
};

__device__ __forceinline__ float log2gamma(int h) { return __log2f(1.0f - __builtin_amdgcn_exp2f(-5.0f - (float)h)); }
__device__ __forceinline__ void rope8(f32x4& v0, f32x4& v1, const f32x4 c, const f32x4 s) {
    f32x4 a, b;
    a[0] = v0[0] * c[0] - v0[1] * s[0]; a[1] = v0[0] * s[0] + v0[1] * c[0];
    a[2] = v0[2] * c[1] - v0[3] * s[1]; a[3] = v0[2] * s[1] + v0[3] * c[1];
    b[0] = v1[0] * c[2] - v1[1] * s[2]; b[1] = v1[0] * s[2] + v1[1] * c[2];
    b[2] = v1[2] * c[3] - v1[3] * s[3]; b[3] = v1[2] * s[3] + v1[3] * c[3];
    v0 = a; v1 = b;
}
struct EpiRetA {
    static constexpr int NVM = 16;
    bf16_t* QB; bf16_t* ACAT; bf16_t* GB; bf16_t* KB; const float* COSR; const float* SINR; bf16_t* KDT;
    __device__ __forceinline__ void operator()(const Acc& acc, const Unit& u, int wr, int wc, int fr, int fq) const {
        const int pn = u.pn, t0 = u.pm * 256;
        if (pn < 4 || pn >= 12) {
            const int head = pn < 4 ? pn : pn - 12; const float l2g = log2gamma(head);
            EPI_OPAQUE();
            const int rbase = wr * 64 + fr_, cb = wc * 32 + fq_ * 8;
            f32x4 cc[2], ss[2], cn[2], sn[2];
#define ROPE_LD(it, C_, S_) do { const size_t o_ = (size_t)(t0 + rbase + ((it) >> 2) * 128 + ((it) & 3) * 16) * 128 + (cb >> 1); \
                C_[0] = *(const f32x4*)(COSR + o_); C_[1] = *(const f32x4*)(COSR + o_ + 64); S_[0] = *(const f32x4*)(SINR + o_); S_[1] = *(const f32x4*)(SINR + o_ + 64); } while (0)
            ROPE_LD(0, cc, ss);
#pragma unroll
            for (int it = 0; it < 8; ++it) { const int ai = it >> 2, m = it & 3, row = ai * 128 + m * 16 + rbase, t = t0 + row;
                if (it < 7) ROPE_LD(it + 1, cn, sn);
#pragma unroll
                for (int bj = 0; bj < 2; ++bj) { const int col = bj * 128 + cb; f32x4 v0 = acc[ai][bj][m][0], v1 = acc[ai][bj][m][1];
                    rope8(v0, v1, cc[bj], ss[bj]);
                    if (pn < 4) {
                        const float f = __builtin_amdgcn_exp2f(l2g * (float)(row + 1));
                        *(u32x4*)(ACAT + (size_t)t * 2048 + head * 512 + 256 + col) = pack8(v0 * f, v1 * f);
                    } else {
                        v0 = v0 * 0.0625f; v1 = v1 * 0.0625f;
                        *(u32x4*)(KB + (size_t)t * 1024 + head * 256 + col) = pack8(v0, v1);
                        const float fd = __builtin_amdgcn_exp2f(l2g * (float)(255 - row));
                        float xk[8] = {v0[0] * fd, v0[1] * fd, v0[2] * fd, v0[3] * fd, v1[0] * fd, v1[1] * fd, v1[2] * fd, v1[3] * fd};
                        xpose8(xk, fr_);
                        bf16_t* kd = KDT + ((size_t)(((t0 >> 13) * 4 + head) * 32 + ((t0 >> 8) & 31))) * 65536 + (size_t)(col + (fr_ & 7)) * 256 + (row & ~7);
                        u32x4 w; w.x = cvt_pk_bf16(xk[0], xk[1]); w.y = cvt_pk_bf16(xk[2], xk[3]); w.z = cvt_pk_bf16(xk[4], xk[5]); w.w = cvt_pk_bf16(xk[6], xk[7]);
                        *(u32x4*)kd = w;
                    } }
                cc[0] = cn[0]; cc[1] = cn[1]; ss[0] = sn[0]; ss[1] = sn[1]; }
#undef ROPE_LD
        } else {
            EPI_BEGIN
                const int t = t0 + row;
                *(u32x4*)(GB + (size_t)t * 2048 + (pn - 4) * 256 + col) = pack8(v0, v1);
            EPI_END
        }
    }
};
struct EpiRetB {
    static constexpr int NVM = 16;
    bf16_t* VS; float asc = 1.0f;
    __device__ __forceinline__ void operator()(const Acc& acc, const Unit& u, int wr, int wc, int fr, int fq) const {
        const int pm = u.pm, b = u.pn >> 5, n = u.pn & 31, hh = pm >> 1, dvb = (pm & 1) * 256;
        EPI_BEGIN
            *(u32x4*)(VS + ((size_t)((b * 4 + hh) * 32 + n)) * 262144 + (size_t)(dvb + row) * 512 + col) = pack8(v0 * asc, v1 * asc);
        EPI_END
    }
};
struct EpiRetP {
    static constexpr int NVM = 16;
    bf16_t* ACAT;
    __device__ __forceinline__ void operator()(const Acc& acc, const Unit& u, int wr, int wc, int fr, int fq) const {
        const int t0 = u.pm * 256, h = u.pn; const float l2g = -log2gamma(h);
        f32x4 cf[2][2];
        { int fq1 = fq; asm volatile("" : "+v"(fq1));
#pragma unroll
          for (int bj = 0; bj < 2; ++bj)
#pragma unroll
              for (int j = 0; j < 4; ++j) { const int c0 = bj * 128 + wc * 32 + fq1 * 8 + j; cf[bj][0][j] = __builtin_amdgcn_exp2f(l2g * (float)(c0 + 1)); cf[bj][1][j] = __builtin_amdgcn_exp2f(l2g * (float)(c0 + 5)); } }
        EPI_BEGIN
            v0 = v0 * cf[bj][0]; v1 = v1 * cf[bj][1];
#pragma unroll
            for (int j = 0; j < 4; ++j) { const int d0 = row - (col + j), d1 = row - (col + 4 + j); v0[j] = d0 >= 0 ? v0[j] : 0.f; v1[j] = d1 >= 0 ? v1[j] : 0.f; }
            *(u32x4*)(ACAT + (size_t)(t0 + row) * 2048 + h * 512 + col) = pack8(v0, v1);
        EPI_END
    }
};
struct EpiRetU {
    static constexpr int NVM = 16;
    bf16_t* VS;
    __device__ __forceinline__ void operator()(const Acc& acc, const Unit& u, int wr, int wc, int fr, int fq) const {
        bf16_t* base = VS + (size_t)u.e * 262144 + (size_t)(u.pm * 256) * 512 + 256;
        EPI_BEGIN
            *(u32x4*)(base + (size_t)row * 512 + col) = pack8(v0, v1);
        EPI_END
    }
};
struct EpiBf16 {
    static constexpr int NVM = 16;
    bf16_t* O; int ldc; float asc = 1.0f;
    __device__ __forceinline__ void operator()(const Acc& acc, const Unit& u, int wr, int wc, int fr, int fq) const {
        bf16_t* base = O + (size_t)(u.pm * 256) * ldc + u.pn * 256;
        EPI_BEGIN
            *(u32x4*)(base + (size_t)row * ldc + col) = pack8(v0 * asc, v1 * asc);
        EPI_END
    }
};
struct EpiF32 {
    float* O; int ldc;
    __device__ __forceinline__ void operator()(const Acc& acc, const Unit& u, int wr, int wc, int fr, int fq) const {
        float* base = O + (size_t)(u.pm * 256) * ldc + u.pn * 256;
        EPI_BEGIN
            *(f32x4*)(base + (size_t)row * ldc + col) = v0; *(f32x4*)(base + (size_t)row * ldc + col + 4) = v1;
        EPI_END
    }
};
struct EpiKVA {
    bf16_t* CKV; float* SSQ; bf16_t* KBUF; const float* COSM; const float* SINM; float asc;
    __device__ __forceinline__ void operator()(const Acc& acc, const Unit& u, int wr, int wc, int fr, int fq) const {
        const int t0 = u.pm * 256;
        if (u.pn == 0) {
#pragma unroll
            for (int ai = 0; ai < 2; ++ai)
#pragma unroll
                for (int m = 0; m < 4; ++m) { EPI_OPAQUE(); const int t = t0 + ai * 128 + wr * 64 + m * 16 + fr_; float ss = 0.f;
#pragma unroll
                    for (int bj = 0; bj < 2; ++bj) { const int col = bj * 128 + wc * 32 + fq_ * 8; const f32x4 v0 = acc[ai][bj][m][0] * asc, v1 = acc[ai][bj][m][1] * asc;
                        ss += (v0[0] * v0[0] + v0[1] * v0[1]) + (v0[2] * v0[2] + v0[3] * v0[3]) + (v1[0] * v1[0] + v1[1] * v1[1]) + (v1[2] * v1[2] + v1[3] * v1[3]);
                        *(u32x4*)(CKV + (size_t)t * 256 + col) = pack8(v0, v1); }
                    ss += __shfl_xor(ss, 16); ss += __shfl_xor(ss, 32);
                    if (fq_ == 0) SSQ[(size_t)t * 4 + wc] = ss; }
        } else {
            if (wc < 2) {
#pragma unroll
                for (int ai = 0; ai < 2; ++ai)
#pragma unroll
                    for (int m = 0; m < 4; ++m) { EPI_OPAQUE(); const int t = t0 + ai * 128 + wr * 64 + m * 16 + fr_; const int col = wc * 32 + fq_ * 8;
                        f32x4 v0 = acc[ai][0][m][0] * asc, v1 = acc[ai][0][m][1] * asc;
                        const f32x4 c4 = *(const f32x4*)(COSM + (size_t)t * 32 + (col >> 1)), s4 = *(const f32x4*)(SINM + (size_t)t * 32 + (col >> 1));
                        rope8(v0, v1, c4, s4);
#if ATT_FP8
                        u32x2 w8; w8.x = cvt4_fp8(v0[0], v0[1], v0[2], v0[3]); w8.y = cvt4_fp8(v1[0], v1[1], v1[2], v1[3]);
#pragma unroll
                        for (int h = 0; h < 8; ++h) *(u32x2*)((unsigned char*)KBUF + (size_t)t * 1536 + h * 192 + 128 + col) = w8; }
#else
                        const u32x4 w = pack8(v0, v1);
#pragma unroll
                        for (int h = 0; h < 8; ++h) *(u32x4*)(KBUF + (size_t)t * 1536 + h * 192 + 128 + col) = w; }
#endif
            }
        }
    }
};
struct EpiKVB {
    bf16_t* KBUF; bf16_t* VBUF; const float* SSQ;
    __device__ __forceinline__ void operator()(const Acc& acc, const Unit& u, int wr, int wc, int fr, int fq) const {
        const int t0 = u.pm * 256, head = u.pn;
        EPI_OPAQUE(); const int rbase = t0 + wr * 64 + fr_, c = wc * 32 + fq_ * 8;
        f32x4 sq[8];
#pragma unroll
        for (int it = 0; it < 8; ++it) sq[it] = *(const f32x4*)(SSQ + (size_t)(rbase + (it >> 2) * 128 + (it & 3) * 16) * 4);
#pragma unroll
        for (int it = 0; it < 8; ++it) { const int ai = it >> 2, m = it & 3, t = rbase + ai * 128 + m * 16;
            const float rstd = rsqrtf(((sq[it][0] + sq[it][1]) + (sq[it][2] + sq[it][3])) * (1.0f / 256.0f) + RMS_EPS);
#if ATT_FP8
            { const f32x4 k0 = acc[ai][0][m][0] * rstd, k1 = acc[ai][0][m][1] * rstd; u32x2 w8; w8.x = cvt4_fp8(k0[0], k0[1], k0[2], k0[3]); w8.y = cvt4_fp8(k1[0], k1[1], k1[2], k1[3]);
              *(u32x2*)((unsigned char*)KBUF + (size_t)t * 1536 + head * 192 + c) = w8;
              const int sq_ = t & 8191, kk = sq_ & 63, k5 = kk & 31, pos = (((k5 >> 2) & 1) << 5) + (k5 & 3) + 4 * (k5 >> 3) + 16 * (kk >> 5);
              unsigned char* vp = (unsigned char*)VBUF + ((size_t)(((t >> 13) * 8 + head) * 128 + (sq_ >> 6)) * 128 + c) * 64 + pos;
              const float vs_ = rstd * ATT_VS; const f32x4 v0 = acc[ai][1][m][0] * vs_, v1 = acc[ai][1][m][1] * vs_;
              const unsigned wa = cvt4_fp8(v0[0], v0[1], v0[2], v0[3]), wb = cvt4_fp8(v1[0], v1[1], v1[2], v1[3]);
              vp[0 * 64] = (unsigned char)(wa); vp[1 * 64] = (unsigned char)(wa >> 8); vp[2 * 64] = (unsigned char)(wa >> 16); vp[3 * 64] = (unsigned char)(wa >> 24);
              vp[4 * 64] = (unsigned char)(wb); vp[5 * 64] = (unsigned char)(wb >> 8); vp[6 * 64] = (unsigned char)(wb >> 16); vp[7 * 64] = (unsigned char)(wb >> 24); } }
#else
            *(u32x4*)(KBUF + (size_t)t * 1536 + head * 192 + c) = pack8(acc[ai][0][m][0] * rstd, acc[ai][0][m][1] * rstd);
            *(u32x4*)(VBUF + (size_t)t * 1024 + head * 128 + c) = pack8(acc[ai][1][m][0] * rstd, acc[ai][1][m][1] * rstd); }
#endif
    }
};
struct EpiQA {
    bf16_t* QLAT; float* SSQ2; float asc;
    __device__ __forceinline__ void operator()(const Acc& acc, const Unit& u, int wr, int wc, int fr, int fq) const {
        const int t0 = u.pm * 256;
#pragma unroll
        for (int ai = 0; ai < 2; ++ai)
#pragma unroll
            for (int m = 0; m < 4; ++m) { EPI_OPAQUE(); const int t = t0 + ai * 128 + wr * 64 + m * 16 + fr_; float ss = 0.f;
#pragma unroll
                for (int bj = 0; bj < 2; ++bj) { const int col = bj * 128 + wc * 32 + fq_ * 8; const f32x4 v0 = acc[ai][bj][m][0] * asc, v1 = acc[ai][bj][m][1] * asc;
                    ss += (v0[0] * v0[0] + v0[1] * v0[1]) + (v0[2] * v0[2] + v0[3] * v0[3]) + (v1[0] * v1[0] + v1[1] * v1[1]) + (v1[2] * v1[2] + v1[3] * v1[3]);
                    *(u32x4*)(QLAT + (size_t)t * 256 + col) = pack8(v0, v1); }
                ss += __shfl_xor(ss, 16); ss += __shfl_xor(ss, 32);
                if (fq_ == 0) SSQ2[(size_t)t * 4 + wc] = ss; }
    }
};
struct EpiQB {
    bf16_t* QBUF; const float* SSQ2; const float* COSM; const float* SINM;
    __device__ __forceinline__ void operator()(const Acc& acc, const Unit& u, int wr, int wc, int fr, int fq) const {
        const int t0 = u.pm * 256, pn = u.pn;
        EPI_OPAQUE(); const int rbase = t0 + wr * 64 + fr_, cb = wc * 32 + fq_ * 8;
        float scv[8];
        { f32x4 sq[8];
#pragma unroll
          for (int it = 0; it < 8; ++it) sq[it] = *(const f32x4*)(SSQ2 + (size_t)(rbase + (it >> 2) * 128 + (it & 3) * 16) * 4);
#pragma unroll
          for (int it = 0; it < 8; ++it) scv[it] = rsqrtf(((sq[it][0] + sq[it][1]) + (sq[it][2] + sq[it][3])) * (1.0f / 256.0f) + RMS_EPS) * 0.10411767f; }
        if (pn < 4) {
#pragma unroll
            for (int it = 0; it < 8; ++it) { const int ai = it >> 2, m = it & 3, t = rbase + ai * 128 + m * 16;
                const float sc = scv[it];
#pragma unroll
#if ATT_FP8
                for (int bj = 0; bj < 2; ++bj) { const f32x4 a0 = acc[ai][bj][m][0] * (sc * ATT_QS), a1 = acc[ai][bj][m][1] * (sc * ATT_QS); u32x2 w8; w8.x = cvt4_fp8(a0[0], a0[1], a0[2], a0[3]); w8.y = cvt4_fp8(a1[0], a1[1], a1[2], a1[3]);
                    *(u32x2*)((unsigned char*)QBUF + (size_t)t * 1536 + (2 * pn + bj) * 192 + cb) = w8; } }
#else
                for (int bj = 0; bj < 2; ++bj) *(u32x4*)(QBUF + (size_t)t * 1536 + (2 * pn + bj) * 192 + cb) = pack8(acc[ai][bj][m][0] * sc, acc[ai][bj][m][1] * sc); }
#endif
        } else {
            f32x4 cc[2], ss[2], cn[2], sn[2];
#define QROPE_LD(it, C_, S_) do { const size_t o_ = (size_t)(rbase + ((it) >> 2) * 128 + ((it) & 3) * 16) * 32 + ((cb & 63) >> 1); \
                C_[0] = *(const f32x4*)(COSM + o_); S_[0] = *(const f32x4*)(SINM + o_); C_[1] = C_[0]; S_[1] = S_[0]; } while (0)
            QROPE_LD(0, cc, ss);
#pragma unroll
            for (int it = 0; it < 8; ++it) { const int ai = it >> 2, m = it & 3, t = rbase + ai * 128 + m * 16;
                if (it < 7) QROPE_LD(it + 1, cn, sn);
                const float sc = scv[it];
#pragma unroll
                for (int bj = 0; bj < 2; ++bj) { const int col = bj * 128 + cb, head = 4 * (pn - 4) + (col >> 6), rr = col & 63;
                    f32x4 v0 = acc[ai][bj][m][0] * sc, v1 = acc[ai][bj][m][1] * sc;
                    rope8(v0, v1, cc[bj], ss[bj]);
#if ATT_FP8
                    { u32x2 w8; w8.x = cvt4_fp8(v0[0] * ATT_QS, v0[1] * ATT_QS, v0[2] * ATT_QS, v0[3] * ATT_QS); w8.y = cvt4_fp8(v1[0] * ATT_QS, v1[1] * ATT_QS, v1[2] * ATT_QS, v1[3] * ATT_QS);
                      *(u32x2*)((unsigned char*)QBUF + (size_t)t * 1536 + head * 192 + 128 + rr) = w8; } }
#else
                    *(u32x4*)(QBUF + (size_t)t * 1536 + head * 192 + 128 + rr) = pack8(v0, v1); }
#endif
                cc[0] = cn[0]; cc[1] = cn[1]; ss[0] = sn[0]; ss[1] = sn[1]; }
#undef QROPE_LD
        }
    }
};
__device__ __forceinline__ void st_pair8(unsigned char* p, size_t rs, int fq, u32x2 a, u32x2 b) {
    const auto x = __builtin_amdgcn_permlane16_swap(a.x, b.x, false, false), y = __builtin_amdgcn_permlane16_swap(a.y, b.y, false, false);
    const u32x4 o = {x[0], y[0], x[1], y[1]};
    unsigned char* q = (fq & 1) ? p + rs - 8 : p;
    *(u32x4*)q = o;
}
__device__ __forceinline__ f32x2 swiglu2(f32x2 ag, f32x2 au, f32x2 bg, f32x2 bu) {
    constexpr float ws_ = 1.0f / WGU_SCALE, ka = -SWIGLU_ALPHA * 1.4426950408889634f;
    f32x2 g = __builtin_elementwise_fma(ag, (f32x2){ws_, ws_}, bg), u = __builtin_elementwise_fma(au, (f32x2){ws_, ws_}, bu);
    g[0] = __builtin_amdgcn_fmed3f(g[0], -24.0f, SWIGLU_LIMIT); g[1] = __builtin_amdgcn_fmed3f(g[1], -24.0f, SWIGLU_LIMIT);
    u[0] = __builtin_amdgcn_fmed3f(u[0], -SWIGLU_LIMIT, SWIGLU_LIMIT); u[1] = __builtin_amdgcn_fmed3f(u[1], -SWIGLU_LIMIT, SWIGLU_LIMIT);
    const f32x2 t = g * (f32x2){ka, ka};
    f32x2 e = {__builtin_amdgcn_exp2f(t[0]), __builtin_amdgcn_exp2f(t[1])}; e = e + (f32x2){1.0f, 1.0f};
    const float rp = __builtin_amdgcn_rcpf(e[0] * e[1]);
    const f32x2 sg = (f32x2){e[1], e[0]} * (f32x2){rp, rp};
    const f32x2 w = __builtin_elementwise_fma(u, (f32x2){ACT_SCALE, ACT_SCALE}, (f32x2){ACT_SCALE, ACT_SCALE});
    return (g * sg) * w;
}
struct EpiGU {
    static constexpr int NVM = 8;
    unsigned char* ACT; const float* bias;
    __device__ __forceinline__ void operator()(const Acc& acc, const Unit& u, int wr, int wc, int fr, int fq) const {
        int fq0 = fq; asm volatile("" : "+v"(fq0));
        const int c = u.pn * 128 + wc * 32 + fq0 * 8; const float* bg = bias + (size_t)u.e * 2048 + c;
        const f32x4 bg0 = *(const f32x4*)bg, bg1 = *(const f32x4*)(bg + 4), bu0 = *(const f32x4*)(bg + 1024), bu1 = *(const f32x4*)(bg + 1028);
#define LO2(v) __builtin_shufflevector(v, v, 0, 1)
#define HI2(v) __builtin_shufflevector(v, v, 2, 3)
#pragma unroll
        for (int ai = 0; ai < 2; ++ai)
#pragma unroll
            for (int mp = 0; mp < 2; ++mp) { EPI_OPAQUE(); const int slot = u.pm * 256 + ai * 128 + wr * 64 + mp * 32 + fr_; u32x2 w[2];
#pragma unroll
                for (int mm = 0; mm < 2; ++mm) { const int m = 2 * mp + mm;
                    const f32x4 ag0 = acc[ai][0][m][0], ag1 = acc[ai][0][m][1], au0 = acc[ai][1][m][0], au1 = acc[ai][1][m][1];
                    const f32x2 r0 = swiglu2(LO2(ag0), LO2(au0), LO2(bg0), LO2(bu0)), r1 = swiglu2(HI2(ag0), HI2(au0), HI2(bg0), HI2(bu0));
                    const f32x2 r2 = swiglu2(LO2(ag1), LO2(au1), LO2(bg1), LO2(bu1)), r3 = swiglu2(HI2(ag1), HI2(au1), HI2(bg1), HI2(bu1));
                    w[mm].x = cvt4_fp8(r0[0], r0[1], r1[0], r1[1]); w[mm].y = cvt4_fp8(r2[0], r2[1], r3[0], r3[1]); }
                st_pair8(ACT + (size_t)slot * 1024 + u.pn * 128 + wc * 32 + fq_ * 8, (size_t)16 * 1024, fq_, w[0], w[1]); }
#undef LO2
#undef HI2
    }
};
struct EpiDN {
    static constexpr int NVM = 12;
    unsigned char* YS; const float* bias;
    __device__ __forceinline__ void operator()(const Acc& acc, const Unit& u, int wr, int wc, int fr, int fq) const {
        int fq0 = fq; asm volatile("" : "+v"(fq0));
        const float* be = bias + (size_t)u.e * 1024 + u.pn * 256 + wc * 32 + fq0 * 8;
        f32x4 bb[2][2];
#pragma unroll
        for (int bj = 0; bj < 2; ++bj) { bb[bj][0] = *(const f32x4*)(be + bj * 128) * YS_SCALE; bb[bj][1] = *(const f32x4*)(be + bj * 128 + 4) * YS_SCALE; }
        constexpr float ws_ = YS_SCALE / (WDN_SCALE * ACT_SCALE);
#pragma unroll
        for (int ai = 0; ai < 2; ++ai)
#pragma unroll
            for (int mp = 0; mp < 2; ++mp) { EPI_OPAQUE(); const int row = ai * 128 + wr * 64 + mp * 32 + fr_;
#pragma unroll
                for (int bj = 0; bj < 2; ++bj) { u32x2 w[2];
#pragma unroll
                    for (int mm = 0; mm < 2; ++mm) { const int m = 2 * mp + mm; const f32x4 r0 = acc[ai][bj][m][0] * ws_ + bb[bj][0], r1 = acc[ai][bj][m][1] * ws_ + bb[bj][1];
                        w[mm].x = cvt4_fp8(r0[0], r0[1], r0[2], r0[3]); w[mm].y = cvt4_fp8(r1[0], r1[1], r1[2], r1[3]); }
                    st_pair8(YS + (size_t)(u.pm * 256 + row) * 1024 + u.pn * 256 + bj * 128 + wc * 32 + fq_ * 8, (size_t)16 * 1024, fq_, w[0], w[1]); } }
    }
};
struct EpiPLE {
    static constexpr int NVM = 48;
    const bf16_t* HB; float* OUT; bf16_t* XB; const bf16_t* PP; unsigned char* XF;
    __device__ __forceinline__ void operator()(const Acc& acc, const Unit& u, int wr, int wc, int fr, int fq) const {
        EPI_OPAQUE();
        const size_t base = (size_t)(u.pm * 256 + wr * 64 + fr_) * 1024 + u.pn * 256 + wc * 32 + fq_ * 8;
        u32x4 hw[2], pw[2], hn[2], pn_[2];
#define PLE_LD(it, H_, P_) do { const size_t o_ = base + (size_t)(((it) >> 2) * 128 + ((it) & 3) * 16) * 1024; \
            H_[0] = *(const u32x4*)(HB + o_); H_[1] = *(const u32x4*)(HB + o_ + 128); P_[0] = *(const u32x4*)(PP + o_); P_[1] = *(const u32x4*)(PP + o_ + 128); } while (0)
        PLE_LD(0, hw, pw);
#pragma unroll
        for (int it = 0; it < 8; ++it) { const int ai = it >> 2, m = it & 3;
            if (it < 7) PLE_LD(it + 1, hn, pn_);
            const size_t o0 = base + (size_t)(ai * 128 + m * 16) * 1024;
#pragma unroll
            for (int bj = 0; bj < 2; ++bj) { const f32x4 v0 = acc[ai][bj][m][0], v1 = acc[ai][bj][m][1]; const u32x4 h_ = hw[bj], p_ = pw[bj]; const size_t o = o0 + bj * 128;
                auto ple2 = [](f32x2 a, unsigned hw_, unsigned pw_) -> f32x2 {
                    const f32x2 t = a * (f32x2){-1.4426950408889634f, -1.4426950408889634f};
                    f32x2 e = {__builtin_amdgcn_exp2f(t[0]), __builtin_amdgcn_exp2f(t[1])}; e = e + (f32x2){1.0f, 1.0f};
                    const f32x2 sg = {__builtin_amdgcn_rcpf(e[0]), __builtin_amdgcn_rcpf(e[1])};
                    return __builtin_elementwise_fma(sg, (f32x2){bflo(pw_), bfhi(pw_)}, (f32x2){bflo(hw_), bfhi(hw_)}); };
                const f32x2 q0 = ple2(__builtin_shufflevector(v0, v0, 0, 1), h_.x, p_.x), q1 = ple2(__builtin_shufflevector(v0, v0, 2, 3), h_.y, p_.y);
                const f32x2 q2 = ple2(__builtin_shufflevector(v1, v1, 0, 1), h_.z, p_.z), q3 = ple2(__builtin_shufflevector(v1, v1, 2, 3), h_.w, p_.w);
                const f32x4 r0 = {q0[0], q0[1], q1[0], q1[1]}, r1 = {q2[0], q2[1], q3[0], q3[1]};
                if (OUT) { *(f32x4*)(OUT + o) = r0; *(f32x4*)(OUT + o + 4) = r1; }
                *(u32x4*)(XB + o) = pack8(r0, r1);
                { u32x2 w8; w8.x = cvt4_fp8(r0[0], r0[1], r0[2], r0[3]); w8.y = cvt4_fp8(r1[0], r1[1], r1[2], r1[3]); *(u32x2*)(XF + o) = w8; } }
            hw[0] = hn[0]; hw[1] = hn[1]; pw[0] = pn_[0]; pw[1] = pn_[1]; }
#undef PLE_LD
    }
};
__device__ __forceinline__ int ropeperm(int d, int half) { return d < half ? 2 * d : 2 * (d - half) + 1; }
__device__ __forceinline__ int rowmap_rt(int map, int n) {
    if (map == 1) {
        if (n < 1024) return (n & ~255) + ropeperm(n & 255, 128);
        if (n < 2048) return 3072 + ((n - 1024) & ~255) + ropeperm(n & 255, 128);
        if (n < 4096) return 4096 + (n - 2048);
        return 1024 + (n - 4096);
    } else if (map == 2) {
        return n < 256 ? n : 256 + ropeperm(n - 256, 32);
    } else if (map == 3) {
        const int hh = n / 192, d = n - hh * 192;
        return d < 128 ? hh * 128 + d : 1024 + hh * 64 + ropeperm(d - 128, 32);
    } else if (map == 4) {
        return n < 1024 ? ((n >> 7) * 256 + (n & 127)) : (((n - 1024) >> 7) * 256 + 128 + ((n - 1024) & 127));
    }
    return n;
}
struct TJob { const float* src; size_t sstride; int nmat, K, N; unsigned char* dst; size_t dstride; int map; const float* kscale; int ksstride; int fp8; float wscale; int sp; };
constexpr int NTJOBS = 11 + G1B_FP8;
__device__ __forceinline__ TJob get_tjob(int j, KPtr p, unsigned char* ws) {
    TJob t; t.kscale = nullptr; t.ksstride = 0; t.fp8 = 0; t.wscale = 1.0f; t.map = 0; t.sp = 0;
    switch (j) {
    case 0:  t.src = p->in[20]; t.sstride = (size_t)1024 * 2048; t.nmat = 128; t.K = 1024; t.N = 2048; t.dst = ws + WS_WGU; t.dstride = (size_t)2048 * 1024; t.map = 4; t.fp8 = 1; t.wscale = WGU_SCALE; break;
    case 1:  t.src = p->in[22]; t.sstride = (size_t)1024 * 1024; t.nmat = 128; t.K = 1024; t.N = 1024; t.dst = ws + WS_WDN; t.dstride = (size_t)1024 * 1024; t.fp8 = 1; t.wscale = WDN_SCALE; break;
    case 2:  t.src = p->in[3];  t.sstride = (size_t)1024 * 6144; t.nmat = 2;   t.K = 1024; t.N = 6144; t.dst = ws + WS_WRIN; t.dstride = (size_t)6144 * 1024 * 2; t.map = 1; break;
    case 3:  t.src = p->in[6];  t.sstride = (size_t)2048 * 1024; t.nmat = 2;   t.K = 2048; t.N = 1024; t.dst = ws + WS_WROUT; t.dstride = (size_t)1024 * 2048 * (G5_FP8 ? 1 : 2); t.fp8 = G5_FP8; t.wscale = G5_FP8 ? WROUT_SCALE : 1.0f; break;
    case 4:  t.src = p->in[10]; t.sstride = (size_t)1024 * 256;  t.nmat = 2;   t.K = 1024; t.N = 256;  t.dst = ws + WS_WQA; t.dstride = (size_t)256 * 1024; t.fp8 = ATT_FP8; t.wscale = ATT_FP8 ? WQA_SCALE : 1.0f; if (!ATT_FP8) t.dstride *= 2; break;
    case 5:  t.src = p->in[12]; t.sstride = (size_t)256 * 1536;  t.nmat = 2;   t.K = 256;  t.N = 1536; t.dst = ws + WS_WQB; t.dstride = (size_t)1536 * 256 * 2; t.map = 3; t.kscale = p->in[11]; t.ksstride = 256; break;
    case 6:  t.src = p->in[13]; t.sstride = (size_t)1024 * 1024; t.nmat = 2;   t.K = 1024; t.N = 1024; t.dst = ws + WS_WO; t.dstride = (size_t)1024 * 1024; t.fp8 = ATT_FP8; t.wscale = ATT_FP8 ? WO_SCALE : 1.0f; if (!ATT_FP8) t.dstride *= 2; break;
    case 7:  t.src = p->in[7];  t.sstride = 0;                   t.nmat = 1;   t.K = 1024; t.N = 320;  t.dst = ws + WS_WKVA; t.dstride = 0; t.map = 2; t.fp8 = ATT_FP8; t.wscale = ATT_FP8 ? WKVA_SCALE : 1.0f; break;
    case 8:  t.src = p->in[9];  t.sstride = 0;                   t.nmat = 1;   t.K = 256;  t.N = 2048; t.dst = ws + WS_WKVB; t.dstride = 0; t.kscale = p->in[8]; break;
    case 9:  t.src = p->in[24]; t.sstride = (size_t)1024 * 1024; t.nmat = 4;   t.K = 1024; t.N = 1024; t.dst = ws + WS_WPG; t.dstride = (size_t)1024 * 1024 * 2; break;
    case 10: t.src = p->in[25]; t.sstride = (size_t)256 * 1024;  t.nmat = 4;   t.K = 256;  t.N = 1024; t.dst = ws + WS_WPP; t.dstride = (size_t)1024 * 256 * 2; break;
    default: t.src = p->in[3] + 2048; t.sstride = (size_t)1024 * 6144; t.nmat = 2; t.K = 1024; t.N = 2048; t.sp = 6144; t.dst = ws + WS_WV8; t.dstride = (size_t)2048 * 1024; t.fp8 = 1; t.wscale = WV_SCALE; break;
    }
    if (t.sp == 0) t.sp = t.N;
    return t;
}
struct TTile { const float* src; unsigned char* dst; const float* kscale; int K, N, k0, n0, map, fp8; float wscale; bool valid; int SP; };
__device__ __forceinline__ TTile get_ttile(int t, KPtr p, unsigned char* ws, int jlo, int jhi) {
    TTile r; r.valid = false;
    int base = 0;
    for (int j = jlo; j < jhi; ++j) { const TJob jb = get_tjob(j, p, ws); const int nnb = (jb.N + 255) >> 8, tpm = (jb.K >> 8) * nnb, nt = jb.nmat * tpm;
        if (t < base + nt) { const int rr = t - base, mat = rr / tpm, q = rr - mat * tpm, kb = q / nnb, nb = q - kb * nnb;
            r.src = jb.src + (size_t)mat * jb.sstride; r.dst = jb.dst + (size_t)mat * jb.dstride; r.kscale = jb.kscale ? jb.kscale + mat * jb.ksstride : nullptr;
            r.K = jb.K; r.N = jb.N; r.k0 = kb << 8; r.n0 = nb << 8; r.map = jb.map; r.fp8 = jb.fp8; r.wscale = jb.wscale; r.SP = jb.sp; r.valid = true; return r; }
        base += nt; }
    return r;
}
__device__ __forceinline__ int ttile_total(KPtr p, unsigned char* ws, int jlo, int jhi) { int n = 0; for (int j = jlo; j < jhi; ++j) { const TJob jb = get_tjob(j, p, ws); n += jb.nmat * (jb.K >> 8) * ((jb.N + 255) >> 8); } return n; }
__device__ __forceinline__ void prologue_phase(KPtr p, unsigned char* ws, LAS unsigned char* lds, int tid, int vcu, int G, int gw, int NGW, int lane, int jlo, int jhi, bool misc) {
    const int wave = __builtin_amdgcn_readfirstlane(tid >> 6);
    const int total = ttile_total(p, ws, jlo, jhi);
    f32x4 R[32];
    TTile cur = get_ttile(vcu, p, ws, jlo, jhi);
#define TT_LOAD(tt) do { const bool ok_ = (tt).n0 + 4 * lane < (tt).N; const float* sp_ = (tt).src + (size_t)((tt).k0 + 32 * wave) * (tt).SP + (tt).n0 + 4 * lane; \
        _Pragma("unroll") for (int i = 0; i < 32; ++i) R[i] = ok_ ? *(const f32x4*)(sp_ + (size_t)i * (tt).SP) : (f32x4){0.f, 0.f, 0.f, 0.f}; } while (0)
    if (vcu < total) TT_LOAD(cur);
    for (int t = vcu; t < total; t += G) {
        const float sc = cur.wscale;
        if (cur.kscale) {
#pragma unroll
            for (int i = 0; i < 32; ++i) R[i] = R[i] * cur.kscale[cur.k0 + 32 * wave + i]; }
        if (!cur.fp8) {
#pragma unroll
            for (int q = 0; q < 4; ++q) { const int row = 4 * lane + q;
#pragma unroll
                for (int ci = 0; ci < 4; ++ci) { u32x4 w; w.x = cvt_pk_bf16(R[ci * 8 + 0][q], R[ci * 8 + 1][q]); w.y = cvt_pk_bf16(R[ci * 8 + 2][q], R[ci * 8 + 3][q]); w.z = cvt_pk_bf16(R[ci * 8 + 4][q], R[ci * 8 + 5][q]); w.w = cvt_pk_bf16(R[ci * 8 + 6][q], R[ci * 8 + 7][q]);
                    *(LAS u32x4*)(lds + row * 512 + (((4 * wave + ci) ^ (lane & 31)) << 4)) = w; } }
        } else {
#pragma unroll
            for (int q = 0; q < 4; ++q) { const int row = 4 * lane + q;
#pragma unroll
                for (int ci = 0; ci < 2; ++ci) { u32x4 w; const int b = ci * 16;
                    w.x = cvt4_fp8(R[b + 0][q] * sc, R[b + 1][q] * sc, R[b + 2][q] * sc, R[b + 3][q] * sc); w.y = cvt4_fp8(R[b + 4][q] * sc, R[b + 5][q] * sc, R[b + 6][q] * sc, R[b + 7][q] * sc);
                    w.z = cvt4_fp8(R[b + 8][q] * sc, R[b + 9][q] * sc, R[b + 10][q] * sc, R[b + 11][q] * sc); w.w = cvt4_fp8(R[b + 12][q] * sc, R[b + 13][q] * sc, R[b + 14][q] * sc, R[b + 15][q] * sc);
                    *(LAS u32x4*)(lds + row * 256 + (((2 * wave + ci) ^ (lane & 15)) << 4)) = w; } }
        }
        __syncthreads();
        const TTile nxt = get_ttile(t + G, p, ws, jlo, jhi);
        if (t + G < total) TT_LOAD(nxt);
        if (!cur.fp8) {
#pragma unroll 4
            for (int i = 0; i < 16; ++i) { const int row = (tid >> 5) + 16 * i, ch = tid & 31;
                if (cur.n0 + row < cur.N) { const u32x4 w = *(const LAS u32x4*)(lds + row * 512 + ((ch ^ ((row >> 2) & 31)) << 4));
                    *(u32x4*)(cur.dst + ((size_t)rowmap_rt(cur.map, cur.n0 + row) * cur.K + cur.k0) * 2 + ch * 16) = w; } }
        } else {
#pragma unroll 4
            for (int i = 0; i < 8; ++i) { const int row = (tid >> 4) + 32 * i, ch = tid & 15;
                if (cur.n0 + row < cur.N) { const u32x4 w = *(const LAS u32x4*)(lds + row * 256 + ((ch ^ ((row >> 2) & 15)) << 4));
                    *(u32x4*)(cur.dst + ((size_t)rowmap_rt(cur.map, cur.n0 + row) * cur.K + cur.k0) + ch * 16) = w; } }
        }
        __syncthreads();
        cur = nxt;
    }
#undef TT_LOAD
    if (!misc) return;
    const size_t gt = (size_t)gw * 64 + lane, NT_ = (size_t)NGW * 64;
    for (size_t i = gt; i < (size_t)192 * 1024 * (ATT_FP8 ? 1 : 2) / 16; i += NT_) *(u32x4*)(ws + WS_WKVA + (size_t)320 * 1024 * (ATT_FP8 ? 1 : 2) + i * 16) = (u32x4){0u, 0u, 0u, 0u};
    for (size_t i = gt; i < (size_t)4 * 32768; i += NT_) { const int l = (int)(i >> 15), r = (int)(i & 32767), e = r >> 10, k = r & 1023; ((float*)(ws + WS_WRT))[i] = p->in[18][(size_t)l * 32768 + k * 32 + e]; }
    for (size_t i = gt; i < (size_t)T * 1024 / 8; i += NT_) { const f32x4 a = *(const f32x4*)(p->in[0] + i * 8), b = *(const f32x4*)(p->in[0] + i * 8 + 4); *(u32x4*)((bf16_t*)(ws + WS_XBA) + i * 8) = pack8(a, b);
        if (G1B_FP8) { u32x2 w8; w8.x = cvt4_fp8(a[0], a[1], a[2], a[3]); w8.y = cvt4_fp8(b[0], b[1], b[2], b[3]); *(u32x2*)(ws + WS_XF8 + i * 8) = w8; } }
    for (size_t i = gt; i < (size_t)4 * T * 256 / 8; i += NT_) { const f32x4 a = *(const f32x4*)(p->in[1] + i * 8), b = *(const f32x4*)(p->in[1] + i * 8 + 4); *(u32x4*)((bf16_t*)(ws + WS_PB) + i * 8) = pack8(a, b); }
    const int* pos = (const int*)p->in[2];
    if ((NT_ & 127) == 0) {
        { const int j = (int)(gt & 127); const double inv = exp(-(double)j * (2.0 / 256.0) * 9.210340371976184);
          for (size_t i = gt; i < (size_t)T * 128; i += NT_) { double sn, cs; sincos((double)pos[i >> 7] * inv, &sn, &cs); ((float*)(ws + WS_COSR))[i] = (float)cs; ((float*)(ws + WS_SINR))[i] = (float)sn; } }
        { const int j = (int)(gt & 31); const double inv = exp(-(double)j * (2.0 / 64.0) * 9.210340371976184);
          for (size_t i = gt; i < (size_t)T * 32; i += NT_) { double sn, cs; sincos((double)pos[i >> 5] * inv, &sn, &cs); ((float*)(ws + WS_COSM))[i] = (float)cs; ((float*)(ws + WS_SINM))[i] = (float)sn; } }
    } else {
    for (size_t i = gt; i < (size_t)T * 128; i += NT_) { const int t = (int)(i >> 7), j = (int)(i & 127);
        const double inv = exp(-(double)j * (2.0 / 256.0) * 9.210340371976184), ang = (double)pos[t] * inv; const float c = (float)cos(ang), s = (float)sin(ang);
        ((float*)(ws + WS_COSR))[i] = c; ((float*)(ws + WS_SINR))[i] = s; }
    for (size_t i = gt; i < (size_t)T * 32; i += NT_) { const int t = (int)(i >> 5), j = (int)(i & 31);
        const double inv = exp(-(double)j * (2.0 / 64.0) * 9.210340371976184), ang = (double)pos[t] * inv;
        ((float*)(ws + WS_COSM))[i] = (float)cos(ang); ((float*)(ws + WS_SINM))[i] = (float)sin(ang); }
    }
}

template <int N> __device__ __forceinline__ void tr_step(float (&pa)[32], float (&pb)[32], int lane, int mask) {
    const bool up = (lane & mask) != 0; float ra[N], rb[N];
#pragma unroll
    for (int i = 0; i < N; ++i) { ra[i] = __shfl_xor(up ? pa[i] : pa[i + N], mask); rb[i] = __shfl_xor(up ? pb[i] : pb[i + N], mask); }
    __builtin_amdgcn_sched_barrier(0);
#pragma unroll
    for (int i = 0; i < N; ++i) { pa[i] = (up ? pa[i + N] : pa[i]) + ra[i]; pb[i] = (up ? pb[i + N] : pb[i]) + rb[i]; }
    __builtin_amdgcn_sched_barrier(0);
}
__device__ __forceinline__ void ln1_router_phase(KPtr p, unsigned char* ws, LAS unsigned char* lds, int layer, const bf16_t* hin, int tid, int wave, int lane, int G, bool dry = false) {
    LAS float* wrt = (LAS float*)lds;
    volatile LAS unsigned* misc = (volatile LAS unsigned*)(lds + MISC_OFF);
    const float* wr = p->in[18] + (size_t)layer * 1024 * 32; const float* br = p->in[19] + layer * 32;
    const float* lg = p->in[14] + layer * 1024; const float* lb = p->in[15] + layer * 1024;
    u32x2 nh[2][4], nm[2][4];
    if ((int)blockIdx.x < T / 128) {
#pragma unroll
        for (int q = 0; q < 2; ++q) { const size_t ro = (size_t)((int)blockIdx.x * 128 + wave * 16 + q) * 1024;
#pragma unroll
            for (int j = 0; j < 4; ++j) { nh[q][j] = *(const u32x2*)(hin + ro + 256 * j + 4 * lane); nm[q][j] = *(const u32x2*)(((const bf16_t*)(ws + WS_MIX)) + ro + 256 * j + 4 * lane); } } }
    { const f32x4* wt4 = (const f32x4*)(ws + WS_WRT) + (size_t)layer * 8192;
#pragma unroll 4
      for (int i = tid; i < 8192; i += 512) *(LAS f32x4*)(wrt + (i >> 8) * 1028 + 4 * (i & 255)) = wt4[i]; }
    bf16_t* H = (bf16_t*)(ws + (dry ? WS_END : WS_H)); const bf16_t* MIX = (const bf16_t*)(ws + WS_MIX); bf16_t* XBB = (bf16_t*)(ws + (dry ? WS_END + ((size_t)T * 4096) : WS_XBB));
    int* EIDX = (int*)(ws + (dry ? WS_END + ((size_t)T * 6144) : WS_EIDX)); float* GATE = (float*)(ws + (dry ? WS_END + ((size_t)T * 6144) + (size_t)T * 16 : WS_GATE)); int* POS = (int*)(ws + (dry ? WS_END + ((size_t)T * 6144) + (size_t)T * 32 : WS_POS));
    unsigned* gcnt = (unsigned*)(ws + WS_CTL) + CW_CNT + (dry ? 4 : layer) * 32 * 64;
    int* TOKL = (int*)(ws + (dry ? WS_END + ((size_t)100 << 20) : WS_XG));
    LAS float* gl = (LAS float*)(lds + GB_OFF);
    if (tid < 256) *(LAS f32x4*)(gl + 4 * tid) = *(const f32x4*)(lg + 4 * tid); else *(LAS f32x4*)(gl + 4 * tid) = *(const f32x4*)(lb + 4 * (tid - 256));
    const float mybias = br[lane >> 1];
    for (int tb = blockIdx.x; tb < T / 128; tb += G) {
        if (tid < 32) misc[MW_LCNT + tid] = 0u;
        __syncthreads();
        const int base = tb * 128;
        if (tb != (int)blockIdx.x)
#pragma unroll
        for (int q = 0; q < 2; ++q) { const size_t ro = (size_t)(base + wave * 16 + q) * 1024;
#pragma unroll
            for (int j = 0; j < 4; ++j) { nh[q][j] = *(const u32x2*)(hin + ro + 256 * j + 4 * lane); nm[q][j] = *(const u32x2*)(MIX + ro + 256 * j + 4 * lane); } }
        for (int pr = 0; pr < 8; ++pr) {
            const int tl = wave * 16 + pr * 2;
            f32x4 y[2][4];
#pragma unroll
            for (int q = 0; q < 2; ++q)
#pragma unroll
                for (int j = 0; j < 4; ++j) { const u32x2 a = nh[q][j], b = nm[q][j];
                    y[q][j] = (f32x4){bflo(a.x), bfhi(a.x), bflo(a.y), bfhi(a.y)} * DN_ALPHA + (f32x4){bflo(b.x), bfhi(b.x), bflo(b.y), bfhi(b.y)}; }
            if (pr < 7) {
#pragma unroll
                for (int q = 0; q < 2; ++q) { const size_t ro = (size_t)(base + tl + 2 + q) * 1024;
#pragma unroll
                    for (int j = 0; j < 4; ++j) { nh[q][j] = *(const u32x2*)(hin + ro + 256 * j + 4 * lane); nm[q][j] = *(const u32x2*)(MIX + ro + 256 * j + 4 * lane); } } }
            f32x4 g4[4], b4[4];
#pragma unroll
            for (int j = 0; j < 4; ++j) { g4[j] = *(const LAS f32x4*)(gl + 256 * j + 4 * lane); b4[j] = *(const LAS f32x4*)(gl + 1024 + 256 * j + 4 * lane); }
#pragma unroll
            for (int q = 0; q < 2; ++q) { const size_t ro = (size_t)(base + tl + q) * 1024; float s = 0.f;
#pragma unroll
                for (int j = 0; j < 4; ++j) s += (y[q][j][0] + y[q][j][1]) + (y[q][j][2] + y[q][j][3]);
                const float mean = wave_sum(s) * (1.0f / 1024.0f); float s2 = 0.f;
#pragma unroll
                for (int j = 0; j < 4; ++j) { y[q][j] = y[q][j] - mean; s2 += (y[q][j][0] * y[q][j][0] + y[q][j][1] * y[q][j][1]) + (y[q][j][2] * y[q][j][2] + y[q][j][3] * y[q][j][3]); }
                const float rstd = rsqrtf(wave_sum(s2) * (1.0f / 1024.0f) + LN_EPS);
#pragma unroll
                for (int j = 0; j < 4; ++j) { y[q][j] = y[q][j] * rstd * g4[j] + b4[j];
                    { u32x2 w; w.x = cvt_pk_bf16(y[q][j][0], y[q][j][1]); w.y = cvt_pk_bf16(y[q][j][2], y[q][j][3]); *(u32x2*)(H + ro + 256 * j + 4 * lane) = w; }
                    *(unsigned*)((unsigned char*)XBB + ro + 256 * j + 4 * lane) = cvt4_fp8(y[q][j][0], y[q][j][1], y[q][j][2], y[q][j][3]); }
            }
            float pa[32], pb[32];
            f32x4 wq[2][4];
#pragma unroll
            for (int j = 0; j < 4; ++j) wq[0][j] = *(const LAS f32x4*)(wrt + 256 * j + 4 * lane);
#pragma unroll
            for (int e = 0; e < 32; ++e) { const int cb = e & 1;
                if (e + 1 < 32) {
#pragma unroll
                    for (int j = 0; j < 4; ++j) wq[cb ^ 1][j] = *(const LAS f32x4*)(wrt + (e + 1) * 1028 + 256 * j + 4 * lane); }
                __builtin_amdgcn_sched_barrier(0);
                f32x2 sa = {0.f, 0.f}, sb = {0.f, 0.f};
#pragma unroll
                for (int j = 0; j < 4; ++j) { const f32x4 w4 = wq[cb][j];
                    const f32x2 wl = __builtin_shufflevector(w4, w4, 0, 1), wh = __builtin_shufflevector(w4, w4, 2, 3);
                    sa = __builtin_elementwise_fma(__builtin_shufflevector(y[0][j], y[0][j], 0, 1), wl, sa); sa = __builtin_elementwise_fma(__builtin_shufflevector(y[0][j], y[0][j], 2, 3), wh, sa);
                    sb = __builtin_elementwise_fma(__builtin_shufflevector(y[1][j], y[1][j], 0, 1), wl, sb); sb = __builtin_elementwise_fma(__builtin_shufflevector(y[1][j], y[1][j], 2, 3), wh, sb); }
                pa[e] = sa[0] + sa[1]; pb[e] = sb[0] + sb[1];
                __builtin_amdgcn_sched_barrier(0); }
            tr_step<16>(pa, pb, lane, 32); tr_step<8>(pa, pb, lane, 16); tr_step<4>(pa, pb, lane, 8); tr_step<2>(pa, pb, lane, 4); tr_step<1>(pa, pb, lane, 2);
            float lv[2]; lv[0] = pa[0] + __shfl_xor(pa[0], 1) + mybias; lv[1] = pb[0] + __shfl_xor(pb[0], 1) + mybias;
            const int myexp = lane >> 1;
#pragma unroll
            for (int q = 0; q < 2; ++q) { float tv[4]; int ti[4];
                const unsigned ub = __float_as_uint(lv[q]); unsigned key = (((ub & 0x80000000u) ? ~ub : (ub | 0x80000000u)) & ~31u) | (unsigned)(31 - myexp);
#pragma unroll
                for (int r = 0; r < 4; ++r) { const unsigned best = wave_umax(key); const int bi = 31 - (int)(best & 31u);
                    ti[r] = bi; tv[r] = __uint_as_float(__builtin_amdgcn_readlane(__float_as_uint(lv[q]), 2 * bi)); if (myexp == bi) key = 0u; }
                const float e1 = __expf(tv[1] - tv[0]), e2 = __expf(tv[2] - tv[0]), e3 = __expf(tv[3] - tv[0]), inv = 1.0f / (1.0f + e1 + e2 + e3);
                if (lane < 4) { const int ek = lane == 0 ? ti[0] : lane == 1 ? ti[1] : lane == 2 ? ti[2] : ti[3];
                    const float gk = (lane == 0 ? 1.0f : lane == 1 ? e1 : lane == 2 ? e2 : e3) * inv;
                    const int t = base + tl + q; EIDX[t * 4 + lane] = ek; GATE[t * 4 + lane] = gk;
                    const unsigned lp = __hip_atomic_fetch_add((LAS unsigned*)&misc[MW_LCNT + ek], 1u, __ATOMIC_RELAXED, __HIP_MEMORY_SCOPE_WORKGROUP);
                    misc[MW_TOK + (tl + q) * 4 + lane] = (unsigned)ek | (lp << 8); }
            }
        }
        __syncthreads();
        if (tid < 32) misc[MW_LBASE + tid] = __hip_atomic_fetch_add(gcnt + tid * 64, misc[MW_LCNT + tid], __ATOMIC_RELAXED, __HIP_MEMORY_SCOPE_AGENT);
        __syncthreads();
        { const unsigned v = misc[MW_TOK + tid]; const unsigned e = v & 255u; const int pos = (int)(misc[MW_LBASE + e] + (v >> 8));
          POS[base * 4 + tid] = pos; TOKL[(size_t)e * T + pos] = base + (tid >> 2); }
        __syncthreads();
    }
}
__device__ __forceinline__ void plan_phase(unsigned char* ws, LAS unsigned char* lds, int layer, int tid) {
    volatile LAS unsigned* misc = (volatile LAS unsigned*)(lds + MISC_OFF);
    unsigned* gcnt = (unsigned*)(ws + WS_CTL) + CW_CNT + layer * 32 * 64;
    if (tid < 32) misc[MW_CNT + tid] = __hip_atomic_load(gcnt + tid * 64, __ATOMIC_RELAXED, __HIP_MEMORY_SCOPE_AGENT);
    __syncthreads();
    if (tid < 32) {
        volatile LAS unsigned char* rbe = (volatile LAS unsigned char*)(misc + MW_RBEXP);
        const unsigned nb = (misc[MW_CNT + tid] + 255u) >> 8; unsigned inc = nb;
#pragma unroll
        for (int d = 1; d < 32; d <<= 1) { const unsigned v = (unsigned)__shfl_up((int)inc, d, 32); if (tid >= d) inc += v; }
        const unsigned first = inc - nb;
        misc[MW_PSTART + tid] = first << 8; for (unsigned r = 0; r < nb; ++r) rbe[first + r] = (unsigned char)tid;
        if (tid == 31) misc[MW_NRB] = inc; }
    __syncthreads();
}
__device__ __forceinline__ void ln2_phase(KPtr p, unsigned char* ws, LAS unsigned char* lds, int layer, int lane, int gw, int NGW, bool dry = false) {
    const bf16_t* H = (const bf16_t*)(ws + WS_H); bf16_t* XBB = (bf16_t*)(ws + (dry ? WS_END + ((size_t)T * 4096) : WS_XBB)); const unsigned char* YS = (const unsigned char*)(ws + WS_YS);
    const int* EIDX = (const int*)(ws + WS_EIDX); const int* POS = (const int*)(ws + WS_POS); const float* GATE = (const float*)(ws + WS_GATE);
    volatile LAS unsigned* misc = (volatile LAS unsigned*)(lds + MISC_OFF);
    const float* lg = p->in[16] + layer * 1024; const float* lb = p->in[17] + layer * 1024;
    f32x4 gam[2][2], bet[2][2];
#pragma unroll
    for (int j = 0; j < 2; ++j) { const int c = j * 512 + lane * 8; gam[j][0] = *(const f32x4*)(lg + c); gam[j][1] = *(const f32x4*)(lg + c + 4); bet[j][0] = *(const f32x4*)(lb + c); bet[j][1] = *(const f32x4*)(lb + c + 4); }
    int sl = 0, sln = 0; float gt = 0.f, gtn = 0.f; u32x4 hr[2]; u32x2 ys[4][2];
#define LN2_SLOTS(tt, S_, G_) do { if ((tt) < T && lane < 4) { S_ = (int)misc[MW_PSTART + EIDX[(tt) * 4 + lane]] + POS[(tt) * 4 + lane]; G_ = GATE[(tt) * 4 + lane]; } } while (0)
#define LN2_ROWS(tt, S_) do { if ((tt) < T) { _Pragma("unroll") for (int k = 0; k < 4; ++k) { const int sk = __builtin_amdgcn_readlane(S_, k); \
            _Pragma("unroll") for (int j = 0; j < 2; ++j) ys[k][j] = *(const u32x2*)(YS + (size_t)sk * 1024 + j * 512 + lane * 8); } \
        _Pragma("unroll") for (int j = 0; j < 2; ++j) hr[j] = *(const u32x4*)(H + (size_t)(tt) * 1024 + j * 512 + lane * 8); } } while (0)
    LN2_SLOTS(gw, sl, gt); LN2_SLOTS(gw + NGW, sln, gtn);
    LN2_ROWS(gw, sl);
    for (int t = gw; t < T; t += NGW) {
        u32x2 cy[4][2]; u32x4 ch[2]; float gk[4];
#pragma unroll
        for (int k = 0; k < 4; ++k) { cy[k][0] = ys[k][0]; cy[k][1] = ys[k][1]; gk[k] = __uint_as_float(__builtin_amdgcn_readlane(__float_as_uint(gt), k)); }
        ch[0] = hr[0]; ch[1] = hr[1];
        sl = sln; gt = gtn;
        LN2_ROWS(t + NGW, sl);
        LN2_SLOTS(t + 2 * NGW, sln, gtn);
        float x[16];
#pragma unroll
        for (int j = 0; j < 2; ++j) { const u32x4 w = ch[j];
            x[j * 8 + 0] = bflo(w.x) * DN_ALPHA; x[j * 8 + 1] = bfhi(w.x) * DN_ALPHA; x[j * 8 + 2] = bflo(w.y) * DN_ALPHA; x[j * 8 + 3] = bfhi(w.y) * DN_ALPHA;
            x[j * 8 + 4] = bflo(w.z) * DN_ALPHA; x[j * 8 + 5] = bfhi(w.z) * DN_ALPHA; x[j * 8 + 6] = bflo(w.w) * DN_ALPHA; x[j * 8 + 7] = bfhi(w.w) * DN_ALPHA; }
        float s = 0.f;
#pragma unroll
        for (int k = 0; k < 4; ++k)
#pragma unroll
            for (int j = 0; j < 2; ++j) { const u32x2 w = cy[k][j]; const float g_ = gk[k] * (1.0f / YS_SCALE);
                const f32x2 a = __builtin_amdgcn_cvt_pk_f32_fp8((int)w.x, false), b = __builtin_amdgcn_cvt_pk_f32_fp8((int)w.x, true);
                const f32x2 c = __builtin_amdgcn_cvt_pk_f32_fp8((int)w.y, false), d = __builtin_amdgcn_cvt_pk_f32_fp8((int)w.y, true);
                x[j * 8 + 0] += g_ * a[0]; x[j * 8 + 1] += g_ * a[1]; x[j * 8 + 2] += g_ * b[0]; x[j * 8 + 3] += g_ * b[1];
                x[j * 8 + 4] += g_ * c[0]; x[j * 8 + 5] += g_ * c[1]; x[j * 8 + 6] += g_ * d[0]; x[j * 8 + 7] += g_ * d[1]; }
#pragma unroll
        for (int i = 0; i < 16; ++i) s += x[i];
        const float mean = wave_sum(s) * (1.0f / 1024.0f); float s2 = 0.f;
#pragma unroll
        for (int i = 0; i < 16; ++i) { x[i] -= mean; s2 += x[i] * x[i]; }
        const float rstd = rsqrtf(wave_sum(s2) * (1.0f / 1024.0f) + LN_EPS);
#pragma unroll
        for (int j = 0; j < 2; ++j) { const int c = j * 512 + lane * 8; const size_t o = (size_t)t * 1024 + c;
            const f32x4 ga = gam[j][0], gb = gam[j][1], ba = bet[j][0], bb = bet[j][1];
            f32x4 ya, yb;
#pragma unroll
            for (int i = 0; i < 4; ++i) { ya[i] = x[j * 8 + i] * rstd * ga[i] + ba[i]; yb[i] = x[j * 8 + 4 + i] * rstd * gb[i] + bb[i]; }
            *(u32x4*)(XBB + o) = pack8(ya, yb); }
    }
#undef LN2_SLOTS
#undef LN2_ROWS
}
__device__ __forceinline__ void ret_scan_phase(unsigned char* ws, int gthread, int nthreads, bool dry = false) {
    bf16_t* VS = (bf16_t*)(ws + WS_VS); const size_t wofs = dry ? (WS_END - WS_VS) / 2 : 0;
    for (int it = gthread; it < 16 * 512 * 32; it += nthreads) {
        const int dk8 = it & 31, dv = (it >> 5) & 511, bh = it >> 14;
        const float g256 = exp2f(log2gamma(bh & 3) * 256.0f);
        bf16_t* ptr = VS + (size_t)bh * 32 * 262144 + (size_t)dv * 512 + 256 + dk8 * 8;
        float s[8];
#pragma unroll
        for (int i = 0; i < 8; ++i) s[i] = 0.f;
        u32x4 ua[32];
#pragma unroll
        for (int n = 0; n < 32; ++n) ua[n] = *(const u32x4*)(ptr + (size_t)n * 262144);
#pragma unroll
        for (int n = 0; n < 32; ++n) {
            const u32x4 uw = ua[n];
            f32x4 a, b; a[0] = s[0]; a[1] = s[1]; a[2] = s[2]; a[3] = s[3]; b[0] = s[4]; b[1] = s[5]; b[2] = s[6]; b[3] = s[7];
            *(u32x4*)(ptr + wofs + (size_t)n * 262144) = pack8(a, b);
            s[0] = s[0] * g256 + bflo(uw.x); s[1] = s[1] * g256 + bfhi(uw.x); s[2] = s[2] * g256 + bflo(uw.y); s[3] = s[3] * g256 + bfhi(uw.y);
            s[4] = s[4] * g256 + bflo(uw.z); s[5] = s[5] * g256 + bfhi(uw.z); s[6] = s[6] * g256 + bflo(uw.w); s[7] = s[7] * g256 + bfhi(uw.w);
        }
    }
}
__device__ __forceinline__ void ret_gn_phase(KPtr p, unsigned char* ws, int layer, int lane, int gw, int NGW) {
    const bf16_t* Y = (const bf16_t*)(ws + WS_Y); const bf16_t* GB = (const bf16_t*)(ws + WS_GB); bf16_t* Z = (bf16_t*)(ws + WS_Z);
    const float* gg = p->in[4] + layer * 2048; const float* gb = p->in[5] + layer * 2048;
    f32x4 gam[4][2], bet[4][2];
#pragma unroll
    for (int hh = 0; hh < 4; ++hh) { const int c = hh * 512 + lane * 8;
        gam[hh][0] = *(const f32x4*)(gg + c); gam[hh][1] = *(const f32x4*)(gg + c + 4); bet[hh][0] = *(const f32x4*)(gb + c); bet[hh][1] = *(const f32x4*)(gb + c + 4); }
    u32x4 ny[4], ng[4];
    if (gw < T) {
#pragma unroll
        for (int hh = 0; hh < 4; ++hh) { const size_t o = (size_t)gw * 2048 + hh * 512 + lane * 8; ny[hh] = *(const u32x4*)(Y + o); ng[hh] = *(const u32x4*)(GB + o); } }
    for (int t = gw; t < T; t += NGW) {
        u32x4 cy[4], cg[4];
#pragma unroll
        for (int hh = 0; hh < 4; ++hh) { cy[hh] = ny[hh]; cg[hh] = ng[hh]; }
        if (t + NGW < T) {
#pragma unroll
            for (int hh = 0; hh < 4; ++hh) { const size_t o = (size_t)(t + NGW) * 2048 + hh * 512 + lane * 8; ny[hh] = *(const u32x4*)(Y + o); ng[hh] = *(const u32x4*)(GB + o); } }
#pragma unroll
        for (int hh = 0; hh < 4; ++hh) { const int c = hh * 512 + lane * 8; const size_t o = (size_t)t * 2048 + c;
            const u32x4 w = cy[hh], gw4 = cg[hh];
            float x[8] = {bflo(w.x), bfhi(w.x), bflo(w.y), bfhi(w.y), bflo(w.z), bfhi(w.z), bflo(w.w), bfhi(w.w)};
            float gv[8] = {bflo(gw4.x), bfhi(gw4.x), bflo(gw4.y), bfhi(gw4.y), bflo(gw4.z), bfhi(gw4.z), bflo(gw4.w), bfhi(gw4.w)};
#pragma unroll
            for (int i = 0; i < 8; i += 2) {
                const f32x2 g2 = {gv[i], gv[i + 1]}; const f32x2 t2 = g2 * (f32x2){-1.4426950408889634f, -1.4426950408889634f};
                f32x2 e2 = {__builtin_amdgcn_exp2f(t2[0]), __builtin_amdgcn_exp2f(t2[1])}; e2 = e2 + (f32x2){1.0f, 1.0f};
                const f32x2 r2 = g2 * (f32x2){__builtin_amdgcn_rcpf(e2[0]), __builtin_amdgcn_rcpf(e2[1])}; gv[i] = r2[0]; gv[i + 1] = r2[1]; }
            float s = 0.f;
#pragma unroll
            for (int i = 0; i < 8; ++i) s += x[i];
            const float mean = wave_sum(s) * (1.0f / 512.0f); float s2 = 0.f;
#pragma unroll
            for (int i = 0; i < 8; ++i) { x[i] -= mean; s2 += x[i] * x[i]; }
            const float rstd = rsqrtf(wave_sum(s2) * (1.0f / 512.0f) + GN_EPS);
            const f32x4 ga = gam[hh][0], gbv = gam[hh][1], ba = bet[hh][0], bb = bet[hh][1];
            f32x4 ya, yb;
#pragma unroll
            for (int i = 0; i < 4; ++i) { ya[i] = (x[i] * rstd * ga[i] + ba[i]) * gv[i]; yb[i] = (x[4 + i] * rstd * gbv[i] + bb[i]) * gv[4 + i]; }
#if G5_FP8
            { u32x2 w8; w8.x = cvt4_fp8(ya[0] * Z_SCALE, ya[1] * Z_SCALE, ya[2] * Z_SCALE, ya[3] * Z_SCALE); w8.y = cvt4_fp8(yb[0] * Z_SCALE, yb[1] * Z_SCALE, yb[2] * Z_SCALE, yb[3] * Z_SCALE); *(u32x2*)((unsigned char*)Z + o) = w8; } }
#else
            *(u32x4*)(Z + o) = pack8(ya, yb); }
#endif
    }
}

namespace att {
constexpr int SHM_V = 64 * 128 * 2, SHM_K = 64 * 192 * 2;
constexpr int OFF_V = 0, OFF_K = 2 * SHM_V, OFF_WS = 2 * SHM_V + 2 * SHM_K;
constexpr float THR = 8.f;
#define KSWZ192(row, colB) ((row) * 384 + ((colB) ^ (((row) & 7) << 4)))
#define SBAR() __builtin_amdgcn_sched_barrier(0)
__device__ __forceinline__ int v_st(int k, int c) { const int kk = (k & ~0xC) | ((k & 4) << 1) | ((k & 8) >> 1); return ((kk >> 3) * 4 + (c >> 5)) * 512 + ((kk & 7) * 32 + (c & 31)) * 2; }
__device__ __forceinline__ int v_rd_base(int lane) { return ((lane & 3) << 3) | (((lane >> 2) & 3) << 6) | (((lane >> 4) & 1) << 5) | (((lane >> 5) & 1) << 8); }
constexpr int v_rd_off(int d0, int ks, int half) { return d0 * 512 + ks * 4096 + half * 2048; }
__device__ __forceinline__ int crow(int r, int hi) { return (r & 3) + 8 * (r >> 2) + 4 * hi; }
__device__ __forceinline__ void mask_tile(f32x16& p0, f32x16& p1, int dq) {
    const float NEG = -__builtin_inff();
#pragma unroll
    for (int r = 0; r < 16; ++r) { const int c = (r & 3) + 8 * (r >> 2);
        if (dq - c < 0) p0[r] = NEG;
        if (dq - c - 32 < 0) p1[r] = NEG; }
}
__device__ __forceinline__ void partialSM(f32x16& p0, f32x16& p1, float& m_reg, float& alpha) {
    float pmax = p0[0];
#pragma unroll
    for (int r = 1; r < 16; ++r) pmax = fmaxf(pmax, p0[r]);
#pragma unroll
    for (int r = 0; r < 16; ++r) pmax = fmaxf(pmax, p1[r]);
    { auto rr = __builtin_amdgcn_permlane32_swap(__float_as_uint(pmax), __float_as_uint(pmax), false, false);
      pmax = fmaxf(__uint_as_float(rr[0]), __uint_as_float(rr[1])); }
    float mn;
    if (__builtin_expect(__all((pmax - m_reg) <= THR), 1)) { mn = m_reg; alpha = 1.f; }
    else { mn = fmaxf(m_reg, pmax); alpha = __builtin_amdgcn_exp2f(m_reg - mn); m_reg = mn; }
#pragma unroll
    for (int r = 0; r < 16; ++r) p0[r] = __builtin_amdgcn_exp2f(p0[r] - mn);
#pragma unroll
    for (int r = 0; r < 16; ++r) p1[r] = __builtin_amdgcn_exp2f(p1[r] - mn);
}
__device__ __forceinline__ void finishSM(const f32x16& p0, const f32x16& p1, float alpha, float& l_reg, bf16x8& pa0, bf16x8& pa1, bf16x8& pa2, bf16x8& pa3) {
    float ps = 0;
#pragma unroll
    for (int r = 0; r < 16; ++r) ps += p0[r];
#pragma unroll
    for (int r = 0; r < 16; ++r) ps += p1[r];
    { auto rr = __builtin_amdgcn_permlane32_swap(__float_as_uint(ps), __float_as_uint(ps), false, false);
      ps = __uint_as_float(rr[0]) + __uint_as_float(rr[1]); }
    l_reg = l_reg * alpha + ps;
#define PK4(P, B_, OUT) do { unsigned a0 = cvt_pk_bf16(P[B_+0], P[B_+1]), a1 = cvt_pk_bf16(P[B_+2], P[B_+3]); \
        unsigned b0 = cvt_pk_bf16(P[B_+4], P[B_+5]), b1 = cvt_pk_bf16(P[B_+6], P[B_+7]); \
        auto r0 = __builtin_amdgcn_permlane32_swap(a0, b0, false, false); auto r1 = __builtin_amdgcn_permlane32_swap(a1, b1, false, false); \
        u32x4 w = {r0[0], r1[0], r0[1], r1[1]}; OUT = __builtin_bit_cast(bf16x8, w); } while (0)
    PK4(p0, 0, pa0); PK4(p0, 8, pa1); PK4(p1, 0, pa2); PK4(p1, 8, pa3);
#undef PK4
}
template <int KB>
__device__ __forceinline__ void qkt(f32x16& p0, f32x16& p1, const LAS char* K_lds, int r32, int hi, const bf16x8* qr) {
    p0 = f32x16{}; p1 = f32x16{};
    const LAS char* kb[4];
#pragma unroll
    for (int dd = 0; dd < 4; ++dd) kb[dd] = K_lds + KB * SHM_K + KSWZ192(r32, (dd * 16 + hi * 8) * 2);
#pragma unroll
    for (int d0 = 0; d0 < 12; ++d0) { const LAS char* a = kb[d0 & 3] + (d0 >> 2) * 128;
        const bf16x8 b0 = *(const LAS bf16x8*)a;
        const bf16x8 b1 = *(const LAS bf16x8*)(a + 32 * 384);
        p0 = __builtin_amdgcn_mfma_f32_32x32x16_bf16(b0, qr[d0], p0, 0, 0, 0);
        p1 = __builtin_amdgcn_mfma_f32_32x32x16_bf16(b1, qr[d0], p1, 0, 0, 0); }
}
template <int VB>
__device__ __forceinline__ void pv_tile(f32x16* o, unsigned vb0, bf16x8 pa0, bf16x8 pa1, bf16x8 pa2, bf16x8 pa3) {
#define TRRD(dst, off) asm volatile("ds_read_b64_tr_b16 %0, %1 offset:%2" : "=&v"(dst) : "v"(vb0), "i"(off) : "memory")
#define PV_D0(d0) do { s16x4 l0, l1, l2, l3, h0, h1, h2, h3; constexpr int b_ = VB * SHM_V + v_rd_off(d0, 0, 0); \
        TRRD(l0, b_); TRRD(h0, b_ + 2048); TRRD(l1, b_ + 4096); TRRD(h1, b_ + 6144); TRRD(l2, b_ + 8192); TRRD(h2, b_ + 10240); TRRD(l3, b_ + 12288); TRRD(h3, b_ + 14336); \
        asm volatile("s_waitcnt lgkmcnt(0)" ::: "memory"); SBAR(); \
        o[d0] = __builtin_amdgcn_mfma_f32_32x32x16_bf16(pa0, (bf16x8){l0[0], l0[1], l0[2], l0[3], h0[0], h0[1], h0[2], h0[3]}, o[d0], 0, 0, 0); \
        o[d0] = __builtin_amdgcn_mfma_f32_32x32x16_bf16(pa1, (bf16x8){l1[0], l1[1], l1[2], l1[3], h1[0], h1[1], h1[2], h1[3]}, o[d0], 0, 0, 0); \
        o[d0] = __builtin_amdgcn_mfma_f32_32x32x16_bf16(pa2, (bf16x8){l2[0], l2[1], l2[2], l2[3], h2[0], h2[1], h2[2], h2[3]}, o[d0], 0, 0, 0); \
        o[d0] = __builtin_amdgcn_mfma_f32_32x32x16_bf16(pa3, (bf16x8){l3[0], l3[1], l3[2], l3[3], h3[0], h3[1], h3[2], h3[3]}, o[d0], 0, 0, 0); } while (0)
    PV_D0(0); PV_D0(1); PV_D0(2); PV_D0(3);
#undef PV_D0
#undef TRRD
}
struct Stage { u32x4 a, b, c; };
__device__ __forceinline__ void attn_block(const bf16_t* __restrict__ Q, const bf16_t* __restrict__ K, const bf16_t* __restrict__ V, bf16_t* __restrict__ O, int b, int h, int qb, LAS char* lds, int tid) {
    asm volatile("" : "+v"(tid));
    const int wid = __builtin_amdgcn_readfirstlane(tid >> 6), lane = tid & 63, r32 = lane & 31, hi = lane >> 5;
    const int P0 = qb * 256, NT = 4 * qb + 4, qlo = P0 + wid * 32, qm = qlo + r32 - 4 * hi;
    const size_t tb = (size_t)b * 8192;
    LAS char* V_lds = lds + OFF_V; LAS char* K_lds = lds + OFF_K;
    LAS float* wsf = (LAS float*)(lds + OFF_WS) + wid * 64; LAS float* li_l = wsf; LAS float* al_l = wsf + 32;
    const int sr = tid >> 4, sc = (tid & 15) * 8, vst0 = v_st(sr, sc), vst1 = v_st(32 + sr, sc);
#define KMAP(i, kr, kc) const int c_##i = tz_ + 512 * (i); const int kr = c_##i / 24, kc = c_##i - kr * 24
    const unsigned vgo = (unsigned)(sr * 1024 + sc);
    const unsigned vb0 = (unsigned)(uintptr_t)V_lds + (unsigned)v_rd_base(lane);
    const bf16_t* Kh = K + tb * 1536 + h * 192; const bf16_t* Vh = V + tb * 1024 + h * 128;
    bf16x8 qr[12];
    { const bf16_t* qp = Q + (tb + qlo + r32) * 1536 + h * 192 + hi * 8;
#pragma unroll
      for (int d0 = 0; d0 < 12; ++d0) qr[d0] = *(const bf16x8*)(qp + d0 * 16); }
    Stage S;
#define SLOAD_K(k0_) do { int tz_ = tid; asm volatile("" : "+v"(tz_)); KMAP(0, r0_, c0_); KMAP(1, r1_, c1_); KMAP(2, r2_, c2_); const bf16_t* kp_ = Kh + (size_t)(k0_) * 1536; \
        S.a = *(const u32x4*)(kp_ + (r0_ * 1536 + c0_ * 8)); S.b = *(const u32x4*)(kp_ + (r1_ * 1536 + c1_ * 8)); S.c = *(const u32x4*)(kp_ + (r2_ * 1536 + c2_ * 8)); } while (0)
#define SWRITE_K(bf) do { int tz_ = tid; asm volatile("" : "+v"(tz_)); KMAP(0, r0_, c0_); KMAP(1, r1_, c1_); KMAP(2, r2_, c2_); \
        *(LAS u32x4*)(K_lds + (bf) * SHM_K + KSWZ192(r0_, c0_ * 16)) = S.a; *(LAS u32x4*)(K_lds + (bf) * SHM_K + KSWZ192(r1_, c1_ * 16)) = S.b; *(LAS u32x4*)(K_lds + (bf) * SHM_K + KSWZ192(r2_, c2_ * 16)) = S.c; } while (0)
#define SLOAD_V(k0_) do { const bf16_t* vp_ = Vh + (size_t)(k0_) * 1024 + vgo; S.a = *(const u32x4*)(vp_); S.b = *(const u32x4*)(vp_ + 32 * 1024); } while (0)
#define SWRITE_V(bf) do { *(LAS u32x4*)(V_lds + (bf) * SHM_V + vst0) = S.a; *(LAS u32x4*)(V_lds + (bf) * SHM_V + vst1) = S.b; } while (0)
    float m_reg = -1e30f, l_reg = 0.f; f32x16 o[4] = {};
    SLOAD_K(0); SWRITE_K(0); SBAR(); SLOAD_V(0); SWRITE_V(0);
    __syncthreads();
    f32x16 p0, p1; float alpha; bf16x8 pa0, pa1, pa2, pa3;
#define TILE_STEP(t, BUF) do { \
        const int kb_ = (t) * 64; const bool act_ = kb_ <= qlo + 31;     \
        if ((t) + 1 < NT) SLOAD_K(kb_ + 64); \
        SBAR(); if (act_) { __builtin_amdgcn_s_setprio(1); qkt<BUF>(p0, p1, K_lds, r32, hi, qr); __builtin_amdgcn_s_setprio(0); } SBAR(); \
        if ((t) + 1 < NT) { SWRITE_K(1 - BUF); SBAR(); SLOAD_V(kb_ + 64); SBAR(); } \
        if (act_) { \
        if (kb_ + 63 > qlo) mask_tile(p0, p1, qm - kb_); \
        partialSM(p0, p1, m_reg, alpha); \
        if (__any(alpha < 1.f)) { if (hi == 0) al_l[r32] = alpha; asm volatile("s_waitcnt lgkmcnt(0)" ::: "memory"); \
            _Pragma("unroll") for (int d_ = 0; d_ < 4; ++d_) _Pragma("unroll") for (int r = 0; r < 16; ++r) o[d_][r] *= al_l[crow(r, hi)]; } \
        finishSM(p0, p1, alpha, l_reg, pa0, pa1, pa2, pa3); SBAR(); \
        __builtin_amdgcn_s_setprio(1); pv_tile<BUF>(o, vb0, pa0, pa1, pa2, pa3); __builtin_amdgcn_s_setprio(0); } \
        if ((t) + 1 < NT) { SWRITE_V(1 - BUF); } \
        __syncthreads(); } while (0)
    for (int t = 0; t < NT; t += 2) { TILE_STEP(t, 0); TILE_STEP(t + 1, 1); }
#undef TILE_STEP
#undef SLOAD_K
#undef KMAP
#undef SWRITE_K
#undef SLOAD_V
#undef SWRITE_V
    int lz = lane; asm volatile("" : "+v"(lz)); const int r32e = lz & 31, hie = lz >> 5;
    if (hie == 0) li_l[r32e] = l_reg; asm volatile("s_waitcnt lgkmcnt(0)" ::: "memory");
    bf16_t* Ow = O + (tb + qlo) * 1024 + h * 128 + r32e;
#pragma unroll
    for (int r = 0; r < 16; ++r) { const int orow = crow(r, hie); const float rl = __builtin_amdgcn_rcpf(li_l[orow]);
#pragma unroll
        for (int d0 = 0; d0 < 4; ++d0) { const float v = o[d0][r] * rl; const float vn = __shfl_xor(v, 1);
            if ((r32e & 1) == 0) *(unsigned*)(Ow + (size_t)orow * 1024 + d0 * 32) = cvt_pk_bf16(v, vn); } }
    __syncthreads();
}
__device__ __forceinline__ void attn_phase(const bf16_t* Q, const bf16_t* K, const bf16_t* V, bf16_t* O, LAS char* lds, int G, int vcu, int tid) {
    for (int L = vcu; L < 512; L += G) {
        const int bh = L >> 4, x = L & 15, b = bh >> 3, h = bh & 7;
#pragma unroll 1
        for (int pass = 0; pass < 2; ++pass) attn_block(Q, K, V, O, b, h, pass ? 31 - x : x, lds, tid);
    }
}
#undef KSWZ192
#undef SBAR
}


namespace att8 {
constexpr int SHM_K = 64 * 192, SHM_V = 128 * 64;
constexpr int OFF_V = 0, OFF_K = 2 * SHM_V, OFF_WS = 2 * SHM_V + 2 * SHM_K;
constexpr float THR = 4.f * ATT_QS;
#define SBAR() __builtin_amdgcn_sched_barrier(0)
__device__ __forceinline__ int crow(int r, int hi) { return (r & 3) + 8 * (r >> 2) + 4 * hi; }
__device__ __forceinline__ void mfma8(f32x16& acc, pg8::v8i32 a, pg8::v8i32 b, int sc) {
    asm volatile("s_nop 1\n\tv_mfma_scale_f32_32x32x64_f8f6f4 %0, %1, %2, %0, %3, %3 op_sel_hi:[0,0,0]" : "+v"(acc) : "v"(a), "v"(b), "v"(sc)); }
__device__ __forceinline__ pg8::v8i32 cat8u(u32x4 x, u32x4 y) { return (pg8::v8i32){(int)x.x, (int)x.y, (int)x.z, (int)x.w, (int)y.x, (int)y.y, (int)y.z, (int)y.w}; }
__device__ __forceinline__ float max3f(float a, float b, float c) { float r; asm("v_max3_f32 %0, %1, %2, %3" : "=v"(r) : "v"(a), "v"(b), "v"(c)); return r; }
__device__ __forceinline__ unsigned exp2_fp8x4(float a, float b, float c, float d, f32x2 c2, f32x2 o2) {
    const f32x2 t0 = __builtin_elementwise_fma((f32x2){a, b}, c2, o2), t1 = __builtin_elementwise_fma((f32x2){c, d}, c2, o2);
    unsigned w = __builtin_amdgcn_cvt_pk_u8_f32(t0[0], 0u, 0u); w = __builtin_amdgcn_cvt_pk_u8_f32(t0[1], 1u, w);
    w = __builtin_amdgcn_cvt_pk_u8_f32(t1[0], 2u, w); w = __builtin_amdgcn_cvt_pk_u8_f32(t1[1], 3u, w); return w; }
__device__ __forceinline__ void mask_tile(f32x16& p0, f32x16& p1, int dq) {
    const float NEG = -__builtin_inff();
#pragma unroll
    for (int r = 0; r < 16; ++r) { const int c = (r & 3) + 8 * (r >> 2);
        if (dq - c < 0) p0[r] = NEG;
        if (dq - c - 32 < 0) p1[r] = NEG; }
}
#define K8SWZ(row, ch) ((row) * 192 + ((((ch)) ^ (((row) >> 2) & 3)) << 4))
#define V8SWZ(row, ch) ((row) * 64 + ((((ch)) ^ (((row) >> 2) & 3)) << 4))
template <int KB>
__device__ __forceinline__ void qkt(f32x16& p0, f32x16& p1, const LAS char* K_lds, int r32, int hi, const pg8::v8i32* qf, int sc) {
    p0 = f32x16{}; p1 = f32x16{};
#pragma unroll
    for (int st = 0; st < 3; ++st) { const int ch = 4 * st + 2 * hi;
        const LAS char* ka = K_lds + KB * SHM_K;
        const u32x4 a0 = *(const LAS u32x4*)(ka + K8SWZ(r32, ch)), a1 = *(const LAS u32x4*)(ka + K8SWZ(r32, ch + 1));
        const u32x4 b0 = *(const LAS u32x4*)(ka + K8SWZ(32 + r32, ch)), b1 = *(const LAS u32x4*)(ka + K8SWZ(32 + r32, ch + 1));
        mfma8(p0, cat8u(a0, a1), qf[st], sc);
        mfma8(p1, cat8u(b0, b1), qf[st], sc); }
    asm volatile("s_nop 15\n\ts_nop 7" ::: "memory");
}
template <int VB>
__device__ __forceinline__ void pv_tile(f32x16* o, const LAS char* V_lds, int r32, int hi, pg8::v8i32 pa, int sc) {
#pragma unroll
    for (int d0 = 0; d0 < 4; ++d0) { const int row = d0 * 32 + r32; const LAS char* va = V_lds + VB * SHM_V;
        const u32x4 v0 = *(const LAS u32x4*)(va + V8SWZ(row, 2 * hi)), v1 = *(const LAS u32x4*)(va + V8SWZ(row, 2 * hi + 1));
        mfma8(o[d0], pa, cat8u(v0, v1), sc); }
}
struct Stage { u32x4 k0, k1, k2, v0, v1; };
constexpr int SHM_K2 = 128 * 192, SHM_V2 = 2 * SHM_V;
constexpr int NBUF = 3;
constexpr int OFF_K2 = NBUF * SHM_V2, OFF_WS2 = NBUF * SHM_V2 + NBUF * SHM_K2;
__device__ __forceinline__ void mfma8z(f32x16& acc, pg8::v8i32 a, pg8::v8i32 b, int sc) {
    asm volatile("s_nop 1\n\tv_mfma_scale_f32_32x32x64_f8f6f4 %0, %1, %2, 0, %3, %3 op_sel_hi:[0,0,0]" : "=&v"(acc) : "v"(a), "v"(b), "v"(sc)); }
#define KFRAG(ka_, st_, j_, rw_) (*(const LAS u32x4*)((ka_) + kof[j_] + 64 * (st_) + 192 * (rw_)))
#define VFRAG(va_, d0_, j_) (*(const LAS u32x4*)((va_) + vof[j_] + 2048 * (d0_)))
__device__ __forceinline__ void qkt2z(f32x16& p0, f32x16& p1, const LAS char* ka, const int* kof, const pg8::v8i32* qf, int sc) {
#pragma unroll
    for (int st = 0; st < 3; ++st) {
        const u32x4 a0 = KFRAG(ka, st, 0, 0), a1 = KFRAG(ka, st, 1, 0), b0 = KFRAG(ka, st, 0, 32), b1 = KFRAG(ka, st, 1, 32);
        if (st == 0) { mfma8z(p0, cat8u(a0, a1), qf[st], sc); mfma8z(p1, cat8u(b0, b1), qf[st], sc); }
        else { mfma8(p0, cat8u(a0, a1), qf[st], sc); mfma8(p1, cat8u(b0, b1), qf[st], sc); } }
}
__device__ __forceinline__ void pv2(f32x16* o, const LAS char* va, const int* vof, pg8::v8i32 pa, int sc) {
#pragma unroll
    for (int d0 = 0; d0 < 4; ++d0) mfma8(o[d0], pa, cat8u(VFRAG(va, d0, 0), VFRAG(va, d0, 1)), sc);
}
template <int I> __device__ __forceinline__ void cvt_ch(pg8::v8i32& pa, const f32x16& p0, const f32x16& p1, f32x2 c2, f32x2 o2) {
    constexpr int j = 4 * (I & 3);
    int w; if (I < 4) w = (int)exp2_fp8x4(p0[j], p0[j + 1], p0[j + 2], p0[j + 3], c2, o2); else w = (int)exp2_fp8x4(p1[j], p1[j + 1], p1[j + 2], p1[j + 3], c2, o2);
    asm volatile("" : "+v"(w)); pa[I] = w; }
template <int G> __device__ __forceinline__ float max_grp(float m, const f32x16& p0, const f32x16& p1) {
    const f32x16& p = G < 2 ? p0 : p1; constexpr int j = 8 * (G & 1);
    if (G == 0) { m = max3f(p[0], p[1], p[2]); m = max3f(m, p[3], p[4]); m = max3f(m, p[5], p[6]); m = max3f(m, p[7], p[7]); }
    else { m = max3f(m, p[j], p[j + 1]); m = max3f(m, p[j + 2], p[j + 3]); m = max3f(m, p[j + 4], p[j + 5]); m = max3f(m, p[j + 6], p[j + 7]); }
    return m; }
__device__ __forceinline__ void attn_block(const unsigned char* __restrict__ Q, const unsigned char* __restrict__ K, const unsigned char* __restrict__ VT, bf16_t* __restrict__ O, int b, int h, int qb, LAS char* lds, int tid) {
    asm volatile("" : "+v"(tid));
    const int wid = __builtin_amdgcn_readfirstlane(tid >> 6), lane = tid & 63, r32 = lane & 31, hi = lane >> 5;
    const int P0 = qb * 256, NS = 2 * qb + 2, qlo = P0 + wid * 32, qm = qlo + r32 - 4 * hi;
    const size_t tb = (size_t)b * 8192;
    LAS char* V_lds = lds; LAS char* K_lds = lds + OFF_K2;
    LAS float* wsf = (LAS float*)(lds + OFF_WS2) + wid * 64; LAS float* al_l = wsf + 32;
    const unsigned char* Kh = K + tb * 1536 + h * 192; const unsigned char* Vh = VT + (size_t)((b * 8 + h) * 128) * 8192;
    int sc = 0x7F7F7F7F; asm volatile("" : "+v"(sc));
    pg8::v8i32 qf[3];
    { const unsigned char* qp = Q + (tb + qlo + r32) * 1536 + h * 192 + hi * 32;
#pragma unroll
      for (int st = 0; st < 3; ++st) qf[st] = cat8u(*(const u32x4*)(qp + st * 64), *(const u32x4*)(qp + st * 64 + 16)); }
    const int swz_ = (r32 >> 2) & 3;
    const int kof[2] = {r32 * 192 + (((2 * hi) ^ swz_) << 4), r32 * 192 + (((2 * hi + 1) ^ swz_) << 4)}, vof[2] = {r32 * 64 + (((2 * hi) ^ swz_) << 4), r32 * 64 + (((2 * hi + 1) ^ swz_) << 4)};
    unsigned kgo[3], vgo;
#pragma unroll
    for (int i = 0; i < 3; ++i) { const int c = (wid * 3 + i) * 64 + lane, rw = c / 12, x = c - rw * 12; kgo[i] = (unsigned)(rw * 1536 + (((x & ~3) | ((x & 3) ^ ((rw >> 2) & 3))) << 4)); }
    { const int c = wid * 64 + lane, rw = c >> 2; vgo = (unsigned)((rw * 4 + ((c & 3) ^ ((rw >> 2) & 3))) << 4); }
#define SDMA_K(s_, bf) do { const unsigned char* kp_ = Kh + (size_t)(s_) * (128 * 1536); LAS char* kd_ = K_lds + (bf) * SHM_K2 + wid * 3072; \
        _Pragma("unroll") for (int i_ = 0; i_ < 3; ++i_) __builtin_amdgcn_global_load_lds((const unsigned*)(kp_ + kgo[i_]), (LAS unsigned*)(kd_ + i_ * 1024), 16, 0, 0); } while (0)
#define SDMA_V(s_, bf) do { const unsigned char* vp_ = Vh + (size_t)(s_) * 16384 + vgo; LAS char* vd_ = V_lds + (bf) * SHM_V2 + wid * 1024; \
        __builtin_amdgcn_global_load_lds((const unsigned*)vp_, (LAS unsigned*)vd_, 16, 0, 0); __builtin_amdgcn_global_load_lds((const unsigned*)(vp_ + 8192), (LAS unsigned*)(vd_ + SHM_V), 16, 0, 0); } while (0)
#define SDMA_WAIT() asm volatile("s_waitcnt vmcnt(0)" ::: "memory")
    LAS char* ones_l = lds + OFF_WS2 + 2048;
    if (tid < 8) ((LAS unsigned*)ones_l)[tid] = 0x38383838u;
    float m_reg = -1e30f; f32x16 o[4] = {}; f32x16 lacc = {};
#define ONES8() cat8u(*(const LAS u32x4*)ones_l, *(const LAS u32x4*)(ones_l + 16))
    SDMA_K(0, 0); SDMA_V(0, 0); SDMA_K(1, 1); SDMA_V(1, 1);
    asm volatile("s_waitcnt vmcnt(5) lgkmcnt(0)" ::: "memory");
    __builtin_amdgcn_s_barrier();
    f32x16 pA0, pA1, pB0, pB1;
    constexpr float ISQ = 1.0f / ATT_QS;
#define SM_DECIDE(PM_, O2_, RESC_) do { float pmax = (PM_); \
        { auto rr = __builtin_amdgcn_permlane32_swap(__float_as_uint(pmax), __float_as_uint(pmax), false, false); pmax = fmaxf(__uint_as_float(rr[0]), __uint_as_float(rr[1])); } \
        float mn, alpha; \
        if (__builtin_expect(__all((pmax - m_reg) <= THR), 1)) { mn = m_reg; alpha = 1.f; RESC_ = false; } \
        else { mn = fmaxf(m_reg, pmax); alpha = __builtin_amdgcn_exp2f((m_reg - mn) * ISQ); m_reg = mn; RESC_ = true; } \
        const float off8_ = 88.0f - mn * (8.0f * ISQ); O2_ = (f32x2){off8_, off8_}; \
        if (__any(alpha < 1.f)) { if (hi == 0) al_l[r32] = alpha; asm volatile("s_nop 15\n\ts_nop 7\n\ts_waitcnt lgkmcnt(0)" ::: "memory");     \
            _Pragma("unroll") for (int r = 0; r < 16; ++r) { const float a_ = al_l[crow(r, hi)]; o[0][r] *= a_; o[1][r] *= a_; o[2][r] *= a_; o[3][r] *= a_; lacc[r] *= a_; } } } while (0)
#define CVT_ALL(PA_, P0_, P1_, O2_) do { cvt_ch<0>(PA_, P0_, P1_, c2_, O2_); cvt_ch<1>(PA_, P0_, P1_, c2_, O2_); cvt_ch<2>(PA_, P0_, P1_, c2_, O2_); cvt_ch<3>(PA_, P0_, P1_, c2_, O2_); \
        cvt_ch<4>(PA_, P0_, P1_, c2_, O2_); cvt_ch<5>(PA_, P0_, P1_, c2_, O2_); cvt_ch<6>(PA_, P0_, P1_, c2_, O2_); cvt_ch<7>(PA_, P0_, P1_, c2_, O2_); } while (0)
    const f32x2 c2_ = {8.0f * ISQ, 8.0f * ISQ};
    struct KF { u32x4 a0, a1, b0, b1; }; struct VF { u32x4 v0, v1; };
#define LDK(ka_, st_) KF{KFRAG(ka_, st_, 0, 0), KFRAG(ka_, st_, 1, 0), KFRAG(ka_, st_, 0, 32), KFRAG(ka_, st_, 1, 32)}
#define LDV(va_, d0_) VF{VFRAG(va_, d0_, 0), VFRAG(va_, d0_, 1)}
#define STEP(s_, BUF) do { \
        const int kb0_ = (s_) * 128, kb1_ = kb0_ + 64;     \
        const int sn_ = (s_) + 2 < NS ? (s_) + 2 : NS - 1;     \
        const LAS char* kbuf_ = K_lds + BUF * SHM_K2; const LAS char* vbuf_ = V_lds + BUF * SHM_V2; const LAS char* kb_ = kbuf_ + 64 * 192; const LAS char* vb_ = vbuf_ + SHM_V; \
        KF f0 = LDK(kbuf_, 0), f1 = LDK(kbuf_, 1);             \
        { \
            pg8::v8i32 pa, pb; float pmb_ = 0.f; f32x2 o2a_, o2b_; VF v0, v1, w0, w1; bool ra_, rb_; \
            { SBAR(); mfma8z(pA0, cat8u(f0.a0, f0.a1), qf[0], sc); mfma8z(pA1, cat8u(f0.b0, f0.b1), qf[0], sc); SBAR(); \
              KF f2 = LDK(kbuf_, 2); SBAR(); SDMA_K(sn_, (BUF + 2) % NBUF);     \
              SBAR(); mfma8(pA0, cat8u(f1.a0, f1.a1), qf[1], sc); mfma8(pA1, cat8u(f1.b0, f1.b1), qf[1], sc); SBAR(); \
              KF g0 = LDK(kb_, 0); SBAR(); SDMA_V(sn_, (BUF + 2) % NBUF); \
              SBAR(); mfma8(pA0, cat8u(f2.a0, f2.a1), qf[2], sc); mfma8(pA1, cat8u(f2.b0, f2.b1), qf[2], sc); SBAR(); \
              KF g1 = LDK(kb_, 1); \
                \
                \
              SBAR(); mfma8z(pB0, cat8u(g0.a0, g0.a1), qf[0], sc); mfma8z(pB1, cat8u(g0.b0, g0.b1), qf[0], sc); SBAR(); \
              asm volatile("s_nop 7" ::: "memory"); \
              if (kb0_ + 63 > qlo) mask_tile(pA0, pA1, qm - kb0_); \
              float pm_ = 0.f; pm_ = max_grp<0>(pm_, pA0, pA1); pm_ = max_grp<1>(pm_, pA0, pA1); pm_ = max_grp<2>(pm_, pA0, pA1); pm_ = max_grp<3>(pm_, pA0, pA1); \
              SM_DECIDE(pm_, o2a_, ra_); \
                \
              KF g2 = LDK(kb_, 2); \
              SBAR(); mfma8(pB0, cat8u(g1.a0, g1.a1), qf[1], sc); SBAR(); cvt_ch<0>(pa, pA0, pA1, c2_, o2a_); cvt_ch<1>(pa, pA0, pA1, c2_, o2a_); cvt_ch<2>(pa, pA0, pA1, c2_, o2a_); \
              SBAR(); mfma8(pB1, cat8u(g1.b0, g1.b1), qf[1], sc); SBAR(); cvt_ch<3>(pa, pA0, pA1, c2_, o2a_); cvt_ch<4>(pa, pA0, pA1, c2_, o2a_); \
              v0 = LDV(vbuf_, 0); v1 = LDV(vbuf_, 1); \
              SBAR(); mfma8(pB0, cat8u(g2.a0, g2.a1), qf[2], sc); SBAR(); cvt_ch<5>(pa, pA0, pA1, c2_, o2a_); cvt_ch<6>(pa, pA0, pA1, c2_, o2a_); \
              SBAR(); mfma8(pB1, cat8u(g2.b0, g2.b1), qf[2], sc); SBAR(); cvt_ch<7>(pa, pA0, pA1, c2_, o2a_); } \
              \
            if (kb1_ + 63 > qlo) { asm volatile("s_nop 15\n\ts_nop 7" ::: "memory"); mask_tile(pB0, pB1, qm - kb1_); } \
              \
            { SBAR(); mfma8(o[0], pa, cat8u(v0.v0, v0.v1), sc); asm volatile("s_nop 7" ::: "memory"); SBAR(); \
              VF v2 = LDV(vbuf_, 2); pmb_ = max_grp<0>(pmb_, pB0, pB1); cvt_ch<0>(pb, pB0, pB1, c2_, o2a_); cvt_ch<1>(pb, pB0, pB1, c2_, o2a_); \
              SBAR(); mfma8(o[1], pa, cat8u(v1.v0, v1.v1), sc); SBAR(); \
              VF v3 = LDV(vbuf_, 3); pmb_ = max_grp<1>(pmb_, pB0, pB1); cvt_ch<2>(pb, pB0, pB1, c2_, o2a_); cvt_ch<3>(pb, pB0, pB1, c2_, o2a_); \
              SBAR(); mfma8(o[2], pa, cat8u(v2.v0, v2.v1), sc); SBAR(); \
              const pg8::v8i32 on_ = ONES8(); pmb_ = max_grp<2>(pmb_, pB0, pB1); cvt_ch<4>(pb, pB0, pB1, c2_, o2a_); cvt_ch<5>(pb, pB0, pB1, c2_, o2a_); \
              SBAR(); mfma8(o[3], pa, cat8u(v3.v0, v3.v1), sc); SBAR(); \
              w0 = LDV(vb_, 0); w1 = LDV(vb_, 1); pmb_ = max_grp<3>(pmb_, pB0, pB1); cvt_ch<6>(pb, pB0, pB1, c2_, o2a_); cvt_ch<7>(pb, pB0, pB1, c2_, o2a_); \
              SBAR(); mfma8(lacc, pa, on_, sc); SBAR(); } \
            SM_DECIDE(pmb_, o2b_, rb_); \
            if (rb_) CVT_ALL(pb, pB0, pB1, o2b_); \
            { SBAR(); mfma8(o[0], pb, cat8u(w0.v0, w0.v1), sc); SBAR(); \
              VF w2 = LDV(vb_, 2); \
              SBAR(); mfma8(o[1], pb, cat8u(w1.v0, w1.v1), sc); SBAR(); \
              VF w3 = LDV(vb_, 3); \
              SBAR(); mfma8(o[2], pb, cat8u(w2.v0, w2.v1), sc); SBAR(); \
              const pg8::v8i32 on_ = ONES8(); \
              SBAR(); mfma8(o[3], pb, cat8u(w3.v0, w3.v1), sc); mfma8(lacc, pb, on_, sc); SBAR(); } \
        } \
        asm volatile("s_waitcnt vmcnt(5) lgkmcnt(0)" ::: "memory");     \
        __builtin_amdgcn_s_barrier(); } while (0)
    for (int s_i = 0; s_i < NS; s_i += 3) { STEP(s_i, 0); if (s_i + 1 < NS) STEP(s_i + 1, 1); if (s_i + 2 < NS) STEP(s_i + 2, 2); }
    SDMA_WAIT();
#undef STEP
#undef SM_DECIDE
#undef CVT_ALL
#undef SDMA_K
#undef SDMA_V
#undef SDMA_WAIT
#undef ONES8
#undef LDK
#undef LDV
    int lz = lane; asm volatile("" : "+v"(lz)); const int r32e = lz & 31, hie = lz >> 5;
    asm volatile("s_nop 15\n\ts_nop 7" ::: "memory");
    LAS unsigned char* stg = (LAS unsigned char*)lds + OFF_WS2 + 2112 + wid * 1152;
    unsigned char* Ob = (unsigned char*)O + (tb + qlo) * 1024 + h * 128;
#pragma unroll
    for (int q = 0; q < 4; ++q) {
#pragma unroll
        for (int rr = 0; rr < 4; ++rr) { const int r = 4 * q + rr, lrow = rr + 4 * hie;
            const float rl = __builtin_amdgcn_rcpf(lacc[r] * (ATT_VS / OB_SCALE));
#pragma unroll
            for (int d0 = 0; d0 < 4; ++d0) { const float v = o[d0][r] * rl; const float vn = DPP_F(v, 0xB1);
                if ((r32e & 1) == 0) *(LAS unsigned short*)(stg + lrow * 144 + d0 * 32 + r32e) = (unsigned short)__builtin_amdgcn_cvt_pk_fp8_f32(v, vn, 0, false); } }
        asm volatile("s_waitcnt lgkmcnt(0)" ::: "memory");
        { const int row = lz >> 3, ch = lz & 7; const u32x4 w = *(const LAS u32x4*)(stg + row * 144 + ch * 16);
          *(u32x4*)(Ob + (size_t)(8 * q + row) * 1024 + ch * 16) = w; }
        __builtin_amdgcn_sched_barrier(0); }
    __syncthreads();
}
#undef KFRAG
#undef VFRAG
__device__ __forceinline__ void attn_phase(const unsigned char* Q, const unsigned char* K, const unsigned char* VT, bf16_t* O, LAS char* lds, int G, int vcu, int tid) {
    for (int L = vcu; L < 512; L += G) {
        const int bh = L >> 4, x = L & 15, b = bh >> 3, h = bh & 7;
#pragma unroll 1
        for (int pass = 0; pass < 2; ++pass) attn_block(Q, K, VT, O, b, h, pass ? 31 - x : x, lds, tid);
    }
}
#undef K8SWZ
#undef V8SWZ
#undef SBAR
}

#ifndef PH_MASK
#define PH_MASK 0xffffffffu
#endif
#define PH_ON(n) (((PH_MASK) >> (n)) & 1u)
#ifndef REP_MASK
#define REP_MASK 0u
#endif
#define REP(n) (1 + (int)(((REP_MASK) >> (n)) & 1u))
__global__ void __launch_bounds__(512, 2) yoco_fwd(const Params p) {
    extern __shared__ __attribute__((aligned(16))) unsigned char lds_raw[];
    LAS unsigned char* lds = (LAS unsigned char*)lds_raw;
    const int G0 = gridDim.x, bx0 = blockIdx.x, vcu0 = (G0 % 8 == 0) ? (bx0 % 8) * (G0 / 8) + bx0 / 8 : bx0;
    volatile LAS unsigned* misc = (volatile LAS unsigned*)(lds + MISC_OFF);
    for (int i = threadIdx.x; i < (LDS_BYTES - MISC_OFF) / 4; i += 512) misc[i] = 0u;
    __syncthreads();
    XcdBarrier bar = xcd_barrier_post((unsigned*)(p.ws + WS_CTL) + CW_BAR, misc + MW_BAR);
#define GRID_BAR() xcd_barrier(bar)
#define PHASE_VARS() KPtr pp = (KPtr)__builtin_amdgcn_kernarg_segment_ptr(); asm volatile("" : "+s"(pp)); unsigned char* ws = pp->ws; (void)pp; \
    int G = G0, bx = bx0, vcu = vcu0; asm volatile("" : "+s"(G), "+s"(bx), "+s"(vcu)); const int NGW = G * 8; (void)NGW; (void)bx; int tid = bar.wave * 64 + lane_id(); asm volatile("" : "+v"(tid)); \
    const int lane = tid & 63, wave = bar.wave, gw = vcu * 8 + wave; (void)lane; (void)gw; (void)ws

    { PHASE_VARS(); if (PH_ON(0)) prologue_phase(pp, ws, lds, tid, vcu, G, gw, NGW, lane, 2, NTJOBS, true); }
    GRID_BAR();
    { PHASE_VARS(); if (PH_ON(0) && (vcu & 1)) prologue_phase(pp, ws, lds, tid, vcu, G, gw, NGW, lane, 0, 2, false); }
    for (int l = 0; l < 4; ++l) { PHASE_VARS();
        DenseSched S; S.init((const bf16_t*)(ws + WS_PB) + (size_t)l * T * 256, (const bf16_t*)(ws + WS_WPP) + (size_t)l * 1024 * 256, T, 1024, 256, 256, G, bx);
        EpiBf16 E{(bf16_t*)(ws + WS_PP) + (size_t)l * T * 1024, 1024};
        if (PH_ON(1)) for (int r_ = 0; r_ < REP(1); ++r_) pg8::gemm_phase(lds, tid, 256, 256, 256, S, E);
    }

    for (int l = 0; l < 4; ++l) {
        if (l < 2) {
            { PHASE_VARS(); DenseSched S; S.init((const bf16_t*)(ws + WS_XBA), (const bf16_t*)(ws + WS_WRIN) + (size_t)l * 6144 * 1024, T, 4096, 1024, 1024, G, bx);
              EpiRetA E{(bf16_t*)(ws + WS_QB), (bf16_t*)(ws + WS_ACAT), (bf16_t*)(ws + WS_GB), (bf16_t*)(ws + WS_KB), (const float*)(ws + WS_COSR), (const float*)(ws + WS_SINR), (bf16_t*)(ws + WS_KDT)};
              if (PH_ON(2)) for (int r_ = 0; r_ < REP(2); ++r_) pg8::gemm_phase(lds, tid, 1024, 1024, 1024, S, E); }
#if G1B_FP8
            { PHASE_VARS(); DenseSched S; S.init((const bf16_t*)(ws + WS_WV8 + (size_t)l * 2048 * 1024), (const bf16_t*)(ws + WS_XF8), 2048, T, 512, 512, G, bx);
              EpiRetB E{(bf16_t*)(ws + WS_VS), 1.0f / WV_SCALE};
              if (PH_ON(3)) for (int r_ = 0; r_ < REP(3); ++r_) pg8::gemm_phase<true>(lds, tid, 512, 512, 512, S, E); }
#else
            { PHASE_VARS(); DenseSched S; S.init((const bf16_t*)(ws + WS_WRIN) + (size_t)l * 6144 * 1024 + (size_t)4096 * 1024, (const bf16_t*)(ws + WS_XBA), 2048, T, 1024, 1024, G, bx);
              EpiRetB E{(bf16_t*)(ws + WS_VS)};
              if (PH_ON(3)) for (int r_ = 0; r_ < REP(3); ++r_) pg8::gemm_phase(lds, tid, 1024, 1024, 1024, S, E); }
#endif
            if (l == 0) { PHASE_VARS(); if (PH_ON(0) && !(vcu & 1)) prologue_phase(pp, ws, lds, tid, vcu, G, gw, NGW, lane, 0, 2, false); }
            GRID_BAR();
            { PHASE_VARS(); SchedG2 S{(const char*)(ws + WS_ACAT), (const char*)(ws + WS_KB), G, bx}; EpiRetP E{(bf16_t*)(ws + WS_ACAT)};
              if (PH_ON(4)) for (int r_ = 0; r_ < REP(4); ++r_) pg8::gemm_phase(lds, tid, 2048, 1024, 256, S, E); }
            { PHASE_VARS(); SchedG3 S{(const char*)(ws + WS_VS), (const char*)(ws + WS_KDT), G, bx}; EpiRetU E{(bf16_t*)(ws + WS_VS)};
              if (PH_ON(5)) for (int r_ = 0; r_ < REP(5); ++r_) pg8::gemm_phase(lds, tid, 512, 256, 256, S, E); }
            GRID_BAR();
            { PHASE_VARS(); if (PH_ON(6)) for (int r_ = REP(6) - 1; r_ >= 0; --r_) ret_scan_phase(ws, gw * 64 + lane, NGW * 64, r_ != 0); }
            GRID_BAR();
            { PHASE_VARS(); SchedG4 S{(const char*)(ws + WS_ACAT), (const char*)(ws + WS_VS), G, bx}; EpiBf16 E{(bf16_t*)(ws + WS_Y), 2048};
              if (PH_ON(7)) for (int r_ = 0; r_ < REP(7); ++r_) pg8::gemm_phase(lds, tid, 2048, 512, 512, S, E); }
            GRID_BAR();
            { PHASE_VARS(); if (PH_ON(8)) for (int r_ = 0; r_ < REP(8); ++r_) ret_gn_phase(pp, ws, l, lane, gw, NGW); }
            GRID_BAR();
#if G5_FP8
            { PHASE_VARS(); DenseSched S; S.init((const bf16_t*)(ws + WS_Z), (const bf16_t*)((unsigned char*)(ws + WS_WROUT) + (size_t)l * 1024 * 2048), T, 1024, 1024, 1024, G, bx);
              EpiBf16 E{(bf16_t*)(ws + WS_MIX), 1024, 1.0f / (WROUT_SCALE * Z_SCALE)};
              if (PH_ON(9)) for (int r_ = 0; r_ < REP(9); ++r_) pg8::gemm_phase<true>(lds, tid, 1024, 1024, 1024, S, E); }
#else
            { PHASE_VARS(); DenseSched S; S.init((const bf16_t*)(ws + WS_Z), (const bf16_t*)(ws + WS_WROUT) + (size_t)l * 1024 * 2048, T, 1024, 2048, 2048, G, bx);
              EpiBf16 E{(bf16_t*)(ws + WS_MIX), 1024};
              if (PH_ON(9)) for (int r_ = 0; r_ < REP(9); ++r_) pg8::gemm_phase(lds, tid, 2048, 2048, 2048, S, E); }
#endif
            GRID_BAR();
        } else {
            const int j = l - 2;
#if ATT_FP8
            if (l == 2) { PHASE_VARS(); DenseSched S; S.init((const bf16_t*)(ws + WS_XF8), (const bf16_t*)(ws + WS_WKVA), T, 512, 512, 512, G, bx);
              EpiKVA E{(bf16_t*)(ws + WS_CKV), (float*)(ws + WS_SSQ), (bf16_t*)(ws + WS_KBUF), (const float*)(ws + WS_COSM), (const float*)(ws + WS_SINM), 1.0f / WKVA_SCALE};
              if (PH_ON(10)) for (int r_ = 0; r_ < REP(10); ++r_) pg8::gemm_phase<true>(lds, tid, 512, 512, 512, S, E); }
            { PHASE_VARS(); DenseSched S; S.init((const bf16_t*)(ws + WS_XF8), (const bf16_t*)((unsigned char*)(ws + WS_WQA) + (size_t)j * 256 * 1024), T, 256, 512, 512, G, bx);
              EpiQA E{(bf16_t*)(ws + WS_QLAT), (float*)(ws + WS_SSQ2), 1.0f / WQA_SCALE};
              if (PH_ON(11)) for (int r_ = 0; r_ < REP(11); ++r_) pg8::gemm_phase<true>(lds, tid, 512, 512, 512, S, E); }
#else
            if (l == 2) { PHASE_VARS(); DenseSched S; S.init((const bf16_t*)(ws + WS_XBA), (const bf16_t*)(ws + WS_WKVA), T, 512, 1024, 1024, G, bx);
              EpiKVA E{(bf16_t*)(ws + WS_CKV), (float*)(ws + WS_SSQ), (bf16_t*)(ws + WS_KBUF), (const float*)(ws + WS_COSM), (const float*)(ws + WS_SINM), 1.0f};
              if (PH_ON(10)) for (int r_ = 0; r_ < REP(10); ++r_) pg8::gemm_phase(lds, tid, 1024, 1024, 1024, S, E); }
            { PHASE_VARS(); DenseSched S; S.init((const bf16_t*)(ws + WS_XBA), (const bf16_t*)(ws + WS_WQA) + (size_t)j * 256 * 1024, T, 256, 1024, 1024, G, bx);
              EpiQA E{(bf16_t*)(ws + WS_QLAT), (float*)(ws + WS_SSQ2), 1.0f};
              if (PH_ON(11)) for (int r_ = 0; r_ < REP(11); ++r_) pg8::gemm_phase(lds, tid, 1024, 1024, 1024, S, E); }
#endif
            GRID_BAR();
            if (l == 2) { PHASE_VARS(); DenseSched S; S.init((const bf16_t*)(ws + WS_CKV), (const bf16_t*)(ws + WS_WKVB), T, 2048, 256, 256, G, bx);
              EpiKVB E{(bf16_t*)(ws + WS_KBUF), (bf16_t*)(ws + WS_VBUF), (const float*)(ws + WS_SSQ)};
              if (PH_ON(12)) for (int r_ = 0; r_ < REP(12); ++r_) pg8::gemm_phase(lds, tid, 256, 256, 256, S, E); }
            { PHASE_VARS(); DenseSched S; S.init((const bf16_t*)(ws + WS_QLAT), (const bf16_t*)(ws + WS_WQB) + (size_t)j * 1536 * 256, T, 1536, 256, 256, G, bx);
              EpiQB E{(bf16_t*)(ws + WS_QBUF), (const float*)(ws + WS_SSQ2), (const float*)(ws + WS_COSM), (const float*)(ws + WS_SINM)};
              if (PH_ON(13)) for (int r_ = 0; r_ < REP(13); ++r_) pg8::gemm_phase(lds, tid, 256, 256, 256, S, E); }
            GRID_BAR();
            { PHASE_VARS(); if (PH_ON(14)) for (int r_ = 0; r_ < REP(14); ++r_)
#if ATT_FP8
              att8::attn_phase((const unsigned char*)(ws + WS_QBUF), (const unsigned char*)(ws + WS_KBUF), (const unsigned char*)(ws + WS_VBUF), (bf16_t*)(ws + WS_OB), (LAS char*)lds, G, vcu, tid); }
#else
              att::attn_phase((const bf16_t*)(ws + WS_QBUF), (const bf16_t*)(ws + WS_KBUF), (const bf16_t*)(ws + WS_VBUF), (bf16_t*)(ws + WS_OB), (LAS char*)lds, G, vcu, tid); }
#endif
            GRID_BAR();
#if ATT_FP8
            { PHASE_VARS(); DenseSched S; S.init((const bf16_t*)(ws + WS_OB), (const bf16_t*)((unsigned char*)(ws + WS_WO) + (size_t)j * 1024 * 1024), T, 1024, 512, 512, G, bx);
              EpiBf16 E{(bf16_t*)(ws + WS_MIX), 1024, 1.0f / (WO_SCALE * OB_SCALE)};
              if (PH_ON(15)) for (int r_ = 0; r_ < REP(15); ++r_) pg8::gemm_phase<true>(lds, tid, 512, 512, 512, S, E); }
#else
            { PHASE_VARS(); DenseSched S; S.init((const bf16_t*)(ws + WS_OB), (const bf16_t*)(ws + WS_WO) + (size_t)j * 1024 * 1024, T, 1024, 1024, 1024, G, bx);
              EpiBf16 E{(bf16_t*)(ws + WS_MIX), 1024};
              if (PH_ON(15)) for (int r_ = 0; r_ < REP(15); ++r_) pg8::gemm_phase(lds, tid, 1024, 1024, 1024, S, E); }
#endif
            GRID_BAR();
        }
        { PHASE_VARS(); const bf16_t* hin = (const bf16_t*)(ws + WS_XBA);
          if (PH_ON(16)) for (int r_ = REP(16) - 1; r_ >= 0; --r_) ln1_router_phase(pp, ws, lds, l, hin, tid, wave, lane, G, r_ != 0); }
        GRID_BAR();
        { PHASE_VARS(); if (PH_ON(17)) plan_phase(ws, lds, l, tid);
          MoeSched S{nullptr, (const char*)(ws + WS_WGU) + (size_t)l * 32 * 2048 * 1024, (size_t)2048 * 1024, 8, G, vcu, misc, (const char*)(ws + WS_XBB), (const int*)(ws + WS_XG)};
          EpiGU E{(unsigned char*)(ws + WS_ACT), pp->in[21] + (size_t)l * 32 * 2048};
          if (PH_ON(18)) for (int r_ = 0; r_ < REP(18); ++r_) pg8::gemm_phase<true, true, true>(lds, tid, 512, 512, 512, S, E); }
        GRID_BAR();
        { PHASE_VARS(); MoeSched S{(const char*)(ws + WS_ACT), (const char*)(ws + WS_WDN) + (size_t)l * 32 * 1024 * 1024, (size_t)1024 * 1024, 4, G, vcu, misc, nullptr, nullptr};
          EpiDN E{(unsigned char*)(ws + WS_YS), pp->in[23] + (size_t)l * 32 * 1024};
          if (PH_ON(19)) for (int r_ = 0; r_ < REP(19); ++r_) pg8::gemm_phase<true>(lds, tid, 512, 512, 512, S, E); }
        GRID_BAR();
        { PHASE_VARS(); if (PH_ON(20)) for (int r_ = REP(20) - 1; r_ >= 0; --r_) ln2_phase(pp, ws, lds, l, lane, gw, NGW, r_ != 0); }
        GRID_BAR();
        { PHASE_VARS(); DenseSched S; S.init((const bf16_t*)(ws + WS_XBB), (const bf16_t*)(ws + WS_WPG) + (size_t)l * 1024 * 1024, T, 1024, 1024, 1024, G, bx);
          if (REP(21) == 2) { EpiPLE E{(const bf16_t*)(ws + WS_XBB), nullptr, (bf16_t*)(ws + WS_END + (size_t)T * 4096), (const bf16_t*)(ws + WS_PP) + (size_t)l * T * 1024, (unsigned char*)(ws + WS_END + (size_t)T * 6144)};
            pg8::gemm_phase(lds, tid, 1024, 1024, 1024, S, E); }
          EpiPLE E{(const bf16_t*)(ws + WS_XBB), (l == 3) ? pp->out : nullptr, (bf16_t*)(ws + WS_XBA), (const bf16_t*)(ws + WS_PP) + (size_t)l * T * 1024, (unsigned char*)(ws + WS_XF8)};
          if (PH_ON(21)) pg8::gemm_phase(lds, tid, 1024, 1024, 1024, S, E); }
        GRID_BAR();
    }
}

extern "C" void kernel_launch(void* const* d_in, const int* in_sizes, int n_in, void* d_out, int out_size, void* d_ws, size_t ws_size, hipStream_t stream) {
    static int grid = 0;
    if (grid == 0) {
        if (n_in != 26 || in_sizes[0] != T * D || out_size != T * D || ws_size < WS_END + ((size_t)300 << 20)) {
            fprintf(stderr, "kernel_launch: unexpected shapes (n_in %d, in0 %d, out %d, ws %zu need %zu); nothing launched\n", n_in, n_in > 0 ? in_sizes[0] : -1, out_size, ws_size, (size_t)WS_END); grid = -1; return; }
        int dev = 0, cus = 0, per_cu = 0;
        if (hipGetDevice(&dev) != hipSuccess || hipDeviceGetAttribute(&cus, hipDeviceAttributeMultiprocessorCount, dev) != hipSuccess) { grid = -1; return; }
        if (hipFuncSetAttribute((const void*)yoco_fwd, hipFuncAttributeMaxDynamicSharedMemorySize, LDS_BYTES) != hipSuccess) { fprintf(stderr, "kernel_launch: hipFuncSetAttribute failed\n"); grid = -1; return; }
        if (hipOccupancyMaxActiveBlocksPerMultiprocessor(&per_cu, (const void*)yoco_fwd, 512, LDS_BYTES) != hipSuccess || per_cu < 1)
            fprintf(stderr, "kernel_launch: note: occupancy query reports %d workgroups per CU\n", per_cu);
        (void)hipGetLastError();
        grid = cus;
    }
    if (grid < 0) return;
    if (hipMemsetAsync((char*)d_ws + WS_CTL, 0, CTL_BYTES, stream) != hipSuccess) { fprintf(stderr, "kernel_launch: memset failed\n"); return; }
    Params a{};
    for (int i = 0; i < 26; ++i) a.in[i] = (const float*)d_in[i];
    a.out = (float*)d_out; a.ws = (unsigned char*)d_ws;
    hipLaunchKernelGGL(yoco_fwd, dim3(grid), dim3(512), LDS_BYTES, stream, a);
    const hipError_t le = hipPeekAtLastError();
    if (le != hipSuccess) fprintf(stderr, "kernel_launch: launch failed: %s\n", hipGetErrorName(le));
}
```
